# Optimizing an MI355X kernel written in HIP

```python
import math
import jax, jax.numpy as jnp
from jax import lax
import numpy as np

D_MODEL = 2048
BATCH = 1
SEQ = 8192
DEPTH = 4

Q_BLOCK = 128
MLA_HEADS = 8
MLA_Q_LORA = 512
MLA_KV_LORA = 256
MLA_NOPE = 128
MLA_ROPE = 64
MLA_V = 128
ROPE_THETA = 10000.0
DIFF_HEADS = 8
DIFF_QK = 64
DIFF_V = 2 * DIFF_QK
NSA_HEADS = 8
NSA_KV_HEADS = 2
NSA_DH = 128
CMP_BLOCK = 32
CMP_STRIDE = 16
SLC_BLOCK = 64
N_SELECT = 16
WINDOW = 512
SLC_PER_CMP = SLC_BLOCK // CMP_STRIDE
CMP_LPAD = CMP_BLOCK // CMP_STRIDE - 1
N_OVERLAP = SLC_PER_CMP + CMP_BLOCK // CMP_STRIDE - 1
N_ALIBI_HEADS = DIFF_HEADS + NSA_HEADS
N_BRANCH = 3
BRANCH_WIDTH = 1024
D_FF = 4 * D_MODEL
N_MOD = 6
ALPHA = (2.0 * DEPTH) ** 0.25
BETA = (8.0 * DEPTH) ** -0.25
SPLITS = (MLA_Q_LORA, MLA_KV_LORA, MLA_ROPE,
          DIFF_HEADS * 2 * DIFF_QK, DIFF_HEADS * 2 * DIFF_QK, DIFF_HEADS * DIFF_V,
          NSA_HEADS * NSA_DH, 3 * 2 * NSA_KV_HEADS * NSA_DH, NSA_HEADS * 3,
          N_BRANCH * D_MODEL)
D_IN = sum(SPLITS)
SPLIT_POINTS = tuple(int(v) for v in np.cumsum(SPLITS)[:-1])

kernel_name = "hybrid_mla_diff_nsa_deepnorm_adaln"


def layer_norm_plain(x, eps=1e-5):
    xf = x.astype(jnp.float32)
    mu = jnp.mean(xf, -1, keepdims=True)
    var = jnp.mean(jnp.square(xf - mu), -1, keepdims=True)
    return ((xf - mu) * lax.rsqrt(var + eps)).astype(x.dtype)


def layer_norm(x, g, b, eps=1e-5):
    return layer_norm_plain(x, eps) * g + b


def rms_norm(x, g, eps=1e-6):
    xf = x.astype(jnp.float32)
    y = xf * lax.rsqrt(jnp.mean(jnp.square(xf), -1, keepdims=True) + eps)
    return y.astype(x.dtype) * g


def modulate(x, shift, scale):
    return layer_norm_plain(x) * (1 + scale) + shift


def masked_softmax(s, mask):
    s = jnp.where(mask, s, -jnp.inf)
    m = jnp.max(s, -1, keepdims=True)
    m = jnp.where(jnp.isfinite(m), m, 0.0)
    e = jnp.exp(s - m)
    d = jnp.sum(e, -1, keepdims=True)
    return e / jnp.where(d > 0, d, 1.0)


def alibi_slopes():
    return 2.0 ** (-8.0 * jnp.arange(1, N_ALIBI_HEADS + 1, dtype=jnp.float32) / N_ALIBI_HEADS)


def dist(a, b):
    return jnp.abs(a - b).astype(jnp.float32)


def rope(x, pos):
    d = x.shape[-1]
    inv = ROPE_THETA ** (-jnp.arange(0, d, 2, dtype=jnp.float32) / d)
    ang = pos.astype(jnp.float32)[:, None, :, None] * inv
    cos, sin = jnp.cos(ang).astype(x.dtype), jnp.sin(ang).astype(x.dtype)
    x1, x2 = x[..., : d // 2], x[..., d // 2:]
    return jnp.concatenate([x1 * cos - x2 * sin, x1 * sin + x2 * cos], -1)


def seq_blocks(x, axis):
    s = x.shape[axis]
    x = x.reshape(x.shape[:axis] + (s // Q_BLOCK, Q_BLOCK) + x.shape[axis + 1:])
    return jnp.moveaxis(x, axis, 0)


def merge_blocks(o, axis):
    o = jnp.moveaxis(o, 0, axis)
    return o.reshape(o.shape[:axis] + (o.shape[axis] * o.shape[axis + 1],) + o.shape[axis + 2:])


def mla_attention(c_q, c_kv, k_r, pos, w_uq, w_ukv, g_q, g_kv):
    b, s, _ = c_q.shape
    q = (rms_norm(c_q, g_q) @ w_uq).reshape(b, s, MLA_HEADS, MLA_NOPE + MLA_ROPE).transpose(0, 2, 1, 3)
    kv = (rms_norm(c_kv, g_kv) @ w_ukv).reshape(b, s, MLA_HEADS, MLA_NOPE + MLA_V).transpose(0, 2, 1, 3)
    q_nope, q_rope = q[..., :MLA_NOPE], rope(q[..., MLA_NOPE:], pos)
    k_nope, v = kv[..., :MLA_NOPE], kv[..., MLA_NOPE:]
    k_rope = rope(k_r[:, None], pos)[:, 0]
    scale = (MLA_NOPE + MLA_ROPE) ** -0.5
    kidx = jnp.arange(s)

    def block(args):
        qn, qr, q0 = args
        sc = (jnp.einsum('bhqd,bhkd->bhqk', qn, k_nope)
              + jnp.einsum('bhqd,bkd->bhqk', qr, k_rope)).astype(jnp.float32) * scale
        qidx = q0 + jnp.arange(Q_BLOCK)
        p = masked_softmax(sc, kidx[None, :] <= qidx[:, None])
        return jnp.einsum('bhqk,bhkd->bhqd', p.astype(v.dtype), v)

    q0s = jnp.arange(s // Q_BLOCK, dtype=jnp.int32) * Q_BLOCK
    o = merge_blocks(lax.map(block, (seq_blocks(q_nope, 2), seq_blocks(q_rope, 2), q0s)), 2)
    return o.transpose(0, 2, 1, 3).reshape(b, s, MLA_HEADS * MLA_V)


def diff_attention(q, k, v, pos, slopes, lam_params, g_sub, layer_idx):
    b, s, _ = q.shape
    q = q.reshape(b, s, DIFF_HEADS, 2, DIFF_QK).transpose(0, 2, 3, 1, 4)
    k = k.reshape(b, s, DIFF_HEADS, 2, DIFF_QK).transpose(0, 2, 3, 1, 4)
    v = v.reshape(b, s, DIFF_HEADS, DIFF_V).transpose(0, 2, 1, 3)
    lam_init = 0.8 - 0.6 * math.exp(-0.3 * layer_idx)
    lp = lam_params.astype(jnp.float32)
    lam = jnp.exp(jnp.sum(lp[0] * lp[1])) - jnp.exp(jnp.sum(lp[2] * lp[3])) + lam_init
    scale = DIFF_QK ** -0.5
    kidx = jnp.arange(s)
    sl = slopes[None, :, None, None, None]

    def block(args):
        qb, pq, q0 = args
        sc = jnp.einsum('bhiqd,bhikd->bhiqk', qb, k).astype(jnp.float32) * scale
        sc = sc - sl * dist(pq[:, None, None, :, None], pos[:, None, None, None, :])
        qidx = q0 + jnp.arange(Q_BLOCK)
        p = masked_softmax(sc, kidx[None, :] <= qidx[:, None])
        a = p[:, :, 0] - lam * p[:, :, 1]
        return jnp.einsum('bhqk,bhkd->bhqd', a.astype(v.dtype), v)

    q0s = jnp.arange(s // Q_BLOCK, dtype=jnp.int32) * Q_BLOCK
    o = merge_blocks(lax.map(block, (seq_blocks(q, 3), seq_blocks(pos, 1), q0s)), 2)
    o = rms_norm(o, g_sub) * (1.0 - lam_init)
    return o.transpose(0, 2, 1, 3).reshape(b, s, DIFF_HEADS * DIFF_V)


def compress(x, w1, b1, w2):
    b, g, s, d = x.shape
    half = x.reshape(b, g, s // CMP_STRIDE, CMP_STRIDE, d)
    blocks = jnp.concatenate([half[:, :, :-1], half[:, :, 1:]], axis=3)
    flat = blocks.reshape(b, g, s // CMP_STRIDE - 1, CMP_BLOCK * d)
    return jax.nn.gelu(flat @ w1 + b1) @ w2


def nsa_attention(q, kv, gate_logits, pos, slopes, w1, b1, w2):
    b, s, _ = q.shape
    G, R, dh = NSA_KV_HEADS, NSA_HEADS // NSA_KV_HEADS, NSA_DH
    q = q.reshape(b, s, G, R, dh).transpose(0, 2, 3, 1, 4)
    kv = kv.reshape(b, s, 3, 2, G, dh).transpose(2, 3, 0, 4, 1, 5)
    gates = jax.nn.sigmoid(gate_logits).reshape(b, s, G, R, 3).transpose(0, 2, 3, 1, 4)
    scale = dh ** -0.5
    sl = slopes.reshape(1, G, R, 1, 1)
    k_cmp = compress(kv[0, 0], w1[0], b1[0], w2[0])
    v_cmp = compress(kv[0, 1], w1[1], b1[1], w2[1])
    n_cmp = k_cmp.shape[2]
    cmp_end = jnp.arange(n_cmp) * CMP_STRIDE + (CMP_BLOCK - 1)
    pos_cmp = pos[:, CMP_BLOCK - 1::CMP_STRIDE]
    n_slc = s // SLC_BLOCK
    top = min(N_SELECT, n_slc)
    k_slc = kv[1, 0].reshape(b, G, n_slc, SLC_BLOCK, dh)
    v_slc = kv[1, 1].reshape(b, G, n_slc, SLC_BLOCK, dh)
    pos_slc = pos.reshape(b, n_slc, SLC_BLOCK)
    bi = jnp.arange(b)[:, None, None, None]
    gi = jnp.arange(G)[None, :, None, None]
    in_blk = jnp.arange(SLC_BLOCK)
    blk = jnp.arange(n_slc)
    pad = ((0, 0), (0, 0), (WINDOW, 0), (0, 0))
    k_win, v_win = jnp.pad(kv[2, 0], pad), jnp.pad(kv[2, 1], pad)
    pos_win = jnp.pad(pos, ((0, 0), (WINDOW, 0)))

    def block(args):
        qb, gb, pq, q0 = args
        qidx = q0 + jnp.arange(Q_BLOCK)
        pq5 = pq[:, None, None, :, None]
        sc = jnp.einsum('bgrqd,bgnd->bgrqn', qb, k_cmp).astype(jnp.float32) * scale
        sc = sc - sl * dist(pq5, pos_cmp[:, None, None, None, :])
        p_cmp = masked_softmax(sc, cmp_end[None, :] <= qidx[:, None])
        o_cmp = jnp.einsum('bgrqn,bgnd->bgrqd', p_cmp.astype(v_cmp.dtype), v_cmp)
        imp = jnp.pad(jnp.sum(p_cmp, 2), ((0, 0), (0, 0), (0, 0), (CMP_LPAD, N_OVERLAP)))
        span = SLC_PER_CMP * (n_slc - 1) + 1
        imp = sum(imp[..., o:o + span:SLC_PER_CMP] for o in range(N_OVERLAP))
        cur = qidx // SLC_BLOCK
        forced = (blk[None, :] == 0) | (blk[None, :] == cur[:, None]) | (blk[None, :] == cur[:, None] - 1)
        causal_blk = blk[None, :] * SLC_BLOCK <= qidx[:, None]
        score = jnp.where(forced, jnp.inf, jnp.where(causal_blk, imp, -jnp.inf))
        topv, idx = lax.top_k(score, top)
        blk_ok = topv > -jnp.inf
        kg = k_slc[bi, gi, idx].reshape(b, G, Q_BLOCK, top * SLC_BLOCK, dh)
        vg = v_slc[bi, gi, idx].reshape(b, G, Q_BLOCK, top * SLC_BLOCK, dh)
        pk = pos_slc[bi, idx].reshape(b, G, Q_BLOCK, top * SLC_BLOCK)
        tok = (idx[..., None] * SLC_BLOCK + in_blk).reshape(b, G, Q_BLOCK, top * SLC_BLOCK)
        ok = jnp.repeat(blk_ok, SLC_BLOCK, -1) & (tok <= qidx[None, None, :, None])
        sc = jnp.einsum('bgrqd,bgqkd->bgrqk', qb, kg).astype(jnp.float32) * scale
        sc = sc - sl * dist(pq5, pk[:, :, None])
        p = masked_softmax(sc, ok[:, :, None])
        o_slc = jnp.einsum('bgrqk,bgqkd->bgrqd', p.astype(vg.dtype), vg)
        kw = lax.dynamic_slice_in_dim(k_win, q0, WINDOW + Q_BLOCK, axis=2)
        vw = lax.dynamic_slice_in_dim(v_win, q0, WINDOW + Q_BLOCK, axis=2)
        pw = lax.dynamic_slice_in_dim(pos_win, q0, WINDOW + Q_BLOCK, axis=1)
        kidx = q0 - WINDOW + jnp.arange(WINDOW + Q_BLOCK)
        okw = (kidx[None, :] <= qidx[:, None]) & (kidx[None, :] > qidx[:, None] - WINDOW) & (kidx[None, :] >= 0)
        sc = jnp.einsum('bgrqd,bgkd->bgrqk', qb, kw).astype(jnp.float32) * scale
        sc = sc - sl * dist(pq5, pw[:, None, None, None, :])
        p = masked_softmax(sc, okw)
        o_win = jnp.einsum('bgrqk,bgkd->bgrqd', p.astype(vw.dtype), vw)
        return gb[..., 0:1] * o_cmp + gb[..., 1:2] * o_slc + gb[..., 2:3] * o_win

    q0s = jnp.arange(s // Q_BLOCK, dtype=jnp.int32) * Q_BLOCK
    o = lax.map(block, (seq_blocks(q, 3), seq_blocks(gates, 3), seq_blocks(pos, 1), q0s))
    o = merge_blocks(o, 3).reshape(b, NSA_HEADS, s, dh)
    return o.transpose(0, 2, 1, 3).reshape(b, s, NSA_HEADS * dh)


def setup_inputs(seed: int = 0) -> dict:
    key = jax.random.key(seed)
    ks = jax.random.split(key, 24)
    f32 = jnp.float32
    L, D = DEPTH, D_MODEL

    def nrm(k, shape, scale):
        return jax.random.normal(k, shape, f32) * scale

    def gain(k, shape):
        return 1.0 + 0.02 * jax.random.normal(k, shape, f32)

    return {
        "x": nrm(ks[0], (BATCH, SEQ, D), 1.0),
        "c": nrm(ks[1], (BATCH, D), 1.0),
        "positions": jnp.broadcast_to(jnp.arange(SEQ, dtype=jnp.int32), (BATCH, SEQ)),
        "w_ada": nrm(ks[2], (L, D, N_MOD * D), 0.5 * D ** -0.5),
        "b_ada": nrm(ks[3], (L, N_MOD * D), 0.02),
        "w_in": nrm(ks[4], (L, D, D_IN), D ** -0.5),
        "mla_q_norm": gain(ks[5], (L, MLA_Q_LORA)),
        "mla_kv_norm": gain(ks[6], (L, MLA_KV_LORA)),
        "mla_w_uq": nrm(ks[7], (L, MLA_Q_LORA, MLA_HEADS * (MLA_NOPE + MLA_ROPE)), MLA_Q_LORA ** -0.5),
        "mla_w_ukv": nrm(ks[8], (L, MLA_KV_LORA, MLA_HEADS * (MLA_NOPE + MLA_V)), MLA_KV_LORA ** -0.5),
        "diff_lambda": nrm(ks[9], (L, 4, DIFF_QK), 0.1),
        "diff_subln": gain(ks[10], (L, DIFF_V)),
        "nsa_cmp_w1": nrm(ks[11], (L, 2, CMP_BLOCK * NSA_DH, NSA_DH), (CMP_BLOCK * NSA_DH) ** -0.5),
        "nsa_cmp_b1": nrm(ks[12], (L, 2, NSA_DH), 0.02),
        "nsa_cmp_w2": nrm(ks[13], (L, 2, NSA_DH, NSA_DH), NSA_DH ** -0.5),
        "w_branch": nrm(ks[14], (L, N_BRANCH, BRANCH_WIDTH, D), BETA * BRANCH_WIDTH ** -0.5),
        "w_out": nrm(ks[15], (L, D, D), BETA * D ** -0.5),
        "ln1_g": gain(ks[16], (L, D)),
        "ln1_b": nrm(ks[17], (L, D), 0.02),
        "w_ff1": nrm(ks[18], (L, D, D_FF), D ** -0.5),
        "w_ff2": nrm(ks[19], (L, D_FF, D), BETA * D_FF ** -0.5),
        "ln2_g": gain(ks[20], (L, D)),
        "ln2_b": nrm(ks[21], (L, D), 0.02),
    }


def reference(x, c, positions, w_ada, b_ada, w_in, mla_q_norm, mla_kv_norm, mla_w_uq, mla_w_ukv,
              diff_lambda, diff_subln, nsa_cmp_w1, nsa_cmp_b1, nsa_cmp_w2, w_branch, w_out,
              ln1_g, ln1_b, w_ff1, w_ff2, ln2_g, ln2_b):
    b, s, _ = x.shape
    slopes = alibi_slopes()
    s_diff, s_nsa = slopes[0::2], slopes[1::2]
    c_act = jax.nn.silu(c)
    for l in range(DEPTH):
        mod = (c_act @ w_ada[l] + b_ada[l])[:, None, :]
        sh_a, sc_a, g_a, sh_m, sc_m, g_m = jnp.split(mod, N_MOD, -1)
        h = modulate(x, sh_a, sc_a)
        z = h @ w_in[l]
        cq, ckv, kr, dq, dk, dv, nq, nkv, ngate, mgate = jnp.split(z, SPLIT_POINTS, -1)
        o_mla = mla_attention(cq, ckv, kr, positions, mla_w_uq[l], mla_w_ukv[l], mla_q_norm[l], mla_kv_norm[l])
        o_diff = diff_attention(dq, dk, dv, positions, s_diff, diff_lambda[l], diff_subln[l], l)
        o_nsa = nsa_attention(nq, nkv, ngate, positions, s_nsa, nsa_cmp_w1[l], nsa_cmp_b1[l], nsa_cmp_w2[l])
        branches = jnp.stack([o_mla, o_diff, o_nsa], 2)
        proj = jnp.einsum('bsnf,nfd->bsnd', branches, w_branch[l])
        gate = jax.nn.sigmoid(mgate).reshape(b, s, N_BRANCH, D_MODEL)
        attn = jnp.sum(gate * proj, 2) @ w_out[l]
        x = layer_norm(ALPHA * x + g_a * attn, ln1_g[l], ln1_b[l])
        h = modulate(x, sh_m, sc_m)
        ff = jnp.square(jax.nn.relu(h @ w_ff1[l])) @ w_ff2[l]
        x = layer_norm(ALPHA * x + g_m * ff, ln2_g[l], ln2_b[l])
    return x
```

```cpp
#include <hip/hip_runtime.h>
#include <cstdio>
#include <cstdint>

#define LAS __attribute__((address_space(3)))
#define GAS __attribute__((address_space(1)))
typedef unsigned short bf16_t;
typedef short bf16x8 __attribute__((ext_vector_type(8)));
typedef short s16x4 __attribute__((ext_vector_type(4)));
typedef float f32x4 __attribute__((ext_vector_type(4)));
typedef float f32x2 __attribute__((ext_vector_type(2)));
typedef float f32x16 __attribute__((ext_vector_type(16)));
typedef unsigned u32x4 __attribute__((ext_vector_type(4)));
typedef unsigned u32x2 __attribute__((ext_vector_type(2)));
typedef GAS unsigned gu32;

constexpr int S = 8192, D = 2048, NL = 4, FF = 8192;
constexpr int LDZ = 12800;
constexpr int ZC_CQ = 0, ZC_CKV = 512, ZC_DQ = 768, ZC_DK = 1792, ZC_DV = 2816, ZC_NQ = 3840, ZC_NKV = 4864, ZC_MG = 6400, ZC_KR = 12544, ZC_NG = 12608;
constexpr int DIN_SRC = 12632;
constexpr float ALPHA_RES = 1.6817928305074292f;
constexpr int NWAVES = 8, NTHREADS = 512;

__host__ __device__ __forceinline__ int zsrc(int n) {
    if (n < 768) return n;
    if (n < 6400) return n + 64;
    if (n < 12544) return n + 88;
    if (n < 12608) return n - 12544 + 768;
    if (n < 12632) return n - 12608 + 6464;
    return -1;
}

constexpr size_t MiB = 1u << 20;
constexpr size_t WS_CTL = 0, CTL_ZERO_BYTES = 1 * MiB;
constexpr size_t WS_MOD = 1 * MiB;
constexpr size_t WS_ROPE = 2 * MiB;
constexpr size_t WS_SSQ = 4 * MiB;
constexpr size_t WS_KCMP = 5 * MiB;
constexpr size_t WS_KROPE = 6 * MiB;
constexpr size_t WS_X = 8 * MiB;
constexpr size_t WS_Y = 72 * MiB;
constexpr size_t WS_MIX = 136 * MiB;
constexpr size_t WS_H = 200 * MiB;
constexpr size_t WS_MIXB = 232 * MiB;
constexpr size_t WS_QM = 264 * MiB;
constexpr size_t WS_KVM = 288 * MiB;
constexpr size_t WS_BR = 320 * MiB;
constexpr size_t WS_Z = 368 * MiB;
constexpr size_t WS_W = 568 * MiB;
constexpr size_t WL_STRIDE = 140 * MiB;
constexpr size_t WL_IN = 0, WL_FF1 = 50 * MiB, WL_FF2 = 82 * MiB, WL_BR = 114 * MiB, WL_OUT = 126 * MiB, WL_UQ = 134 * MiB, WL_UKV = 136 * MiB, WL_C1 = 137 * MiB, WL_C2 = 139 * MiB;
constexpr size_t WS_END = WS_W + NL * WL_STRIDE;

constexpr int CW_BAR = 4096;
constexpr int CW_QUEUE = 16384;

constexpr int RING_BYTES = 131072;
constexpr int MISC_OFF = RING_BYTES;
constexpr int LDS_BYTES = RING_BYTES + 1024;

#define RLX_AGENT __ATOMIC_RELAXED, __HIP_MEMORY_SCOPE_AGENT
#define LDS_WAIT() asm volatile("s_waitcnt lgkmcnt(0)" ::: "memory")
#define VM_WAIT() asm volatile("s_waitcnt vmcnt(0)" ::: "memory")
__device__ __forceinline__ unsigned f2bf(float f) { unsigned u = __builtin_bit_cast(unsigned, f); return (u + 0x7fffu + ((u >> 16) & 1u)) >> 16; }
__device__ __forceinline__ unsigned pk2(float lo, float hi) { return f2bf(lo) | (f2bf(hi) << 16); }
__device__ __forceinline__ float bflo(unsigned w) { return __builtin_bit_cast(float, w << 16); }
__device__ __forceinline__ float bfhi(unsigned w) { return __builtin_bit_cast(float, w & 0xffff0000u); }
__device__ __forceinline__ float bf1(bf16_t h) { return __builtin_bit_cast(float, ((unsigned)h) << 16); }
__device__ __forceinline__ float wave_sum(float v) {
#pragma unroll
    for (int o = 1; o < 64; o <<= 1) v += __shfl_xor(v, o);
    return v;
}
__device__ __forceinline__ float wave_max(float v) {
#pragma unroll
    for (int o = 1; o < 64; o <<= 1) v = fmaxf(v, __shfl_xor(v, o));
    return v;
}
__device__ __forceinline__ float sigmoidf_(float x) { return 1.f / (1.f + __expf(-x)); }
#define MK_N_LAUNCHES 1
namespace pg8 {
#define PG8_LAS __attribute__((address_space(3)))
constexpr int BM = 256, BK = 64, HALF = 128, HTB = HALF * BK * 2  , STAGE_BYTES = 8 * HTB, NXCD = 8, WGM = 8;

__host__ __device__ __forceinline__ int lds_byte(int r, int c) { const int st = (r >> 4) * 2 + (c >> 5), rr = r & 15, cc = c & 31, ob = rr * 64 + cc * 2; return st * 1024 + (ob ^ (((ob >> 9) & 1) << 5)); }
__host__ __device__ __forceinline__ void stage_rc(int b, int& R, int& C) { const int st = b / 1024, sb = b % 1024, swz = sb ^ (((sb >> 9) & 1) << 5); R = (st >> 1) * 16 + swz / 64; C = (st & 1) * 32 + (swz % 64) / 2; }
__host__ __device__ __forceinline__ int perm32(int rho) { const int n = rho >> 4, i = rho & 15; return 8 * (i >> 2) + 4 * n + (i & 3); }

struct Unit { int pm, pn, z; };
struct Gemm { const bf16_t* A; const bf16_t* Bt; int K, lda, ldb; size_t az, bz; };

__host__ __device__ __forceinline__ void tile_of(int wgid, int nM, int nN, int& pm, int& pn) {
    const int nwg = nM * nN;
    { const int q = nwg / NXCD, r = nwg % NXCD, xcd = wgid % NXCD, off = wgid / NXCD; wgid = (xcd < r ? xcd * (q + 1) : r * (q + 1) + (xcd - r) * q) + off; }
    const int nig = WGM * nN, gid = wgid / nig, fm = gid * WGM, gsz = (nM - fm) < WGM ? (nM - fm) : WGM;
    pm = fm + ((wgid % nig) % gsz); pn = (wgid % nig) / gsz;
}
struct PlainOrder {
    int nM, nN, nwg, G, c;
    __host__ __device__ void init(int M, int N, int G_, int c_) { nM = M / BM; nN = N / BM; nwg = nM * nN; G = G_; c = c_; }
    __host__ __device__ bool next(int i, Unit& u) const {
        const long L = (long)i * G + c; if (L >= nwg) return false;
        tile_of((int)L, nM, nN, u.pm, u.pn); u.z = 0; return true;
    }
    __device__ __forceinline__ void a_ready(const Unit&) const {}
    __device__ __forceinline__ void done(const Unit&) const {}
};
template <int NZ> struct SliceOrder {
    int nM, nN, nwg, G, c;
    __host__ __device__ void init(int M, int N, int G_, int c_) { nM = M / BM; nN = N / BM; nwg = nM * nN; G = G_; c = c_; }
    __host__ __device__ bool next(int i, Unit& u) const {
        const long L = (long)(i / NZ) * G + c; if (L >= nwg) return false;
        tile_of((int)L, nM, nN, u.pm, u.pn); u.z = i % NZ; return true;
    }
    __device__ __forceinline__ void a_ready(const Unit&) const {}
    __device__ __forceinline__ void done(const Unit&) const {}
};

__device__ __forceinline__ unsigned cvt_pk_bf16(float lo, float hi) { unsigned r; asm volatile("v_cvt_pk_bf16_f32 %0, %1, %2" : "=v"(r) : "v"(lo), "v"(hi)); return r; }


struct EpiZ {
    static constexpr bool PERM = true, AFTER_DRAIN = false;
    bf16_t* Z; float* ssq;
    __device__ __forceinline__ void operator()(const f32x4 (&acc)[2][2][4][2], const Unit& u, int wr, int wc, int fr, int fq) const {
        const int row0 = u.pm * BM + wr * 64 + fr, col0 = u.pn * BM + wc * 32 + 8 * fq;
#pragma unroll
        for (int ai = 0; ai < 2; ++ai)
#pragma unroll
            for (int m = 0; m < 4; ++m) { const int row = row0 + ai * HALF + m * 16; bf16_t* rowp = Z + (size_t)row * LDZ + col0; float ss = 0.f;
#pragma unroll
                for (int bj = 0; bj < 2; ++bj) { const f32x4 v0 = acc[ai][bj][m][0], v1 = acc[ai][bj][m][1];
                    ss += (v0[0] * v0[0] + v0[1] * v0[1]) + (v0[2] * v0[2] + v0[3] * v0[3]) + (v1[0] * v1[0] + v1[1] * v1[1]) + (v1[2] * v1[2] + v1[3] * v1[3]);
                    u32x4 w; w.x = cvt_pk_bf16(v0[0], v0[1]); w.y = cvt_pk_bf16(v0[2], v0[3]); w.z = cvt_pk_bf16(v1[0], v1[1]); w.w = cvt_pk_bf16(v1[2], v1[3]);
                    *(u32x4*)(rowp + bj * HALF) = w; }
                if (u.pn < 3) { ss += __shfl_xor(ss, 16); ss += __shfl_xor(ss, 32);
                    if (fq == 0) __hip_atomic_fetch_add(ssq + (size_t)row * 2 + (u.pn == 2 ? 1 : 0), ss, __ATOMIC_RELAXED, __HIP_MEMORY_SCOPE_AGENT); } }
    }
};
struct EpiRs {
    static constexpr bool PERM = true, AFTER_DRAIN = false;
    bf16_t* O; int ldc; const float* ssq; int which; float invK;
    __device__ __forceinline__ void operator()(const f32x4 (&acc)[2][2][4][2], const Unit& u, int wr, int wc, int fr, int fq) const {
        const int row0 = u.pm * BM + wr * 64 + fr, col0 = u.pn * BM + wc * 32 + 8 * fq;
#pragma unroll
        for (int ai = 0; ai < 2; ++ai)
#pragma unroll
            for (int m = 0; m < 4; ++m) { const int row = row0 + ai * HALF + m * 16; bf16_t* rowp = O + (size_t)row * ldc + col0;
                const float rs = 1.0f / sqrtf(ssq[(size_t)row * 2 + which] * invK + 1e-6f);
#pragma unroll
                for (int bj = 0; bj < 2; ++bj) { const f32x4 v0 = acc[ai][bj][m][0] * rs, v1 = acc[ai][bj][m][1] * rs;
                    u32x4 w; w.x = cvt_pk_bf16(v0[0], v0[1]); w.y = cvt_pk_bf16(v0[2], v0[3]); w.z = cvt_pk_bf16(v1[0], v1[1]); w.w = cvt_pk_bf16(v1[2], v1[3]);
                    *(u32x4*)(rowp + bj * HALF) = w; } }
    }
};
struct EpiRelu2 {
    static constexpr bool PERM = true, AFTER_DRAIN = false;
    bf16_t* O; int ldc;
    __device__ __forceinline__ void operator()(const f32x4 (&acc)[2][2][4][2], const Unit& u, int wr, int wc, int fr, int fq) const {
        const int row0 = u.pm * BM + wr * 64 + fr, col0 = u.pn * BM + wc * 32 + 8 * fq;
#pragma unroll
        for (int ai = 0; ai < 2; ++ai)
#pragma unroll
            for (int m = 0; m < 4; ++m) { bf16_t* rowp = O + (size_t)(row0 + ai * HALF + m * 16) * ldc + col0;
#pragma unroll
                for (int bj = 0; bj < 2; ++bj) { f32x4 v0 = acc[ai][bj][m][0], v1 = acc[ai][bj][m][1];
#pragma unroll
                    for (int j = 0; j < 4; ++j) { const float a = fmaxf(v0[j], 0.f), b = fmaxf(v1[j], 0.f); v0[j] = a * a; v1[j] = b * b; }
                    u32x4 w; w.x = cvt_pk_bf16(v0[0], v0[1]); w.y = cvt_pk_bf16(v0[2], v0[3]); w.z = cvt_pk_bf16(v1[0], v1[1]); w.w = cvt_pk_bf16(v1[2], v1[3]);
                    *(u32x4*)(rowp + bj * HALF) = w; } }
    }
};
struct EpiMix {
    static constexpr bool PERM = true, AFTER_DRAIN = false;
    const bf16_t* Zg; float* MIX; bf16_t* MIXB;
    __device__ __forceinline__ void operator()(const f32x4 (&acc)[2][2][4][2], const Unit& u, int wr, int wc, int fr, int fq) const {
        const int row0 = u.pm * BM + wr * 64 + fr, col0 = u.pn * BM + wc * 32 + 8 * fq;
#pragma unroll
        for (int ai = 0; ai < 2; ++ai)
#pragma unroll
            for (int m = 0; m < 4; ++m) { const int row = row0 + ai * HALF + m * 16;
#pragma unroll
                for (int bj = 0; bj < 2; ++bj) { const int col = col0 + bj * HALF;
                    const u32x4 gw = *(const u32x4*)(Zg + (size_t)row * LDZ + u.z * D + col);
                    f32x4 g0, g1; g0[0] = sigmoidf_(bflo(gw.x)); g0[1] = sigmoidf_(bfhi(gw.x)); g0[2] = sigmoidf_(bflo(gw.y)); g0[3] = sigmoidf_(bfhi(gw.y));
                    g1[0] = sigmoidf_(bflo(gw.z)); g1[1] = sigmoidf_(bfhi(gw.z)); g1[2] = sigmoidf_(bflo(gw.w)); g1[3] = sigmoidf_(bfhi(gw.w));
                    f32x4 v0 = acc[ai][bj][m][0] * g0, v1 = acc[ai][bj][m][1] * g1;
                    float* mp = MIX + (size_t)row * D + col;
                    if (u.z > 0) { v0 += *(const f32x4*)mp; v1 += *(const f32x4*)(mp + 4); }
                    if (u.z < 2) { *(f32x4*)mp = v0; *(f32x4*)(mp + 4) = v1; }
                    else { u32x4 w; w.x = cvt_pk_bf16(v0[0], v0[1]); w.y = cvt_pk_bf16(v0[2], v0[3]); w.z = cvt_pk_bf16(v1[0], v1[1]); w.w = cvt_pk_bf16(v1[2], v1[3]);
                        *(u32x4*)(MIXB + (size_t)row * D + col) = w; } } }
    }
};
struct EpiRes {
    static constexpr bool PERM = false, AFTER_DRAIN = false;
    const float* X; const float* gvec; float* Y;
    __device__ __forceinline__ void operator()(const f32x4 (&acc)[2][2][4][2], const Unit& u, int wr, int wc, int fr, int fq) const {
        const int row0 = u.pm * BM + wr * 64 + fr, col0 = u.pn * BM + wc * 32 + 4 * fq;
        f32x4 gv[2][2];
#pragma unroll
        for (int bj = 0; bj < 2; ++bj)
#pragma unroll
            for (int n = 0; n < 2; ++n) gv[bj][n] = *(const f32x4*)(gvec + col0 + bj * HALF + n * 16);
#pragma unroll
        for (int ai = 0; ai < 2; ++ai)
#pragma unroll
            for (int m = 0; m < 4; ++m) { const size_t ro = (size_t)(row0 + ai * HALF + m * 16) * D + col0;
#pragma unroll
                for (int bj = 0; bj < 2; ++bj)
#pragma unroll
                    for (int n = 0; n < 2; ++n) { const f32x4 xv = *(const f32x4*)(X + ro + bj * HALF + n * 16);
                        *(f32x4*)(Y + ro + bj * HALF + n * 16) = xv * ALPHA_RES + gv[bj][n] * acc[ai][bj][m][n]; } }
    }
};

template <class Epi, class Sched, bool ALIGN_EPI = false>
__device__ __forceinline__ void gemm_phase(PG8_LAS unsigned char* lds, const Gemm g, const Sched& S, const Epi& E, const int tid) {
    const int wid = __builtin_amdgcn_readfirstlane(tid >> 6), lane = tid & 63, wr = wid >> 2, wc = wid & 3, fr = lane & 15, fq = lane >> 4;
    const int K = g.K, nt = K / BK;
    unsigned voffA[2], voffB[2];
#pragma unroll
    for (int i = 0; i < 2; ++i) { int R, C; stage_rc(tid * 16 + i * 8192, R, C); const int Rb = Epi::PERM ? ((R & ~31) + perm32(R & 31)) : R;
        voffA[i] = (unsigned)(R * g.lda + C) * 2u; voffB[i] = (unsigned)(Rb * g.ldb + C) * 2u; }
    const size_t kstep = (size_t)(BK * 2);
    const size_t hstepA = (size_t)HALF * g.lda * 2, hstepB = (size_t)HALF * g.ldb * 2;
    const size_t tstepA = 2 * hstepA, tstepB = 2 * hstepB;
    const unsigned ldsw = (unsigned)wid * 1024u;
    const int aoff = lds_byte(wr * 64 + fr, fq * 8), boff = lds_byte(wc * 32 + fr, fq * 8);
#define PG8_SA(b, h) (((b) * 2 + (h)) * HTB)
#define PG8_SB(b, h) ((4 + (b) * 2 + (h)) * HTB)
#define PG8_STAGE(bufoff, gbase, voff) do { _Pragma("unroll") for (int _i = 0; _i < 2; ++_i) \
        __builtin_amdgcn_global_load_lds((const unsigned*)((const char*)(gbase) + (voff)[_i]), (PG8_LAS unsigned*)(lds + (bufoff) + ldsw + _i * 8192), 16, 0, 0); } while (0)
#define PG8_LDA(dst, b, h) do { _Pragma("unroll") for (int m = 0; m < 4; ++m) _Pragma("unroll") for (int k = 0; k < 2; ++k) dst[m][k] = *(const PG8_LAS bf16x8*)(lds + PG8_SA(b, h) + aoff + m * 2048 + k * 1024); } while (0)
#define PG8_LDB(dst, b, h) do { _Pragma("unroll") for (int n = 0; n < 2; ++n) _Pragma("unroll") for (int k = 0; k < 2; ++k) dst[n][k] = *(const PG8_LAS bf16x8*)(lds + PG8_SB(b, h) + boff + n * 2048 + k * 1024); } while (0)
#define PG8_MMA(ai, bj, At, Bt) do { __builtin_amdgcn_s_setprio(1); _Pragma("unroll") for (int m = 0; m < 4; ++m) _Pragma("unroll") for (int n = 0; n < 2; ++n) _Pragma("unroll") for (int k = 0; k < 2; ++k) \
        acc[ai][bj][m][n] = __builtin_amdgcn_mfma_f32_16x16x32_bf16(Bt[n][k], At[m][k], acc[ai][bj][m][n], 0, 0, 0); __builtin_amdgcn_s_setprio(0); } while (0)
#define PG8_WAIT_V(n) asm volatile("s_waitcnt vmcnt(" #n ")" ::: "memory")
#define PG8_WAIT_L(n) asm volatile("s_waitcnt lgkmcnt(" #n ")" ::: "memory")
#define PG8_BAR __builtin_amdgcn_s_barrier()
#define PG8_SCHED __builtin_amdgcn_sched_barrier(0)
    Unit cur, nxt; int ui = 0;
    if (!S.next(0, cur)) return;
    f32x4 acc[2][2][4][2];
#pragma unroll
    for (int a = 0; a < 2; ++a)
#pragma unroll
        for (int b = 0; b < 2; ++b)
#pragma unroll
            for (int m = 0; m < 4; ++m)
#pragma unroll
                for (int n = 0; n < 2; ++n) acc[a][b][m][n] = (f32x4){0.f, 0.f, 0.f, 0.f};
    bf16x8 At[4][2], B0[2][2], B1[2][2];
    const char* cA = (const char*)(g.A + (size_t)cur.z * g.az) + (size_t)cur.pm * tstepA; const char* cB = (const char*)(g.Bt + (size_t)cur.z * g.bz) + (size_t)cur.pn * tstepB;
    S.a_ready(cur);
    PG8_STAGE(PG8_SB(0, 0), cB, voffB); PG8_STAGE(PG8_SB(0, 1), cB + hstepB, voffB); PG8_STAGE(PG8_SA(0, 0), cA, voffA); PG8_STAGE(PG8_SA(0, 1), cA + hstepA, voffA);
    if (wr == 1) PG8_BAR;
    PG8_WAIT_V(2); PG8_BAR;
    PG8_STAGE(PG8_SB(1, 0), cB + kstep, voffB); PG8_STAGE(PG8_SA(1, 0), cA + kstep, voffA); PG8_STAGE(PG8_SB(1, 1), cB + hstepB + kstep, voffB);
    PG8_WAIT_V(6); PG8_BAR;
    for (;;) {
        const bool has_next = S.next(ui + 1, nxt);
        const char* nA = has_next ? (const char*)(g.A + (size_t)nxt.z * g.az) + (size_t)nxt.pm * tstepA : cA; const char* nB = has_next ? (const char*)(g.Bt + (size_t)nxt.z * g.bz) + (size_t)nxt.pn * tstepB : cB;
        for (int t = 0; t < nt; t += 2) {
            const bool last = (t == nt - 2);
            const char* a1 = cA + (size_t)(t + 1) * kstep;
            const char* a2 = last ? nA : cA + (size_t)(t + 2) * kstep; const char* b2 = last ? nB : cB + (size_t)(t + 2) * kstep;
            const char* a3 = a2 + kstep; const char* b3 = b2 + kstep;
            if (last && has_next) S.a_ready(nxt);
            PG8_LDB(B0, 0, 0); PG8_LDB(B1, 0, 1); PG8_SCHED; PG8_LDA(At, 0, 0); PG8_STAGE(PG8_SA(1, 1), a1 + hstepA, voffA);
            PG8_WAIT_V(8); PG8_WAIT_L(0); PG8_BAR; PG8_MMA(0, 0, At, B0); PG8_MMA(0, 1, At, B1); PG8_BAR; PG8_SCHED;
            PG8_LDA(At, 0, 1); PG8_STAGE(PG8_SB(0, 0), b2, voffB); PG8_STAGE(PG8_SB(0, 1), b2 + hstepB, voffB); PG8_STAGE(PG8_SA(0, 0), a2, voffA);
            PG8_WAIT_V(8); PG8_WAIT_L(0); PG8_BAR; PG8_MMA(1, 0, At, B0); PG8_MMA(1, 1, At, B1); PG8_BAR; PG8_SCHED;
            PG8_LDB(B0, 1, 0); PG8_LDB(B1, 1, 1); PG8_SCHED; PG8_LDA(At, 1, 0); PG8_STAGE(PG8_SA(0, 1), a2 + hstepA, voffA);
            PG8_WAIT_V(8); PG8_WAIT_L(0); PG8_BAR; PG8_MMA(0, 0, At, B0); PG8_MMA(0, 1, At, B1); PG8_BAR; PG8_SCHED;
            PG8_LDA(At, 1, 1); PG8_STAGE(PG8_SB(1, 0), b3, voffB); PG8_STAGE(PG8_SB(1, 1), b3 + hstepB, voffB); PG8_STAGE(PG8_SA(1, 0), a3, voffA);
            PG8_WAIT_V(8); PG8_WAIT_L(0); PG8_BAR; PG8_MMA(1, 0, At, B0); PG8_MMA(1, 1, At, B1); PG8_BAR; PG8_SCHED;
        }
        if constexpr (ALIGN_EPI) { if (wr == 0) PG8_BAR; }
        E(acc, cur, wr, wc, fr, fq); S.done(cur);
        if (!has_next) break;
#pragma unroll
        for (int a = 0; a < 2; ++a)
#pragma unroll
            for (int b = 0; b < 2; ++b)
#pragma unroll
                for (int m = 0; m < 4; ++m)
#pragma unroll
                    for (int n = 0; n < 2; ++n) acc[a][b][m][n] = (f32x4){0.f, 0.f, 0.f, 0.f};
        cur = nxt; cA = nA; cB = nB; ++ui;
        if constexpr (ALIGN_EPI) { if (wr == 1) PG8_BAR; }
    }
    PG8_WAIT_V(0);
    if constexpr (!ALIGN_EPI) { if (wr == 0) PG8_BAR; }
    PG8_BAR;
#undef PG8_SA
#undef PG8_SB
#undef PG8_STAGE
#undef PG8_LDA
#undef PG8_LDB
#undef PG8_MMA
#undef PG8_WAIT_V
#undef PG8_WAIT_L
#undef PG8_BAR
#undef PG8_SCHED
}
}
#define XB_TMO      128
#define XB_XCNT(j)  (256  + 64 * (j))
#define XB_XSUB(j)  (1280 + 64 * (j))
#define XB_XGEN(j)  (2304 + 64 * (j))
#define XB_TOP      3328
#define XB_TOPGEN   3392
#define XCD_BAR_WORDS 3456
#define XB_SPIN_CAP (1u << 22)

__device__ __forceinline__ unsigned xb_ld(unsigned* p)              { return __hip_atomic_load(p, __ATOMIC_RELAXED, __HIP_MEMORY_SCOPE_AGENT); }
__device__ __forceinline__ unsigned xb_add(unsigned* p, unsigned v) { return __hip_atomic_fetch_add(p, v, __ATOMIC_RELAXED, __HIP_MEMORY_SCOPE_AGENT); }
__device__ __forceinline__ unsigned xb_xcc_id() { return (unsigned)__builtin_amdgcn_s_getreg((3 << 11) | 20) & 0xFu; }
#define XB_SPIN(cond, bar) do { unsigned _sp = 0; while (cond) { __builtin_amdgcn_s_sleep(1); \
    if ((++_sp & 255u) == 0u) { if (xb_ld(&(bar)[XB_TMO])) break; if (_sp > XB_SPIN_CAP) { atomicAdd(&(bar)[XB_TMO], 1u); break; } } } } while (0)

struct XcdBarrier {
    unsigned* bar; unsigned x;
    volatile LAS unsigned* st;
};

__device__ __forceinline__ XcdBarrier xcd_barrier_post(unsigned* bar, volatile LAS unsigned* st) {
    XcdBarrier b; b.bar = bar; b.x = xb_xcc_id(); b.st = st;
    if (threadIdx.x == 0) (void)xb_add(&bar[XB_XCNT(b.x)], 1u);
    return b;
}
__device__ __forceinline__ void xcd_barrier_complete(unsigned* bar, unsigned x, unsigned& nloc, unsigned& nx) {
    const unsigned G = gridDim.x * gridDim.y * gridDim.z;
    unsigned sum, cnt, mine, sp = 0u;
    for (;;) {
        sum = 0u; cnt = 0u; mine = 0u;
#pragma unroll
        for (unsigned j = 0; j < 16; ++j) { const unsigned c = xb_ld(&bar[XB_XCNT(j)]); sum += c; cnt += (c > 0u) ? 1u : 0u; mine = (j == x) ? c : mine; }
        if (sum == G) break;
        __builtin_amdgcn_s_sleep(1);
        if ((++sp & 255u) == 0u) { if (xb_ld(&bar[XB_TMO])) break; if (sp > XB_SPIN_CAP) { atomicAdd(&bar[XB_TMO], 1u); break; } }
    }
    nloc = mine > 0u ? mine : 1u; nx = cnt > 0u ? cnt : 1u;
}

__device__ __forceinline__ void xcd_barrier(const XcdBarrier& b) {
    asm volatile("s_waitcnt vmcnt(0)" ::: "memory");
    __syncthreads();
    if (threadIdx.x == 0) {
        unsigned* bar = b.bar;
        __builtin_amdgcn_s_waitcnt(0);
        unsigned nloc = b.st[0], nx = b.st[1];
        if (nloc == 0u) { xcd_barrier_complete(bar, b.x, nloc, nx); b.st[0] = nloc; b.st[1] = nx; }
        const unsigned old = xb_add(&bar[XB_XSUB(b.x)], 1u);
        const unsigned gen = old / nloc;
        if (old + 1u == (gen + 1u) * nloc) {
            __builtin_amdgcn_fence(__ATOMIC_RELEASE, "agent");
            asm volatile("s_waitcnt vmcnt(0)" ::: "memory");
            const unsigned og = xb_add(&bar[XB_TOP], 1u);
            const unsigned tg = og / nx;
            if (og + 1u == (tg + 1u) * nx) xb_add(&bar[XB_TOPGEN], 1u);
            else XB_SPIN(xb_ld(&bar[XB_TOPGEN]) == tg, bar);
            __builtin_amdgcn_fence(__ATOMIC_ACQUIRE, "agent");
            xb_add(&bar[XB_XGEN(b.x)], 1u);
            asm volatile("s_waitcnt vmcnt(0)" ::: "memory");
        } else {
            XB_SPIN(xb_ld(&bar[XB_XGEN(b.x)]) == gen, bar);
            __builtin_amdgcn_fence(__ATOMIC_ACQUIRE, "agent");
            asm volatile("s_waitcnt vmcnt(0)" ::: "memory");
        }
    }
    __syncthreads();
}

struct Args { const float* in[23]; float* out; unsigned char* ws; int ph_lo, ph_hi; };
struct Frame {
    LAS unsigned char* lds;
    volatile LAS unsigned* MISC;
    gu32* ctl;
    int tid, lane, wave, bid, G, gw, NGW;
    const int* pos; float* out; unsigned char* ws;
};
__device__ __forceinline__ void fresh(Frame& F, const Args& args) {
    int t = threadIdx.x; asm volatile("; fresh tid" : "+v"(t)); int b = blockIdx.x; asm volatile("; fresh bid" : "+s"(b));
    unsigned char* w = args.ws; asm volatile("; fresh ws" : "+s"(w));
    F.tid = t; F.lane = t & 63; F.wave = __builtin_amdgcn_readfirstlane(t >> 6); F.bid = b; F.gw = b * NWAVES + F.wave; F.ws = w; F.ctl = (gu32*)(w + WS_CTL);
}
#define WSP(T, off) ((T*)(F.ws + (off)))
#define WLP(T, l, off) ((T*)(F.ws + WS_W + (size_t)(l) * WL_STRIDE + (off)))
enum { IN_X = 0, IN_C, IN_POS, IN_WADA, IN_BADA, IN_WIN, IN_QNORM, IN_KVNORM, IN_WUQ, IN_WUKV, IN_DLAM, IN_DSUB, IN_CW1, IN_CB1, IN_CW2, IN_WBR, IN_WOUT, IN_LN1G, IN_LN1B, IN_WFF1, IN_WFF2, IN_LN2G, IN_LN2B };

template <class Map>
__device__ __forceinline__ void transpose_item(const float* W, int K, int Nsrc, bf16_t* WT, int Ndst, const Map& map, const float* rowscale, LAS float* scr, int item, int lane) {
    const int nblk = Ndst / 32, kb = item / nblk, nb = item % nblk, k0 = 64 * kb, n0 = 32 * nb;
    const int ns = map(n0 + (lane & 31));
#pragma unroll 8
    for (int i = 0; i < 32; ++i) { const int kk = 2 * i + (lane >> 5); float v = 0.f;
        if (ns >= 0) { v = W[(size_t)(k0 + kk) * Nsrc + ns]; if (rowscale) v *= rowscale[k0 + kk]; }
        scr[kk * 33 + (lane & 31)] = v; }
    LDS_WAIT(); asm volatile("" ::: "memory");
    const int c = lane & 7;
#pragma unroll
    for (int j = 0; j < 4; ++j) { const int n = (lane >> 3) + 8 * j; const LAS float* s = scr + (8 * c) * 33 + n;
        u32x4 o; o.x = pk2(s[0 * 33], s[1 * 33]); o.y = pk2(s[2 * 33], s[3 * 33]); o.z = pk2(s[4 * 33], s[5 * 33]); o.w = pk2(s[6 * 33], s[7 * 33]);
        *(GAS u32x4*)(WT + (size_t)(n0 + n) * K + k0 + 8 * c) = o; }
    LDS_WAIT(); asm volatile("" ::: "memory");
}
struct MapId { __device__ __forceinline__ int operator()(int n) const { return n; } };
struct MapZ { __device__ __forceinline__ int operator()(int n) const { return zsrc(n); } };
template <class Map>
__device__ __forceinline__ void transpose_all(Frame& F, const float* W, int K, int Nsrc, bf16_t* WT, int Ndst, const Map& map, const float* rowscale, int& rot) {
    LAS float* scr = (LAS float*)(F.lds + F.wave * 16384);
    const int nitems = (K / 64) * (Ndst / 32);
    int start = F.gw - rot; start %= F.NGW; if (start < 0) start += F.NGW;
    for (int it = start; it < nitems; it += F.NGW) transpose_item(W, K, Nsrc, WT, Ndst, map, rowscale, scr, it, F.lane);
    rot = (rot + nitems) % F.NGW;
}
__device__ __forceinline__ void p0_prologue(Frame& F, const Args& args) {
    int rot = 0;
    for (int l = 0; l < NL; ++l) {
        transpose_all(F, args.in[IN_WIN] + (size_t)l * D * DIN_SRC, D, DIN_SRC, WLP(bf16_t, l, WL_IN), LDZ, MapZ(), nullptr, rot);
        transpose_all(F, args.in[IN_WFF1] + (size_t)l * D * FF, D, FF, WLP(bf16_t, l, WL_FF1), FF, MapId(), nullptr, rot);
        transpose_all(F, args.in[IN_WFF2] + (size_t)l * FF * D, FF, D, WLP(bf16_t, l, WL_FF2), D, MapId(), nullptr, rot);
        for (int n = 0; n < 3; ++n)
            transpose_all(F, args.in[IN_WBR] + ((size_t)l * 3 + n) * 1024 * D, 1024, D, WLP(bf16_t, l, WL_BR) + (size_t)n * D * 1024, D, MapId(), nullptr, rot);
        transpose_all(F, args.in[IN_WOUT] + (size_t)l * D * D, D, D, WLP(bf16_t, l, WL_OUT), D, MapId(), nullptr, rot);
        transpose_all(F, args.in[IN_WUQ] + (size_t)l * 512 * 1536, 512, 1536, WLP(bf16_t, l, WL_UQ), 1536, MapId(), args.in[IN_QNORM] + l * 512, rot);
        transpose_all(F, args.in[IN_WUKV] + (size_t)l * 256 * 2048, 256, 2048, WLP(bf16_t, l, WL_UKV), 2048, MapId(), args.in[IN_KVNORM] + l * 256, rot);
    }
    __syncthreads();
    { float* rc = WSP(float, WS_ROPE); float* rs = rc + (size_t)S * 32;
      for (int idx = F.bid * NTHREADS + F.tid; idx < S * 32; idx += F.G * NTHREADS) { const int s = idx >> 5, i = idx & 31;
          const float inv = powf(10000.0f, -(float)(2 * i) / 64.0f); const float ang = (float)F.pos[s] * inv; rc[idx] = cosf(ang); rs[idx] = sinf(ang); } }
    { LAS float* cact = (LAS float*)F.lds; LAS float* red = cact + 2048;
      for (int k = F.tid; k < D; k += NTHREADS) { const float cv = args.in[IN_C][k]; cact[k] = cv / (1.f + __expf(-cv)); }
      __syncthreads();
      for (int job = F.bid; job < NL * 48; job += F.G) { const int l = job / 48, col0 = (job % 48) * 256;
          const float* wp = args.in[IN_WADA] + (size_t)l * D * (6 * D) + col0 + 4 * F.lane;
          f32x4 a = {0.f, 0.f, 0.f, 0.f};
          const int kbeg = F.wave * 256;
#pragma unroll 8
          for (int k = 0; k < 256; ++k) { const f32x4 w = *(const f32x4*)(wp + (size_t)(kbeg + k) * (6 * D)); a += w * cact[kbeg + k]; }
          *(LAS f32x4*)(red + F.wave * 256 + 4 * F.lane) = a;
          __syncthreads();
          if (F.tid < 256) { float s = args.in[IN_BADA][(size_t)l * 6 * D + col0 + F.tid];
#pragma unroll
              for (int w = 0; w < 8; ++w) s += red[w * 256 + F.tid];
              WSP(float, WS_MOD)[(size_t)l * 6 * D + col0 + F.tid] = s; }
          __syncthreads(); } }
}

__device__ __forceinline__ void ln_rows(Frame& F, const float* src, bool do_ln, const float* g, const float* b, float* xout, bool do_mod, const float* shift, const float* scale, bf16_t* hout, float* ssq_zero) {
    for (int row = F.gw; row < S; row += F.NGW) {
        const GAS f32x4* xr = (const GAS f32x4*)(src + (size_t)row * D) + F.lane;
        f32x4 v[8]; float s = 0.f;
#pragma unroll
        for (int j = 0; j < 8; ++j) { v[j] = xr[64 * j]; s += (v[j][0] + v[j][1]) + (v[j][2] + v[j][3]); }
        if (do_ln) {
            const float mean = wave_sum(s) * (1.f / D); float s2 = 0.f;
#pragma unroll
            for (int j = 0; j < 8; ++j) { v[j] = v[j] - mean; s2 += (v[j][0] * v[j][0] + v[j][1] * v[j][1]) + (v[j][2] * v[j][2] + v[j][3] * v[j][3]); }
            const float rstd = 1.f / sqrtf(wave_sum(s2) * (1.f / D) + 1e-5f);
            s = 0.f;
#pragma unroll
            for (int j = 0; j < 8; ++j) { const f32x4 gg = *((const f32x4*)g + F.lane + 64 * j), bb = *((const f32x4*)b + F.lane + 64 * j);
                v[j] = v[j] * rstd * gg + bb; *((GAS f32x4*)(xout + (size_t)row * D) + F.lane + 64 * j) = v[j]; s += (v[j][0] + v[j][1]) + (v[j][2] + v[j][3]); }
        }
        if (do_mod) {
            const float mean = wave_sum(s) * (1.f / D); float s2 = 0.f;
#pragma unroll
            for (int j = 0; j < 8; ++j) { v[j] = v[j] - mean; s2 += (v[j][0] * v[j][0] + v[j][1] * v[j][1]) + (v[j][2] * v[j][2] + v[j][3] * v[j][3]); }
            const float rstd = 1.f / sqrtf(wave_sum(s2) * (1.f / D) + 1e-5f);
#pragma unroll
            for (int j = 0; j < 8; ++j) { const f32x4 sc = *((const f32x4*)scale + F.lane + 64 * j), sh = *((const f32x4*)shift + F.lane + 64 * j);
                const f32x4 h = v[j] * rstd * (sc + 1.0f) + sh;
                u32x2 w; w.x = pk2(h[0], h[1]); w.y = pk2(h[2], h[3]);
                *((GAS u32x2*)(hout + (size_t)row * D) + F.lane + 64 * j) = w; }
        }
        if (ssq_zero && F.lane < 2) ssq_zero[(size_t)row * 2 + F.lane] = 0.f;
    }
}

__device__ __forceinline__ void krope_job(Frame& F) {
    const bf16_t* Z = WSP(bf16_t, WS_Z); bf16_t* KR = WSP(bf16_t, WS_KROPE); const float* rc = WSP(float, WS_ROPE); const float* rs = rc + (size_t)S * 32;
    for (int idx = F.bid * NTHREADS + F.tid; idx < S * 32; idx += F.G * NTHREADS) { const int s = idx >> 5, i = idx & 31;
        const float x1 = bf1(Z[(size_t)s * LDZ + ZC_KR + i]), x2 = bf1(Z[(size_t)s * LDZ + ZC_KR + 32 + i]); const float c = rc[idx], sn = rs[idx];
        KR[(size_t)s * 64 + i] = (bf16_t)f2bf(x1 * c - x2 * sn); KR[(size_t)s * 64 + 32 + i] = (bf16_t)f2bf(x1 * sn + x2 * c); }
}
__device__ __forceinline__ float gelu_tanh(float x) { const float u = 0.7978845608028654f * (x + 0.044715f * x * x * x); return 0.5f * x * (1.f + tanhf(u)); }
__device__ __forceinline__ void compress_naive(Frame& F, const Args& args, int l) {
    const bf16_t* Z = WSP(bf16_t, WS_Z); bf16_t* KC = WSP(bf16_t, WS_KCMP);
    LAS float* hs = (LAS float*)(F.lds + F.wave * 4096);
    for (int item = F.gw; item < 4 * 128; item += F.NGW) { const int inst = item >> 7, kv = inst >> 1, g = inst & 1, n0 = (item & 127) * 4;
        const float* w1 = args.in[IN_CW1] + ((size_t)l * 2 + kv) * 4096 * 128; const float* b1 = args.in[IN_CB1] + ((size_t)l * 2 + kv) * 128; const float* w2 = args.in[IN_CW2] + ((size_t)l * 2 + kv) * 128 * 128;
        const int zc = ZC_NKV + ((0 * 2 + kv) * 2 + g) * 128;
        float a[4][2];
#pragma unroll
        for (int r = 0; r < 4; ++r) { a[r][0] = 0.f; a[r][1] = 0.f; }
        for (int k = 0; k < 4096; ++k) { const int t = k >> 7, d = k & 127; const f32x2 w = *(const f32x2*)(w1 + (size_t)k * 128 + 2 * F.lane);
#pragma unroll
            for (int r = 0; r < 4; ++r) { int tok = 16 * (n0 + r) + t; tok = tok < S ? tok : S - 1; const float xv = bf1(Z[(size_t)tok * LDZ + zc + d]); a[r][0] += xv * w[0]; a[r][1] += xv * w[1]; } }
        const f32x2 bb = *(const f32x2*)(b1 + 2 * F.lane);
#pragma unroll
        for (int r = 0; r < 4; ++r) { hs[r * 128 + 2 * F.lane] = gelu_tanh(a[r][0] + bb[0]); hs[r * 128 + 2 * F.lane + 1] = gelu_tanh(a[r][1] + bb[1]); }
        LDS_WAIT(); asm volatile("" ::: "memory");
        float o[4][2];
#pragma unroll
        for (int r = 0; r < 4; ++r) { o[r][0] = 0.f; o[r][1] = 0.f; }
        for (int j = 0; j < 128; ++j) { const f32x2 w = *(const f32x2*)(w2 + (size_t)j * 128 + 2 * F.lane);
#pragma unroll
            for (int r = 0; r < 4; ++r) { const float hv = hs[r * 128 + j]; o[r][0] += hv * w[0]; o[r][1] += hv * w[1]; } }
#pragma unroll
        for (int r = 0; r < 4; ++r) { const int n = n0 + r; const unsigned pk = (n < 511) ? pk2(o[r][0], o[r][1]) : 0u;
            *(unsigned*)(KC + (((size_t)kv * 2 + g) * 512 + n) * 128 + 2 * F.lane) = pk; }
        LDS_WAIT(); asm volatile("" ::: "memory");
    }
}

__device__ __forceinline__ float dotrow(const LAS float* q, const bf16_t* k, int n8) {
    float a = 0.f;
    for (int i = 0; i < n8; ++i) { const u32x4 w = *(const u32x4*)(k + 8 * i); const LAS f32x4* qq = (const LAS f32x4*)(q + 8 * i); const f32x4 q0 = qq[0], q1 = qq[1];
        a += q0[0] * bflo(w.x) + q0[1] * bfhi(w.x) + q0[2] * bflo(w.y) + q0[3] * bfhi(w.y) + q1[0] * bflo(w.z) + q1[1] * bfhi(w.z) + q1[2] * bflo(w.w) + q1[3] * bfhi(w.w); }
    return a;
}
__device__ __forceinline__ void naive_update(float& m, float& l, float& o0, float& o1, float s, const bf16_t* vrow0, size_t vstride) {
    const float mn = fmaxf(m, wave_max(s)); const float alpha = __expf(m - mn); const float p = __expf(s - mn);
    l = l * alpha + wave_sum(p); o0 *= alpha; o1 *= alpha; m = mn;
    for (int kk = 0; kk < 64; ++kk) { const float pk = __builtin_bit_cast(float, __builtin_amdgcn_readlane(__builtin_bit_cast(int, p), kk));
        if (pk != 0.f) { const unsigned v = *(const unsigned*)(vrow0 + (size_t)kk * vstride); o0 += pk * bflo(v); o1 += pk * bfhi(v); } }
}
__device__ __forceinline__ void pv_norm(float& o0, float& o1, float p, const bf16_t* vrow0, size_t vstride) {
    for (int kk = 0; kk < 64; ++kk) { const float pk = __builtin_bit_cast(float, __builtin_amdgcn_readlane(__builtin_bit_cast(int, p), kk));
        if (pk != 0.f) { const unsigned v = *(const unsigned*)(vrow0 + (size_t)kk * vstride); o0 += pk * bflo(v); o1 += pk * bfhi(v); } }
}
#define WAVE_LDS_SYNC() do { LDS_WAIT(); __builtin_amdgcn_wave_barrier(); asm volatile("" ::: "memory"); } while (0)
constexpr float NEG_INF = -__builtin_inff();

__device__ __forceinline__ void attn_naive(Frame& F, const Args& args, int l) {
    const bf16_t* Z = WSP(bf16_t, WS_Z); const bf16_t* QM = WSP(bf16_t, WS_QM); const bf16_t* KVM = WSP(bf16_t, WS_KVM); const bf16_t* KR = WSP(bf16_t, WS_KROPE);
    const bf16_t* KC = WSP(bf16_t, WS_KCMP); bf16_t* BR = WSP(bf16_t, WS_BR);
    const float* rc = WSP(float, WS_ROPE); const float* rs = rc + (size_t)S * 32;
    LAS float* wq = (LAS float*)(F.lds + F.wave * 2048);
    LAS float* wimp = wq + 256;
    const int lane = F.lane;
    const float* lp = args.in[IN_DLAM] + (size_t)l * 256;
    const float lam_init = 0.8f - 0.6f * expf(-0.3f * (float)l);
    const float lam = expf(wave_sum(lp[lane] * lp[64 + lane])) - expf(wave_sum(lp[128 + lane] * lp[192 + lane])) + lam_init;
    for (int item = F.gw; item < S * 8; item += F.NGW) { const int q = item >> 3, h = item & 7;
        { const float sc = 0.07216878364870322f;
          const bf16_t* qr = QM + (size_t)q * 1536 + h * 192;
          wq[lane] = bf1(qr[lane]) * sc; wq[64 + lane] = bf1(qr[64 + lane]) * sc;
          const int i = lane & 31; const float x1 = bf1(qr[128 + i]), x2 = bf1(qr[160 + i]), c = rc[(size_t)q * 32 + i], sn = rs[(size_t)q * 32 + i];
          wq[128 + lane] = (lane < 32 ? x1 * c - x2 * sn : x1 * sn + x2 * c) * sc; }
        WAVE_LDS_SYNC();
        float m = -1e30f, ls = 0.f, o0 = 0.f, o1 = 0.f;
        for (int kb = 0; kb <= q; kb += 64) { const int key = kb + lane; float s = NEG_INF;
            if (key <= q) s = dotrow(wq, KVM + (size_t)key * 2048 + h * 256, 16) + dotrow(wq + 128, KR + (size_t)key * 64, 8);
            naive_update(m, ls, o0, o1, s, KVM + (size_t)kb * 2048 + h * 256 + 128 + 2 * lane, 2048); }
        const float inv = ls > 0.f ? 1.f / ls : 0.f;
        *(unsigned*)(BR + (size_t)q * 3072 + h * 128 + 2 * lane) = pk2(o0 * inv, o1 * inv);
        WAVE_LDS_SYNC();
    }
    for (int item = F.gw; item < S * 8; item += F.NGW) { const int q = item >> 3, h = item & 7;
        const float slope = exp2f(-0.5f * (float)(2 * h + 1)); const float pq = (float)F.pos[q];
        float r0[2], r1[2];
#pragma unroll
        for (int mp = 0; mp < 2; ++mp) {
            wq[lane] = bf1(Z[(size_t)q * LDZ + ZC_DQ + h * 128 + mp * 64 + lane]) * 0.125f;
            WAVE_LDS_SYNC();
            float m = -1e30f, ls = 0.f, o0 = 0.f, o1 = 0.f;
            for (int kb = 0; kb <= q; kb += 64) { const int key = kb + lane; float s = NEG_INF;
                if (key <= q) s = dotrow(wq, Z + (size_t)key * LDZ + ZC_DK + h * 128 + mp * 64, 8) - slope * fabsf(pq - (float)F.pos[key]);
                naive_update(m, ls, o0, o1, s, Z + (size_t)kb * LDZ + ZC_DV + h * 128 + 2 * lane, LDZ); }
            const float inv = ls > 0.f ? 1.f / ls : 0.f; r0[mp] = o0 * inv; r1[mp] = o1 * inv;
            WAVE_LDS_SYNC();
        }
        const float a0 = r0[0] - lam * r0[1], a1 = r1[0] - lam * r1[1];
        const float rr = 1.f / sqrtf(wave_sum(a0 * a0 + a1 * a1) * (1.f / 128.f) + 1e-6f);
        const float* gs = args.in[IN_DSUB] + (size_t)l * 128;
        *(unsigned*)(BR + (size_t)q * 3072 + 1024 + h * 128 + 2 * lane) = pk2(a0 * rr * gs[2 * lane] * (1.f - lam_init), a1 * rr * gs[2 * lane + 1] * (1.f - lam_init));
    }
    for (int item = F.gw; item < S * 2; item += F.NGW) { const int q = item >> 1, g = item & 1;
        const float pq = (float)F.pos[q]; const int cur = q >> 6; const int ncmp = q >= 31 ? ((q - 31) >> 4) + 1 : 0;
        const float sc = 0.08838834764831845f;
        wimp[lane] = 0.f; wimp[64 + lane] = 0.f;
        float oc0[4], oc1[4];
#pragma unroll
        for (int r = 0; r < 4; ++r) { const int hh = 4 * g + r; const float slope = exp2f(-(float)(hh + 1));
            const bf16_t* qr = Z + (size_t)q * LDZ + ZC_NQ + hh * 128; wq[lane] = bf1(qr[lane]) * sc; wq[64 + lane] = bf1(qr[64 + lane]) * sc;
            WAVE_LDS_SYNC();
            const bf16_t* kc = KC + ((size_t)(0 * 2 + g) * 512) * 128; const bf16_t* vc = KC + ((size_t)(1 * 2 + g) * 512) * 128;
            float m = -1e30f, ls = 0.f;
            for (int nb = 0; nb < ncmp; nb += 64) { const int n = nb + lane; float s = NEG_INF;
                if (n < ncmp) s = dotrow(wq, kc + (size_t)n * 128, 16) - slope * fabsf(pq - (float)F.pos[31 + 16 * n]);
                const float mn = fmaxf(m, wave_max(s)); ls = ls * __expf(m - mn) + wave_sum(__expf(s - mn)); m = mn; }
            const float inv = ls > 0.f ? 1.f / ls : 0.f; float o0 = 0.f, o1 = 0.f;
            for (int nb = 0; nb < ncmp; nb += 64) { const int n = nb + lane; float p = 0.f;
                if (n < ncmp) { const float s = dotrow(wq, kc + (size_t)n * 128, 16) - slope * fabsf(pq - (float)F.pos[31 + 16 * n]); p = __expf(s - m) * inv;
                    atomicAdd((float*)(wimp + (n >> 2)), p); if ((n & 3) == 3) atomicAdd((float*)(wimp + (n >> 2) + 1), p); }
                pv_norm(o0, o1, p, vc + (size_t)nb * 128 + 2 * lane, 128); }
            oc0[r] = o0; oc1[r] = o1;
            WAVE_LDS_SYNC();
        }
        unsigned long long mlo, mhi;
        { float v0, v1; { const int j0 = lane, j1 = lane + 64;
              v0 = (j0 == 0 || j0 == cur || j0 == cur - 1) ? __builtin_inff() : (j0 <= cur ? wimp[j0] : NEG_INF);
              v1 = (j1 == cur || j1 == cur - 1) ? __builtin_inff() : (j1 <= cur ? wimp[j1] : NEG_INF); }
          int c0 = 0, c1 = 0;
          for (int k = 0; k < 128; ++k) { const float vk = (k == 0 || k == cur || k == cur - 1) ? __builtin_inff() : (k <= cur ? wimp[k] : NEG_INF);
              c0 += (vk > v0 || (vk == v0 && k < lane)) ? 1 : 0; c1 += (vk > v1 || (vk == v1 && k < lane + 64)) ? 1 : 0; }
          mlo = __ballot(c0 < 16 && v0 > NEG_INF); mhi = __ballot(c1 < 16 && v1 > NEG_INF); }
        WAVE_LDS_SYNC();
#pragma unroll
        for (int r = 0; r < 4; ++r) { const int hh = 4 * g + r; const float slope = exp2f(-(float)(hh + 1));
            const bf16_t* qr = Z + (size_t)q * LDZ + ZC_NQ + hh * 128; wq[lane] = bf1(qr[lane]) * sc; wq[64 + lane] = bf1(qr[64 + lane]) * sc;
            WAVE_LDS_SYNC();
            const bf16_t* ks = Z + ZC_NKV + ((1 * 2 + 0) * 2 + g) * 128; const bf16_t* vs = Z + ZC_NKV + ((1 * 2 + 1) * 2 + g) * 128;
            float m = -1e30f, ls = 0.f, o0 = 0.f, o1 = 0.f;
            for (int j = 0; j < 128; ++j) { const bool on = j < 64 ? ((mlo >> j) & 1ull) : ((mhi >> (j - 64)) & 1ull); if (!on) continue;
                const int key = 64 * j + lane; float s = NEG_INF;
                if (key <= q) s = dotrow(wq, ks + (size_t)key * LDZ, 16) - slope * fabsf(pq - (float)F.pos[key]);
                naive_update(m, ls, o0, o1, s, vs + (size_t)(64 * j) * LDZ + 2 * lane, LDZ); }
            const float is = ls > 0.f ? 1.f / ls : 0.f; const float os0 = o0 * is, os1 = o1 * is;
            const bf16_t* kw = Z + ZC_NKV + ((2 * 2 + 0) * 2 + g) * 128; const bf16_t* vw = Z + ZC_NKV + ((2 * 2 + 1) * 2 + g) * 128;
            m = -1e30f; ls = 0.f; o0 = 0.f; o1 = 0.f;
            int kb0 = q - 511; kb0 = kb0 < 0 ? 0 : (kb0 & ~63);
            for (int kb = kb0; kb <= q; kb += 64) { const int key = kb + lane; float s = NEG_INF;
                if (key <= q && key > q - 512) s = dotrow(wq, kw + (size_t)key * LDZ, 16) - slope * fabsf(pq - (float)F.pos[key]);
                naive_update(m, ls, o0, o1, s, vw + (size_t)kb * LDZ + 2 * lane, LDZ); }
            const float iw = ls > 0.f ? 1.f / ls : 0.f; const float ow0 = o0 * iw, ow1 = o1 * iw;
            const bf16_t* gl = Z + (size_t)q * LDZ + ZC_NG + hh * 3;
            const float g0 = sigmoidf_(bf1(gl[0])), g1 = sigmoidf_(bf1(gl[1])), g2 = sigmoidf_(bf1(gl[2]));
            *(unsigned*)(BR + (size_t)q * 3072 + 2048 + hh * 128 + 2 * lane) = pk2(g0 * oc0[r] + g1 * os0 + g2 * ow0, g0 * oc1[r] + g1 * os1 + g2 * ow1);
            WAVE_LDS_SYNC();
        }
    }
}
#ifndef MK_N_LAUNCHES
#define MK_N_LAUNCHES 1
#endif
constexpr int NPHASE = 2 + 9 * NL;
__global__ void __launch_bounds__(NTHREADS, 2) fwd(Args args) {
    extern __shared__ __attribute__((aligned(16))) unsigned char lds[];
    Frame F;
    F.lds = (LAS unsigned char*)lds;
    F.MISC = (volatile LAS unsigned*)(F.lds + MISC_OFF);
    F.tid = threadIdx.x; F.lane = F.tid & 63; F.wave = __builtin_amdgcn_readfirstlane(F.tid >> 6);
    F.G = gridDim.x; F.bid = blockIdx.x; F.gw = blockIdx.x * NWAVES + F.wave; F.NGW = F.G * NWAVES;
    F.pos = (const int*)args.in[IN_POS]; F.out = args.out; F.ws = args.ws;
    F.ctl = (gu32*)(args.ws + WS_CTL);
    for (int u = F.tid; u < (LDS_BYTES - MISC_OFF) / 4; u += NTHREADS) ((LAS unsigned*)(F.lds + MISC_OFF))[u] = 0u;
    __syncthreads();
    const int lo = args.ph_lo, hi = args.ph_hi;
    XcdBarrier bar; bar.bar = (unsigned*)(F.ctl + CW_BAR); bar.x = 0; bar.st = F.MISC + 8;
    if (hi - lo > 1) bar = xcd_barrier_post((unsigned*)(F.ctl + CW_BAR), F.MISC + 8);
#define IN(k) (lo <= (k) && (k) < hi)
#define SEAM(k) do { if (IN(k) && IN((k) + 1)) xcd_barrier(bar); } while (0)

#define Z WSP(bf16_t, WS_Z)
#define H WSP(bf16_t, WS_H)
#define X WSP(float, WS_X)
#define Y WSP(float, WS_Y)
#define SSQ WSP(float, WS_SSQ)
#define MODL (WSP(float, WS_MOD) + (size_t)l * 6 * D)

    #ifndef SKIP_P0
    if (IN(0)) { fresh(F, args); p0_prologue(F, args); }
#endif
    SEAM(0);

    for (int l = 0; l < NL; ++l) {
        const int pb = 1 + 9 * l;
        if (IN(pb + 0)) { fresh(F, args);
            if (l == 0) ln_rows(F, args.in[IN_X], false, nullptr, nullptr, nullptr, true, MODL, MODL + D, H, SSQ);
            else ln_rows(F, Y, true, args.in[IN_LN2G] + (size_t)(l - 1) * D, args.in[IN_LN2B] + (size_t)(l - 1) * D, X, true, MODL, MODL + D, H, SSQ);
        }
        SEAM(pb + 0);
        if (IN(pb + 1)) { fresh(F, args);
            pg8::Gemm g{H, WLP(bf16_t, l, WL_IN), D, D, D, 0, 0}; pg8::PlainOrder So; So.init(S, LDZ, F.G, F.bid);
            pg8::EpiZ E{Z, SSQ};
            pg8::gemm_phase<pg8::EpiZ, pg8::PlainOrder, true>(F.lds, g, So, E, F.tid);
        }
        SEAM(pb + 1);
        if (IN(pb + 2)) {
            { fresh(F, args); pg8::Gemm g{Z + ZC_CQ, WLP(bf16_t, l, WL_UQ), 512, LDZ, 512, 0, 0}; pg8::PlainOrder So; So.init(S, 1536, F.G, F.bid);
              pg8::EpiRs E{WSP(bf16_t, WS_QM), 1536, SSQ, 0, 1.f / 512.f};
              pg8::gemm_phase<pg8::EpiRs, pg8::PlainOrder, false>(F.lds, g, So, E, F.tid); }
            { fresh(F, args); pg8::Gemm g{Z + ZC_CKV, WLP(bf16_t, l, WL_UKV), 256, LDZ, 256, 0, 0}; pg8::PlainOrder So; So.init(S, 2048, F.G, F.bid);
              pg8::EpiRs E{WSP(bf16_t, WS_KVM), 2048, SSQ, 1, 1.f / 256.f};
              pg8::gemm_phase<pg8::EpiRs, pg8::PlainOrder, false>(F.lds, g, So, E, F.tid); }
#ifndef SKIP_SIDE
            fresh(F, args); krope_job(F);
            compress_naive(F, args, l);
#endif
        }
        SEAM(pb + 2);
#ifndef SKIP_ATTN
        if (IN(pb + 3)) { fresh(F, args); attn_naive(F, args, l); }
#endif
        SEAM(pb + 3);
        if (IN(pb + 4)) { fresh(F, args);
            pg8::Gemm g{WSP(bf16_t, WS_BR), WLP(bf16_t, l, WL_BR), 1024, 3072, 1024, 1024, (size_t)D * 1024}; pg8::SliceOrder<3> So; So.init(S, D, F.G, F.bid);
            pg8::EpiMix E{Z + ZC_MG, WSP(float, WS_MIX), WSP(bf16_t, WS_MIXB)};
            pg8::gemm_phase<pg8::EpiMix, pg8::SliceOrder<3>, true>(F.lds, g, So, E, F.tid);
        }
        SEAM(pb + 4);
        if (IN(pb + 5)) { fresh(F, args);
            pg8::Gemm g{WSP(bf16_t, WS_MIXB), WLP(bf16_t, l, WL_OUT), D, D, D, 0, 0}; pg8::PlainOrder So; So.init(S, D, F.G, F.bid);
            pg8::EpiRes E{l == 0 ? args.in[IN_X] : X, MODL + 2 * D, Y};
            pg8::gemm_phase<pg8::EpiRes, pg8::PlainOrder, false>(F.lds, g, So, E, F.tid);
        }
        SEAM(pb + 5);
        if (IN(pb + 6)) { fresh(F, args); ln_rows(F, Y, true, args.in[IN_LN1G] + (size_t)l * D, args.in[IN_LN1B] + (size_t)l * D, X, true, MODL + 3 * D, MODL + 4 * D, H, nullptr); }
        SEAM(pb + 6);
        if (IN(pb + 7)) { fresh(F, args);
            pg8::Gemm g{H, WLP(bf16_t, l, WL_FF1), D, D, D, 0, 0}; pg8::PlainOrder So; So.init(S, FF, F.G, F.bid);
            pg8::EpiRelu2 E{Z  , FF};
            pg8::gemm_phase<pg8::EpiRelu2, pg8::PlainOrder, true>(F.lds, g, So, E, F.tid);
        }
        SEAM(pb + 7);
        if (IN(pb + 8)) { fresh(F, args);
            pg8::Gemm g{Z, WLP(bf16_t, l, WL_FF2), FF, FF, FF, 0, 0}; pg8::PlainOrder So; So.init(S, D, F.G, F.bid);
            pg8::EpiRes E{X, MODL + 5 * D, Y};
            pg8::gemm_phase<pg8::EpiRes, pg8::PlainOrder, false>(F.lds, g, So, E, F.tid);
        }
        SEAM(pb + 8);
    }
    if (IN(NPHASE - 1)) { fresh(F, args); ln_rows(F, Y, true, args.in[IN_LN2G] + (size_t)(NL - 1) * D, args.in[IN_LN2B] + (size_t)(NL - 1) * D, F.out, false, nullptr, nullptr, nullptr, nullptr); }
#undef IN
#undef SEAM
#undef Z
#undef H
#undef X
#undef Y
#undef SSQ
#undef MODL
}

extern "C" void kernel_launch(void* const* d_in, const int* in_sizes, int n_in, void* d_out, int out_size, void* d_ws, size_t ws_size, hipStream_t stream) {
    static int grid = 0;
    if (grid == 0) {
        if (n_in != 23 || in_sizes[0] != S * D || out_size != S * D || ws_size < WS_END) {
            fprintf(stderr, "kernel_launch: shape mismatch: n_in %d in0 %d out %d ws %zu (need %zu)\n", n_in, n_in > 0 ? in_sizes[0] : -1, out_size, ws_size, (size_t)WS_END); grid = -1; return; }
        int dev = 0, cus = 0, per_cu = 0;
        if (hipGetDevice(&dev) != hipSuccess || hipDeviceGetAttribute(&cus, hipDeviceAttributeMultiprocessorCount, dev) != hipSuccess) { fprintf(stderr, "kernel_launch: device query failed\n"); grid = -1; return; }
        if (hipFuncSetAttribute((const void*)fwd, hipFuncAttributeMaxDynamicSharedMemorySize, LDS_BYTES) != hipSuccess) { fprintf(stderr, "kernel_launch: hipFuncSetAttribute failed\n"); grid = -1; return; }
        if (hipOccupancyMaxActiveBlocksPerMultiprocessor(&per_cu, (const void*)fwd, NTHREADS, LDS_BYTES) != hipSuccess || per_cu < 1) { fprintf(stderr, "kernel_launch: occupancy query says %d\n", per_cu); }
        (void)hipGetLastError();
        grid = cus;
    }
    if (grid < 0) return;
    if (hipMemsetAsync((char*)d_ws + WS_CTL, 0, CTL_ZERO_BYTES, stream) != hipSuccess) { fprintf(stderr, "kernel_launch: memset failed\n"); return; }
    Args a{};
    for (int i = 0; i < 23; ++i) a.in[i] = (const float*)d_in[i];
    a.out = (float*)d_out; a.ws = (unsigned char*)d_ws;
#if MK_N_LAUNCHES == 1
    a.ph_lo = 0; a.ph_hi = NPHASE;
    hipLaunchKernelGGL(fwd, dim3(grid), dim3(NTHREADS), LDS_BYTES, stream, a);
#else
    for (int p = 0; p < NPHASE; ++p) { a.ph_lo = p; a.ph_hi = p + 1; hipLaunchKernelGGL(fwd, dim3(grid), dim3(NTHREADS), LDS_BYTES, stream, a); }
#endif
    const hipError_t le = hipPeekAtLastError();
    if (le != hipSuccess) fprintf(stderr, "kernel_launch: launch failed: %s\n", hipGetErrorName(le));
}
```

```cpp
#include <hip/hip_runtime.h>
#include <cstdio>
#include <cstdint>

#define LAS __attribute__((address_space(3)))
#define GAS __attribute__((address_space(1)))
typedef unsigned short bf16_t;
typedef short bf16x8 __attribute__((ext_vector_type(8)));
typedef short s16x4 __attribute__((ext_vector_type(4)));
typedef float f32x4 __attribute__((ext_vector_type(4)));
typedef float f32x2 __attribute__((ext_vector_type(2)));
typedef float f32x16 __attribute__((ext_vector_type(16)));
typedef unsigned u32x4 __attribute__((ext_vector_type(4)));
typedef unsigned u32x2 __attribute__((ext_vector_type(2)));
typedef GAS unsigned gu32;

constexpr int S = 8192, D = 2048, NL = 4, FF = 8192;
constexpr int LDZ = 12800;
constexpr int ZC_CQ = 0, ZC_CKV = 512, ZC_DQ = 768, ZC_DK = 1792, ZC_DV = 2816, ZC_NQ = 3840, ZC_NKV = 4864, ZC_MG = 6400, ZC_KR = 12544, ZC_NG = 12608;
constexpr int DIN_SRC = 12632;
constexpr float ALPHA_RES = 1.6817928305074292f;
constexpr int NWAVES = 8, NTHREADS = 512;

__host__ __device__ __forceinline__ int zsrc(int n) {
    if (n < 768) return n;
    if (n < 6400) return n + 64;
    if (n < 12544) return n + 88;
    if (n < 12608) return n - 12544 + 768;
    if (n < 12632) return n - 12608 + 6464;
    return -1;
}

constexpr size_t MiB = 1u << 20;
constexpr size_t WS_CTL = 0, CTL_ZERO_BYTES = 1 * MiB;
constexpr size_t WS_MOD = 1 * MiB;
constexpr size_t WS_ROPE = 2 * MiB;
constexpr size_t WS_SSQ = 4 * MiB;
constexpr size_t WS_KCMP = 5 * MiB;
constexpr size_t WS_KROPE = 6 * MiB;
constexpr size_t WS_X = 8 * MiB;
constexpr size_t WS_Y = 72 * MiB;
constexpr size_t WS_MIX = 136 * MiB;
constexpr size_t WS_H = 200 * MiB;
constexpr size_t WS_MIXB = 232 * MiB;
constexpr size_t WS_QM = 264 * MiB;
constexpr size_t WS_KVM = 288 * MiB;
constexpr size_t WS_BR = 320 * MiB;
constexpr size_t WS_Z = 368 * MiB;
constexpr size_t WS_W = 568 * MiB;
constexpr size_t WL_STRIDE = 140 * MiB;
constexpr size_t WL_IN = 0, WL_FF1 = 50 * MiB, WL_FF2 = 82 * MiB, WL_BR = 114 * MiB, WL_OUT = 126 * MiB, WL_UQ = 134 * MiB, WL_UKV = 136 * MiB, WL_C1 = 137 * MiB, WL_C2 = 139 * MiB;
constexpr size_t WS_END = WS_W + NL * WL_STRIDE;

constexpr int CW_BAR = 4096;
constexpr int CW_QUEUE = 16384;

constexpr int RING_BYTES = 131072;
constexpr int MISC_OFF = RING_BYTES;
constexpr int LDS_BYTES = RING_BYTES + 1024;

#define RLX_AGENT __ATOMIC_RELAXED, __HIP_MEMORY_SCOPE_AGENT
#define LDS_WAIT() asm volatile("s_waitcnt lgkmcnt(0)" ::: "memory")
#define VM_WAIT() asm volatile("s_waitcnt vmcnt(0)" ::: "memory")
__device__ __forceinline__ unsigned f2bf(float f) { unsigned u = __builtin_bit_cast(unsigned, f); return (u + 0x7fffu + ((u >> 16) & 1u)) >> 16; }
__device__ __forceinline__ unsigned pk2(float lo, float hi) { return f2bf(lo) | (f2bf(hi) << 16); }
__device__ __forceinline__ float bflo(unsigned w) { return __builtin_bit_cast(float, w << 16); }
__device__ __forceinline__ float bfhi(unsigned w) { return __builtin_bit_cast(float, w & 0xffff0000u); }
__device__ __forceinline__ float bf1(bf16_t h) { return __builtin_bit_cast(float, ((unsigned)h) << 16); }
__device__ __forceinline__ float wave_sum(float v) {
#pragma unroll
    for (int o = 1; o < 64; o <<= 1) v += __shfl_xor(v, o);
    return v;
}
__device__ __forceinline__ float wave_max(float v) {
#pragma unroll
    for (int o = 1; o < 64; o <<= 1) v = fmaxf(v, __shfl_xor(v, o));
    return v;
}
__device__ __forceinline__ float sigmoidf_(float x) { return 1.f / (1.f + __expf(-x)); }
#define MK_N_LAUNCHES 1
namespace pg8 {
#define PG8_LAS __attribute__((address_space(3)))
constexpr int BM = 256, BK = 64, HALF = 128, HTB = HALF * BK * 2  , STAGE_BYTES = 8 * HTB, NXCD = 8, WGM = 8;

__host__ __device__ __forceinline__ int lds_byte(int r, int c) { const int st = (r >> 4) * 2 + (c >> 5), rr = r & 15, cc = c & 31, ob = rr * 64 + cc * 2; return st * 1024 + (ob ^ (((ob >> 9) & 1) << 5)); }
__host__ __device__ __forceinline__ void stage_rc(int b, int& R, int& C) { const int st = b / 1024, sb = b % 1024, swz = sb ^ (((sb >> 9) & 1) << 5); R = (st >> 1) * 16 + swz / 64; C = (st & 1) * 32 + (swz % 64) / 2; }
__host__ __device__ __forceinline__ int perm32(int rho) { const int n = rho >> 4, i = rho & 15; return 8 * (i >> 2) + 4 * n + (i & 3); }

struct Unit { int pm, pn, z; };
struct Gemm { const bf16_t* A; const bf16_t* Bt; int K, lda, ldb; size_t az, bz; };

__host__ __device__ __forceinline__ void tile_of(int wgid, int nM, int nN, int& pm, int& pn) {
    const int nwg = nM * nN;
    { const int q = nwg / NXCD, r = nwg % NXCD, xcd = wgid % NXCD, off = wgid / NXCD; wgid = (xcd < r ? xcd * (q + 1) : r * (q + 1) + (xcd - r) * q) + off; }
    const int nig = WGM * nN, gid = wgid / nig, fm = gid * WGM, gsz = (nM - fm) < WGM ? (nM - fm) : WGM;
    pm = fm + ((wgid % nig) % gsz); pn = (wgid % nig) / gsz;
}
struct PlainOrder {
    int nM, nN, nwg, G, c;
    __host__ __device__ void init(int M, int N, int G_, int c_) { nM = M / BM; nN = N / BM; nwg = nM * nN; G = G_; c = c_; }
    __host__ __device__ bool next(int i, Unit& u) const {
        const long L = (long)i * G + c; if (L >= nwg) return false;
        tile_of((int)L, nM, nN, u.pm, u.pn); u.z = 0; return true;
    }
    __device__ __forceinline__ void a_ready(const Unit&) const {}
    __device__ __forceinline__ void done(const Unit&) const {}
};
template <int NZ> struct SliceOrder {
    int nM, nN, nwg, G, c;
    __host__ __device__ void init(int M, int N, int G_, int c_) { nM = M / BM; nN = N / BM; nwg = nM * nN; G = G_; c = c_; }
    __host__ __device__ bool next(int i, Unit& u) const {
        const long L = (long)(i / NZ) * G + c; if (L >= nwg) return false;
        tile_of((int)L, nM, nN, u.pm, u.pn); u.z = i % NZ; return true;
    }
    __device__ __forceinline__ void a_ready(const Unit&) const {}
    __device__ __forceinline__ void done(const Unit&) const {}
};

__device__ __forceinline__ unsigned cvt_pk_bf16(float lo, float hi) { unsigned r; asm volatile("v_cvt_pk_bf16_f32 %0, %1, %2" : "=v"(r) : "v"(lo), "v"(hi)); return r; }


struct EpiZ {
    static constexpr bool PERM = true, AFTER_DRAIN = false;
    bf16_t* Z; float* ssq;
    __device__ __forceinline__ void operator()(const f32x4 (&acc)[2][2][4][2], const Unit& u, int wr, int wc, int fr, int fq) const {
        const int row0 = u.pm * BM + wr * 64 + fr, col0 = u.pn * BM + wc * 32 + 8 * fq;
#pragma unroll
        for (int ai = 0; ai < 2; ++ai)
#pragma unroll
            for (int m = 0; m < 4; ++m) { const int row = row0 + ai * HALF + m * 16; bf16_t* rowp = Z + (size_t)row * LDZ + col0; float ss = 0.f;
#pragma unroll
                for (int bj = 0; bj < 2; ++bj) { const f32x4 v0 = acc[ai][bj][m][0], v1 = acc[ai][bj][m][1];
                    ss += (v0[0] * v0[0] + v0[1] * v0[1]) + (v0[2] * v0[2] + v0[3] * v0[3]) + (v1[0] * v1[0] + v1[1] * v1[1]) + (v1[2] * v1[2] + v1[3] * v1[3]);
                    u32x4 w; w.x = cvt_pk_bf16(v0[0], v0[1]); w.y = cvt_pk_bf16(v0[2], v0[3]); w.z = cvt_pk_bf16(v1[0], v1[1]); w.w = cvt_pk_bf16(v1[2], v1[3]);
                    *(u32x4*)(rowp + bj * HALF) = w; }
                if (u.pn < 3) { ss += __shfl_xor(ss, 16); ss += __shfl_xor(ss, 32);
                    if (fq == 0) __hip_atomic_fetch_add(ssq + (size_t)row * 2 + (u.pn == 2 ? 1 : 0), ss, __ATOMIC_RELAXED, __HIP_MEMORY_SCOPE_AGENT); } }
    }
};
struct EpiRs {
    static constexpr bool PERM = true, AFTER_DRAIN = false;
    bf16_t* O; int ldc; const float* ssq; int which; float invK;
    __device__ __forceinline__ void operator()(const f32x4 (&acc)[2][2][4][2], const Unit& u, int wr, int wc, int fr, int fq) const {
        const int row0 = u.pm * BM + wr * 64 + fr, col0 = u.pn * BM + wc * 32 + 8 * fq;
#pragma unroll
        for (int ai = 0; ai < 2; ++ai)
#pragma unroll
            for (int m = 0; m < 4; ++m) { const int row = row0 + ai * HALF + m * 16; bf16_t* rowp = O + (size_t)row * ldc + col0;
                const float rs = 1.0f / sqrtf(ssq[(size_t)row * 2 + which] * invK + 1e-6f);
#pragma unroll
                for (int bj = 0; bj < 2; ++bj) { const f32x4 v0 = acc[ai][bj][m][0] * rs, v1 = acc[ai][bj][m][1] * rs;
                    u32x4 w; w.x = cvt_pk_bf16(v0[0], v0[1]); w.y = cvt_pk_bf16(v0[2], v0[3]); w.z = cvt_pk_bf16(v1[0], v1[1]); w.w = cvt_pk_bf16(v1[2], v1[3]);
                    *(u32x4*)(rowp + bj * HALF) = w; } }
    }
};
struct EpiRelu2 {
    static constexpr bool PERM = true, AFTER_DRAIN = false;
    bf16_t* O; int ldc;
    __device__ __forceinline__ void operator()(const f32x4 (&acc)[2][2][4][2], const Unit& u, int wr, int wc, int fr, int fq) const {
        const int row0 = u.pm * BM + wr * 64 + fr, col0 = u.pn * BM + wc * 32 + 8 * fq;
#pragma unroll
        for (int ai = 0; ai < 2; ++ai)
#pragma unroll
            for (int m = 0; m < 4; ++m) { bf16_t* rowp = O + (size_t)(row0 + ai * HALF + m * 16) * ldc + col0;
#pragma unroll
                for (int bj = 0; bj < 2; ++bj) { f32x4 v0 = acc[ai][bj][m][0], v1 = acc[ai][bj][m][1];
#pragma unroll
                    for (int j = 0; j < 4; ++j) { const float a = fmaxf(v0[j], 0.f), b = fmaxf(v1[j], 0.f); v0[j] = a * a; v1[j] = b * b; }
                    u32x4 w; w.x = cvt_pk_bf16(v0[0], v0[1]); w.y = cvt_pk_bf16(v0[2], v0[3]); w.z = cvt_pk_bf16(v1[0], v1[1]); w.w = cvt_pk_bf16(v1[2], v1[3]);
                    *(u32x4*)(rowp + bj * HALF) = w; } }
    }
};
struct EpiMix {
    static constexpr bool PERM = true, AFTER_DRAIN = false;
    const bf16_t* Zg; float* MIX; bf16_t* MIXB;
    __device__ __forceinline__ void operator()(const f32x4 (&acc)[2][2][4][2], const Unit& u, int wr, int wc, int fr, int fq) const {
        const int row0 = u.pm * BM + wr * 64 + fr, col0 = u.pn * BM + wc * 32 + 8 * fq;
#pragma unroll
        for (int ai = 0; ai < 2; ++ai)
#pragma unroll
            for (int m = 0; m < 4; ++m) { const int row = row0 + ai * HALF + m * 16;
#pragma unroll
                for (int bj = 0; bj < 2; ++bj) { const int col = col0 + bj * HALF;
                    const u32x4 gw = *(const u32x4*)(Zg + (size_t)row * LDZ + u.z * D + col);
                    f32x4 g0, g1; g0[0] = sigmoidf_(bflo(gw.x)); g0[1] = sigmoidf_(bfhi(gw.x)); g0[2] = sigmoidf_(bflo(gw.y)); g0[3] = sigmoidf_(bfhi(gw.y));
                    g1[0] = sigmoidf_(bflo(gw.z)); g1[1] = sigmoidf_(bfhi(gw.z)); g1[2] = sigmoidf_(bflo(gw.w)); g1[3] = sigmoidf_(bfhi(gw.w));
                    f32x4 v0 = acc[ai][bj][m][0] * g0, v1 = acc[ai][bj][m][1] * g1;
                    float* mp = MIX + (size_t)row * D + col;
                    if (u.z > 0) { v0 += *(const f32x4*)mp; v1 += *(const f32x4*)(mp + 4); }
                    if (u.z < 2) { *(f32x4*)mp = v0; *(f32x4*)(mp + 4) = v1; }
                    else { u32x4 w; w.x = cvt_pk_bf16(v0[0], v0[1]); w.y = cvt_pk_bf16(v0[2], v0[3]); w.z = cvt_pk_bf16(v1[0], v1[1]); w.w = cvt_pk_bf16(v1[2], v1[3]);
                        *(u32x4*)(MIXB + (size_t)row * D + col) = w; } } }
    }
};
struct EpiRes {
    static constexpr bool PERM = false, AFTER_DRAIN = false;
    const float* X; const float* gvec; float* Y;
    __device__ __forceinline__ void operator()(const f32x4 (&acc)[2][2][4][2], const Unit& u, int wr, int wc, int fr, int fq) const {
        const int row0 = u.pm * BM + wr * 64 + fr, col0 = u.pn * BM + wc * 32 + 4 * fq;
        f32x4 gv[2][2];
#pragma unroll
        for (int bj = 0; bj < 2; ++bj)
#pragma unroll
            for (int n = 0; n < 2; ++n) gv[bj][n] = *(const f32x4*)(gvec + col0 + bj * HALF + n * 16);
#pragma unroll
        for (int ai = 0; ai < 2; ++ai)
#pragma unroll
            for (int m = 0; m < 4; ++m) { const size_t ro = (size_t)(row0 + ai * HALF + m * 16) * D + col0;
#pragma unroll
                for (int bj = 0; bj < 2; ++bj)
#pragma unroll
                    for (int n = 0; n < 2; ++n) { const f32x4 xv = *(const f32x4*)(X + ro + bj * HALF + n * 16);
                        *(f32x4*)(Y + ro + bj * HALF + n * 16) = xv * ALPHA_RES + gv[bj][n] * acc[ai][bj][m][n]; } }
    }
};

template <class Epi, class Sched, bool ALIGN_EPI = false>
__device__ __forceinline__ void gemm_phase(PG8_LAS unsigned char* lds, const Gemm g, const Sched& S, const Epi& E, const int tid) {
    const int wid = __builtin_amdgcn_readfirstlane(tid >> 6), lane = tid & 63, wr = wid >> 2, wc = wid & 3, fr = lane & 15, fq = lane >> 4;
    const int K = g.K, nt = K / BK;
    unsigned voffA[2], voffB[2];
#pragma unroll
    for (int i = 0; i < 2; ++i) { int R, C; stage_rc(tid * 16 + i * 8192, R, C); const int Rb = Epi::PERM ? ((R & ~31) + perm32(R & 31)) : R;
        voffA[i] = (unsigned)(R * g.lda + C) * 2u; voffB[i] = (unsigned)(Rb * g.ldb + C) * 2u; }
    const size_t kstep = (size_t)(BK * 2);
    const size_t hstepA = (size_t)HALF * g.lda * 2, hstepB = (size_t)HALF * g.ldb * 2;
    const size_t tstepA = 2 * hstepA, tstepB = 2 * hstepB;
    const unsigned ldsw = (unsigned)wid * 1024u;
    const int aoff = lds_byte(wr * 64 + fr, fq * 8), boff = lds_byte(wc * 32 + fr, fq * 8);
#define PG8_SA(b, h) (((b) * 2 + (h)) * HTB)
#define PG8_SB(b, h) ((4 + (b) * 2 + (h)) * HTB)
#define PG8_STAGE(bufoff, gbase, voff) do { _Pragma("unroll") for (int _i = 0; _i < 2; ++_i) \
        __builtin_amdgcn_global_load_lds((const unsigned*)((const char*)(gbase) + (voff)[_i]), (PG8_LAS unsigned*)(lds + (bufoff) + ldsw + _i * 8192), 16, 0, 0); } while (0)
#define PG8_LDA(dst, b, h) do { _Pragma("unroll") for (int m = 0; m < 4; ++m) _Pragma("unroll") for (int k = 0; k < 2; ++k) dst[m][k] = *(const PG8_LAS bf16x8*)(lds + PG8_SA(b, h) + aoff + m * 2048 + k * 1024); } while (0)
#define PG8_LDB(dst, b, h) do { _Pragma("unroll") for (int n = 0; n < 2; ++n) _Pragma("unroll") for (int k = 0; k < 2; ++k) dst[n][k] = *(const PG8_LAS bf16x8*)(lds + PG8_SB(b, h) + boff + n * 2048 + k * 1024); } while (0)
#define PG8_MMA(ai, bj, At, Bt) do { __builtin_amdgcn_s_setprio(1); _Pragma("unroll") for (int m = 0; m < 4; ++m) _Pragma("unroll") for (int n = 0; n < 2; ++n) _Pragma("unroll") for (int k = 0; k < 2; ++k) \
        acc[ai][bj][m][n] = __builtin_amdgcn_mfma_f32_16x16x32_bf16(Bt[n][k], At[m][k], acc[ai][bj][m][n], 0, 0, 0); __builtin_amdgcn_s_setprio(0); } while (0)
#define PG8_WAIT_V(n) asm volatile("s_waitcnt vmcnt(" #n ")" ::: "memory")
#define PG8_WAIT_L(n) asm volatile("s_waitcnt lgkmcnt(" #n ")" ::: "memory")
#define PG8_BAR __builtin_amdgcn_s_barrier()
#define PG8_SCHED __builtin_amdgcn_sched_barrier(0)
    Unit cur, nxt; int ui = 0;
    if (!S.next(0, cur)) return;
    f32x4 acc[2][2][4][2];
#pragma unroll
    for (int a = 0; a < 2; ++a)
#pragma unroll
        for (int b = 0; b < 2; ++b)
#pragma unroll
            for (int m = 0; m < 4; ++m)
#pragma unroll
                for (int n = 0; n < 2; ++n) acc[a][b][m][n] = (f32x4){0.f, 0.f, 0.f, 0.f};
    bf16x8 At[4][2], B0[2][2], B1[2][2];
    const char* cA = (const char*)(g.A + (size_t)cur.z * g.az) + (size_t)cur.pm * tstepA; const char* cB = (const char*)(g.Bt + (size_t)cur.z * g.bz) + (size_t)cur.pn * tstepB;
    S.a_ready(cur);
    PG8_STAGE(PG8_SB(0, 0), cB, voffB); PG8_STAGE(PG8_SB(0, 1), cB + hstepB, voffB); PG8_STAGE(PG8_SA(0, 0), cA, voffA); PG8_STAGE(PG8_SA(0, 1), cA + hstepA, voffA);
    if (wr == 1) PG8_BAR;
    PG8_WAIT_V(2); PG8_BAR;
    PG8_STAGE(PG8_SB(1, 0), cB + kstep, voffB); PG8_STAGE(PG8_SA(1, 0), cA + kstep, voffA); PG8_STAGE(PG8_SB(1, 1), cB + hstepB + kstep, voffB);
    PG8_WAIT_V(6); PG8_BAR;
    for (;;) {
        const bool has_next = S.next(ui + 1, nxt);
        const char* nA = has_next ? (const char*)(g.A + (size_t)nxt.z * g.az) + (size_t)nxt.pm * tstepA : cA; const char* nB = has_next ? (const char*)(g.Bt + (size_t)nxt.z * g.bz) + (size_t)nxt.pn * tstepB : cB;
        for (int t = 0; t < nt; t += 2) {
            const bool last = (t == nt - 2);
            const char* a1 = cA + (size_t)(t + 1) * kstep;
            const char* a2 = last ? nA : cA + (size_t)(t + 2) * kstep; const char* b2 = last ? nB : cB + (size_t)(t + 2) * kstep;
            const char* a3 = a2 + kstep; const char* b3 = b2 + kstep;
            if (last && has_next) S.a_ready(nxt);
            PG8_LDB(B0, 0, 0); PG8_LDB(B1, 0, 1); PG8_SCHED; PG8_LDA(At, 0, 0); PG8_STAGE(PG8_SA(1, 1), a1 + hstepA, voffA);
            PG8_WAIT_V(8); PG8_WAIT_L(0); PG8_BAR; PG8_MMA(0, 0, At, B0); PG8_MMA(0, 1, At, B1); PG8_BAR; PG8_SCHED;
            PG8_LDA(At, 0, 1); PG8_STAGE(PG8_SB(0, 0), b2, voffB); PG8_STAGE(PG8_SB(0, 1), b2 + hstepB, voffB); PG8_STAGE(PG8_SA(0, 0), a2, voffA);
            PG8_WAIT_V(8); PG8_WAIT_L(0); PG8_BAR; PG8_MMA(1, 0, At, B0); PG8_MMA(1, 1, At, B1); PG8_BAR; PG8_SCHED;
            PG8_LDB(B0, 1, 0); PG8_LDB(B1, 1, 1); PG8_SCHED; PG8_LDA(At, 1, 0); PG8_STAGE(PG8_SA(0, 1), a2 + hstepA, voffA);
            PG8_WAIT_V(8); PG8_WAIT_L(0); PG8_BAR; PG8_MMA(0, 0, At, B0); PG8_MMA(0, 1, At, B1); PG8_BAR; PG8_SCHED;
            PG8_LDA(At, 1, 1); PG8_STAGE(PG8_SB(1, 0), b3, voffB); PG8_STAGE(PG8_SB(1, 1), b3 + hstepB, voffB); PG8_STAGE(PG8_SA(1, 0), a3, voffA);
            PG8_WAIT_V(8); PG8_WAIT_L(0); PG8_BAR; PG8_MMA(1, 0, At, B0); PG8_MMA(1, 1, At, B1); PG8_BAR; PG8_SCHED;
        }
        if constexpr (ALIGN_EPI) { if (wr == 0) PG8_BAR; }
        E(acc, cur, wr, wc, fr, fq); S.done(cur);
        if (!has_next) break;
#pragma unroll
        for (int a = 0; a < 2; ++a)
#pragma unroll
            for (int b = 0; b < 2; ++b)
#pragma unroll
                for (int m = 0; m < 4; ++m)
#pragma unroll
                    for (int n = 0; n < 2; ++n) acc[a][b][m][n] = (f32x4){0.f, 0.f, 0.f, 0.f};
        cur = nxt; cA = nA; cB = nB; ++ui;
        if constexpr (ALIGN_EPI) { if (wr == 1) PG8_BAR; }
    }
    PG8_WAIT_V(0);
    if constexpr (!ALIGN_EPI) { if (wr == 0) PG8_BAR; }
    PG8_BAR;
#undef PG8_SA
#undef PG8_SB
#undef PG8_STAGE
#undef PG8_LDA
#undef PG8_LDB
#undef PG8_MMA
#undef PG8_WAIT_V
#undef PG8_WAIT_L
#undef PG8_BAR
#undef PG8_SCHED
}
}
#define XB_TMO      128
#define XB_XCNT(j)  (256  + 64 * (j))
#define XB_XSUB(j)  (1280 + 64 * (j))
#define XB_XGEN(j)  (2304 + 64 * (j))
#define XB_TOP      3328
#define XB_TOPGEN   3392
#define XCD_BAR_WORDS 3456
#define XB_SPIN_CAP (1u << 22)

__device__ __forceinline__ unsigned xb_ld(unsigned* p)              { return __hip_atomic_load(p, __ATOMIC_RELAXED, __HIP_MEMORY_SCOPE_AGENT); }
__device__ __forceinline__ unsigned xb_add(unsigned* p, unsigned v) { return __hip_atomic_fetch_add(p, v, __ATOMIC_RELAXED, __HIP_MEMORY_SCOPE_AGENT); }
__device__ __forceinline__ unsigned xb_xcc_id() { return (unsigned)__builtin_amdgcn_s_getreg((3 << 11) | 20) & 0xFu; }
#define XB_SPIN(cond, bar) do { unsigned _sp = 0; while (cond) { __builtin_amdgcn_s_sleep(1); \
    if ((++_sp & 255u) == 0u) { if (xb_ld(&(bar)[XB_TMO])) break; if (_sp > XB_SPIN_CAP) { atomicAdd(&(bar)[XB_TMO], 1u); break; } } } } while (0)

struct XcdBarrier {
    unsigned* bar; unsigned x;
    volatile LAS unsigned* st;
};

__device__ __forceinline__ XcdBarrier xcd_barrier_post(unsigned* bar, volatile LAS unsigned* st) {
    XcdBarrier b; b.bar = bar; b.x = xb_xcc_id(); b.st = st;
    if (threadIdx.x == 0) (void)xb_add(&bar[XB_XCNT(b.x)], 1u);
    return b;
}
__device__ __forceinline__ void xcd_barrier_complete(unsigned* bar, unsigned x, unsigned& nloc, unsigned& nx) {
    const unsigned G = gridDim.x * gridDim.y * gridDim.z;
    unsigned sum, cnt, mine, sp = 0u;
    for (;;) {
        sum = 0u; cnt = 0u; mine = 0u;
#pragma unroll
        for (unsigned j = 0; j < 16; ++j) { const unsigned c = xb_ld(&bar[XB_XCNT(j)]); sum += c; cnt += (c > 0u) ? 1u : 0u; mine = (j == x) ? c : mine; }
        if (sum == G) break;
        __builtin_amdgcn_s_sleep(1);
        if ((++sp & 255u) == 0u) { if (xb_ld(&bar[XB_TMO])) break; if (sp > XB_SPIN_CAP) { atomicAdd(&bar[XB_TMO], 1u); break; } }
    }
    nloc = mine > 0u ? mine : 1u; nx = cnt > 0u ? cnt : 1u;
}

__device__ __forceinline__ void xcd_barrier(const XcdBarrier& b) {
    asm volatile("s_waitcnt vmcnt(0)" ::: "memory");
    __syncthreads();
    if (threadIdx.x == 0) {
        unsigned* bar = b.bar;
        __builtin_amdgcn_s_waitcnt(0);
        unsigned nloc = b.st[0], nx = b.st[1];
        if (nloc == 0u) { xcd_barrier_complete(bar, b.x, nloc, nx); b.st[0] = nloc; b.st[1] = nx; }
        const unsigned old = xb_add(&bar[XB_XSUB(b.x)], 1u);
        const unsigned gen = old / nloc;
        if (old + 1u == (gen + 1u) * nloc) {
            __builtin_amdgcn_fence(__ATOMIC_RELEASE, "agent");
            asm volatile("s_waitcnt vmcnt(0)" ::: "memory");
            const unsigned og = xb_add(&bar[XB_TOP], 1u);
            const unsigned tg = og / nx;
            if (og + 1u == (tg + 1u) * nx) xb_add(&bar[XB_TOPGEN], 1u);
            else XB_SPIN(xb_ld(&bar[XB_TOPGEN]) == tg, bar);
            __builtin_amdgcn_fence(__ATOMIC_ACQUIRE, "agent");
            xb_add(&bar[XB_XGEN(b.x)], 1u);
            asm volatile("s_waitcnt vmcnt(0)" ::: "memory");
        } else {
            XB_SPIN(xb_ld(&bar[XB_XGEN(b.x)]) == gen, bar);
            __builtin_amdgcn_fence(__ATOMIC_ACQUIRE, "agent");
            asm volatile("s_waitcnt vmcnt(0)" ::: "memory");
        }
    }
    __syncthreads();
}

struct Args { const float* in[23]; float* out; unsigned char* ws; int ph_lo, ph_hi; };
struct Frame {
    LAS unsigned char* lds;
    volatile LAS unsigned* MISC;
    gu32* ctl;
    int tid, lane, wave, bid, G, gw, NGW;
    const int* pos; float* out; GAS unsigned char* ws;
};
__device__ __forceinline__ void fresh(Frame& F, const Args& args) {
    int t = threadIdx.x; asm volatile("; fresh tid" : "+v"(t)); int b = blockIdx.x; asm volatile("; fresh bid" : "+s"(b));
    GAS unsigned char* w = (GAS unsigned char*)args.ws; asm volatile("; fresh ws" : "+s"(w));
    F.tid = t; F.lane = t & 63; F.wave = __builtin_amdgcn_readfirstlane(t >> 6); F.bid = b; F.gw = b * NWAVES + F.wave; F.ws = w; F.ctl = (gu32*)(w + WS_CTL);
}
#define WSP(T, off) ((T*)(F.ws + (off)))
#define WLP(T, l, off) ((T*)(F.ws + WS_W + (size_t)(l) * WL_STRIDE + (off)))
enum { IN_X = 0, IN_C, IN_POS, IN_WADA, IN_BADA, IN_WIN, IN_QNORM, IN_KVNORM, IN_WUQ, IN_WUKV, IN_DLAM, IN_DSUB, IN_CW1, IN_CB1, IN_CW2, IN_WBR, IN_WOUT, IN_LN1G, IN_LN1B, IN_WFF1, IN_WFF2, IN_LN2G, IN_LN2B };

template <class Map>
__device__ __forceinline__ void transpose_item(const float* W, int K, int Nsrc, bf16_t* WT, int Ndst, const Map& map, const float* rowscale, LAS float* scr, int item, int lane) {
    const int nblk = Ndst / 32, kb = item / nblk, nb = item % nblk, k0 = 64 * kb, n0 = 32 * nb;
    const int ns = map(n0 + (lane & 31));
#pragma unroll 8
    for (int i = 0; i < 32; ++i) { const int kk = 2 * i + (lane >> 5); float v = 0.f;
        if (ns >= 0) { v = W[(size_t)(k0 + kk) * Nsrc + ns]; if (rowscale) v *= rowscale[k0 + kk]; }
        scr[kk * 33 + (lane & 31)] = v; }
    LDS_WAIT(); asm volatile("" ::: "memory");
    const int c = lane & 7;
#pragma unroll
    for (int j = 0; j < 4; ++j) { const int n = (lane >> 3) + 8 * j; const LAS float* s = scr + (8 * c) * 33 + n;
        u32x4 o; o.x = pk2(s[0 * 33], s[1 * 33]); o.y = pk2(s[2 * 33], s[3 * 33]); o.z = pk2(s[4 * 33], s[5 * 33]); o.w = pk2(s[6 * 33], s[7 * 33]);
        *(GAS u32x4*)(WT + (size_t)(n0 + n) * K + k0 + 8 * c) = o; }
    LDS_WAIT(); asm volatile("" ::: "memory");
}
struct MapId { __device__ __forceinline__ int operator()(int n) const { return n; } };
struct MapZ { __device__ __forceinline__ int operator()(int n) const { return zsrc(n); } };
template <class Map>
__device__ __forceinline__ void transpose_all(Frame& F, const float* W, int K, int Nsrc, bf16_t* WT, int Ndst, const Map& map, const float* rowscale, int& rot) {
    LAS float* scr = (LAS float*)(F.lds + F.wave * 16384);
    const int nitems = (K / 64) * (Ndst / 32);
    int start = F.gw - rot; start %= F.NGW; if (start < 0) start += F.NGW;
    for (int it = start; it < nitems; it += F.NGW) transpose_item(W, K, Nsrc, WT, Ndst, map, rowscale, scr, it, F.lane);
    rot = (rot + nitems) % F.NGW;
}
__device__ __forceinline__ void p0_prologue(Frame& F, const Args& args) {
    int rot = 0;
    for (int l = 0; l < NL; ++l) {
        transpose_all(F, args.in[IN_WIN] + (size_t)l * D * DIN_SRC, D, DIN_SRC, WLP(bf16_t, l, WL_IN), LDZ, MapZ(), nullptr, rot);
        transpose_all(F, args.in[IN_WFF1] + (size_t)l * D * FF, D, FF, WLP(bf16_t, l, WL_FF1), FF, MapId(), nullptr, rot);
        transpose_all(F, args.in[IN_WFF2] + (size_t)l * FF * D, FF, D, WLP(bf16_t, l, WL_FF2), D, MapId(), nullptr, rot);
        for (int n = 0; n < 3; ++n)
            transpose_all(F, args.in[IN_WBR] + ((size_t)l * 3 + n) * 1024 * D, 1024, D, WLP(bf16_t, l, WL_BR) + (size_t)n * D * 1024, D, MapId(), nullptr, rot);
        transpose_all(F, args.in[IN_WOUT] + (size_t)l * D * D, D, D, WLP(bf16_t, l, WL_OUT), D, MapId(), nullptr, rot);
        transpose_all(F, args.in[IN_WUQ] + (size_t)l * 512 * 1536, 512, 1536, WLP(bf16_t, l, WL_UQ), 1536, MapId(), args.in[IN_QNORM] + l * 512, rot);
        transpose_all(F, args.in[IN_WUKV] + (size_t)l * 256 * 2048, 256, 2048, WLP(bf16_t, l, WL_UKV), 2048, MapId(), args.in[IN_KVNORM] + l * 256, rot);
    }
    __syncthreads();
    { float* rc = WSP(float, WS_ROPE); float* rs = rc + (size_t)S * 32;
      for (int idx = F.bid * NTHREADS + F.tid; idx < S * 32; idx += F.G * NTHREADS) { const int s = idx >> 5, i = idx & 31;
          const float inv = powf(10000.0f, -(float)(2 * i) / 64.0f); const float ang = (float)F.pos[s] * inv; rc[idx] = cosf(ang); rs[idx] = sinf(ang); } }
    { LAS float* cact = (LAS float*)F.lds; LAS float* red = cact + 2048;
      for (int k = F.tid; k < D; k += NTHREADS) { const float cv = args.in[IN_C][k]; cact[k] = cv / (1.f + __expf(-cv)); }
      __syncthreads();
      for (int job = F.bid; job < NL * 48; job += F.G) { const int l = job / 48, col0 = (job % 48) * 256;
          const float* wp = args.in[IN_WADA] + (size_t)l * D * (6 * D) + col0 + 4 * F.lane;
          f32x4 a = {0.f, 0.f, 0.f, 0.f};
          const int kbeg = F.wave * 256;
#pragma unroll 8
          for (int k = 0; k < 256; ++k) { const f32x4 w = *(const f32x4*)(wp + (size_t)(kbeg + k) * (6 * D)); a += w * cact[kbeg + k]; }
          *(LAS f32x4*)(red + F.wave * 256 + 4 * F.lane) = a;
          __syncthreads();
          if (F.tid < 256) { float s = args.in[IN_BADA][(size_t)l * 6 * D + col0 + F.tid];
#pragma unroll
              for (int w = 0; w < 8; ++w) s += red[w * 256 + F.tid];
              WSP(float, WS_MOD)[(size_t)l * 6 * D + col0 + F.tid] = s; }
          __syncthreads(); } }
}

__device__ __forceinline__ void ln_rows(Frame& F, const float* src, bool do_ln, const float* g, const float* b, float* xout, bool do_mod, const float* shift, const float* scale, bf16_t* hout, float* ssq_zero) {
    for (int row = F.gw; row < S; row += F.NGW) {
        const GAS f32x4* xr = (const GAS f32x4*)(src + (size_t)row * D) + F.lane;
        f32x4 v[8]; float s = 0.f;
#pragma unroll
        for (int j = 0; j < 8; ++j) { v[j] = xr[64 * j]; s += (v[j][0] + v[j][1]) + (v[j][2] + v[j][3]); }
        if (do_ln) {
            const float mean = wave_sum(s) * (1.f / D); float s2 = 0.f;
#pragma unroll
            for (int j = 0; j < 8; ++j) { v[j] = v[j] - mean; s2 += (v[j][0] * v[j][0] + v[j][1] * v[j][1]) + (v[j][2] * v[j][2] + v[j][3] * v[j][3]); }
            const float rstd = 1.f / sqrtf(wave_sum(s2) * (1.f / D) + 1e-5f);
            s = 0.f;
#pragma unroll
            for (int j = 0; j < 8; ++j) { const f32x4 gg = *((const f32x4*)g + F.lane + 64 * j), bb = *((const f32x4*)b + F.lane + 64 * j);
                v[j] = v[j] * rstd * gg + bb; *((GAS f32x4*)(xout + (size_t)row * D) + F.lane + 64 * j) = v[j]; s += (v[j][0] + v[j][1]) + (v[j][2] + v[j][3]); }
        }
        if (do_mod) {
            const float mean = wave_sum(s) * (1.f / D); float s2 = 0.f;
#pragma unroll
            for (int j = 0; j < 8; ++j) { v[j] = v[j] - mean; s2 += (v[j][0] * v[j][0] + v[j][1] * v[j][1]) + (v[j][2] * v[j][2] + v[j][3] * v[j][3]); }
            const float rstd = 1.f / sqrtf(wave_sum(s2) * (1.f / D) + 1e-5f);
#pragma unroll
            for (int j = 0; j < 8; ++j) { const f32x4 sc = *((const f32x4*)scale + F.lane + 64 * j), sh = *((const f32x4*)shift + F.lane + 64 * j);
                const f32x4 h = v[j] * rstd * (sc + 1.0f) + sh;
                u32x2 w; w.x = pk2(h[0], h[1]); w.y = pk2(h[2], h[3]);
                *((GAS u32x2*)(hout + (size_t)row * D) + F.lane + 64 * j) = w; }
        }
        if (ssq_zero && F.lane < 2) ssq_zero[(size_t)row * 2 + F.lane] = 0.f;
    }
}

__device__ __forceinline__ void krope_job(Frame& F) {
    const bf16_t* Z = WSP(bf16_t, WS_Z); bf16_t* KR = WSP(bf16_t, WS_KROPE); const float* rc = WSP(float, WS_ROPE); const float* rs = rc + (size_t)S * 32;
    for (int idx = F.bid * NTHREADS + F.tid; idx < S * 32; idx += F.G * NTHREADS) { const int s = idx >> 5, i = idx & 31;
        const float x1 = bf1(Z[(size_t)s * LDZ + ZC_KR + i]), x2 = bf1(Z[(size_t)s * LDZ + ZC_KR + 32 + i]); const float c = rc[idx], sn = rs[idx];
        KR[(size_t)s * 64 + i] = (bf16_t)f2bf(x1 * c - x2 * sn); KR[(size_t)s * 64 + 32 + i] = (bf16_t)f2bf(x1 * sn + x2 * c); }
}
__device__ __forceinline__ float gelu_tanh(float x) { const float u = 0.7978845608028654f * (x + 0.044715f * x * x * x); return 0.5f * x * (1.f + tanhf(u)); }
__device__ __forceinline__ void compress_naive(Frame& F, const Args& args, int l) {
    const bf16_t* Z = WSP(bf16_t, WS_Z); bf16_t* KC = WSP(bf16_t, WS_KCMP);
    LAS float* hs = (LAS float*)(F.lds + F.wave * 4096);
    for (int item = F.gw; item < 4 * 128; item += F.NGW) { const int inst = item >> 7, kv = inst >> 1, g = inst & 1, n0 = (item & 127) * 4;
        const float* w1 = args.in[IN_CW1] + ((size_t)l * 2 + kv) * 4096 * 128; const float* b1 = args.in[IN_CB1] + ((size_t)l * 2 + kv) * 128; const float* w2 = args.in[IN_CW2] + ((size_t)l * 2 + kv) * 128 * 128;
        const int zc = ZC_NKV + ((0 * 2 + kv) * 2 + g) * 128;
        float a[4][2];
#pragma unroll
        for (int r = 0; r < 4; ++r) { a[r][0] = 0.f; a[r][1] = 0.f; }
        for (int k = 0; k < 4096; ++k) { const int t = k >> 7, d = k & 127; const f32x2 w = *(const f32x2*)(w1 + (size_t)k * 128 + 2 * F.lane);
#pragma unroll
            for (int r = 0; r < 4; ++r) { int tok = 16 * (n0 + r) + t; tok = tok < S ? tok : S - 1; const float xv = bf1(Z[(size_t)tok * LDZ + zc + d]); a[r][0] += xv * w[0]; a[r][1] += xv * w[1]; } }
        const f32x2 bb = *(const f32x2*)(b1 + 2 * F.lane);
#pragma unroll
        for (int r = 0; r < 4; ++r) { hs[r * 128 + 2 * F.lane] = gelu_tanh(a[r][0] + bb[0]); hs[r * 128 + 2 * F.lane + 1] = gelu_tanh(a[r][1] + bb[1]); }
        LDS_WAIT(); asm volatile("" ::: "memory");
        float o[4][2];
#pragma unroll
        for (int r = 0; r < 4; ++r) { o[r][0] = 0.f; o[r][1] = 0.f; }
        for (int j = 0; j < 128; ++j) { const f32x2 w = *(const f32x2*)(w2 + (size_t)j * 128 + 2 * F.lane);
#pragma unroll
            for (int r = 0; r < 4; ++r) { const float hv = hs[r * 128 + j]; o[r][0] += hv * w[0]; o[r][1] += hv * w[1]; } }
#pragma unroll
        for (int r = 0; r < 4; ++r) { const int n = n0 + r; const unsigned pk = (n < 511) ? pk2(o[r][0], o[r][1]) : 0u;
            *(unsigned*)(KC + (((size_t)kv * 2 + g) * 512 + n) * 128 + 2 * F.lane) = pk; }
        LDS_WAIT(); asm volatile("" ::: "memory");
    }
}

__device__ __forceinline__ float dotrow(const LAS float* q, const bf16_t* k, int n8) {
    float a = 0.f;
    for (int i = 0; i < n8; ++i) { const u32x4 w = *(const u32x4*)(k + 8 * i); const LAS f32x4* qq = (const LAS f32x4*)(q + 8 * i); const f32x4 q0 = qq[0], q1 = qq[1];
        a += q0[0] * bflo(w.x) + q0[1] * bfhi(w.x) + q0[2] * bflo(w.y) + q0[3] * bfhi(w.y) + q1[0] * bflo(w.z) + q1[1] * bfhi(w.z) + q1[2] * bflo(w.w) + q1[3] * bfhi(w.w); }
    return a;
}
__device__ __forceinline__ void naive_update(float& m, float& l, float& o0, float& o1, float s, const bf16_t* vrow0, size_t vstride) {
    const float mn = fmaxf(m, wave_max(s)); const float alpha = __expf(m - mn); const float p = __expf(s - mn);
    l = l * alpha + wave_sum(p); o0 *= alpha; o1 *= alpha; m = mn;
    for (int kk = 0; kk < 64; ++kk) { const float pk = __builtin_bit_cast(float, __builtin_amdgcn_readlane(__builtin_bit_cast(int, p), kk));
        if (pk != 0.f) { const unsigned v = *(const unsigned*)(vrow0 + (size_t)kk * vstride); o0 += pk * bflo(v); o1 += pk * bfhi(v); } }
}
__device__ __forceinline__ void pv_norm(float& o0, float& o1, float p, const bf16_t* vrow0, size_t vstride) {
    for (int kk = 0; kk < 64; ++kk) { const float pk = __builtin_bit_cast(float, __builtin_amdgcn_readlane(__builtin_bit_cast(int, p), kk));
        if (pk != 0.f) { const unsigned v = *(const unsigned*)(vrow0 + (size_t)kk * vstride); o0 += pk * bflo(v); o1 += pk * bfhi(v); } }
}
#define WAVE_LDS_SYNC() do { LDS_WAIT(); __builtin_amdgcn_wave_barrier(); asm volatile("" ::: "memory"); } while (0)
constexpr float NEG_INF = -__builtin_inff();

__device__ __forceinline__ void attn_naive(Frame& F, const Args& args, int l, bool do_mla, bool do_diff, bool do_nsa, size_t br_off = WS_BR) {
    const bf16_t* Z = WSP(bf16_t, WS_Z); const bf16_t* QM = WSP(bf16_t, WS_QM); const bf16_t* KVM = WSP(bf16_t, WS_KVM); const bf16_t* KR = WSP(bf16_t, WS_KROPE);
    const bf16_t* KC = WSP(bf16_t, WS_KCMP); bf16_t* BR = WSP(bf16_t, br_off);
    const float* rc = WSP(float, WS_ROPE); const float* rs = rc + (size_t)S * 32;
    LAS float* wq = (LAS float*)(F.lds + F.wave * 2048);
    LAS float* wimp = wq + 256;
    const int lane = F.lane;
    const float* lp = args.in[IN_DLAM] + (size_t)l * 256;
    const float lam_init = 0.8f - 0.6f * expf(-0.3f * (float)l);
    const float lam = expf(wave_sum(lp[lane] * lp[64 + lane])) - expf(wave_sum(lp[128 + lane] * lp[192 + lane])) + lam_init;
    if (do_mla) for (int item = F.gw; item < S * 8; item += F.NGW) { const int q = item >> 3, h = item & 7;
        { const float sc = 0.07216878364870322f;
          const bf16_t* qr = QM + (size_t)q * 1536 + h * 192;
          wq[lane] = bf1(qr[lane]) * sc; wq[64 + lane] = bf1(qr[64 + lane]) * sc;
          const int i = lane & 31; const float x1 = bf1(qr[128 + i]), x2 = bf1(qr[160 + i]), c = rc[(size_t)q * 32 + i], sn = rs[(size_t)q * 32 + i];
          wq[128 + lane] = (lane < 32 ? x1 * c - x2 * sn : x1 * sn + x2 * c) * sc; }
        WAVE_LDS_SYNC();
        float m = -1e30f, ls = 0.f, o0 = 0.f, o1 = 0.f;
        for (int kb = 0; kb <= q; kb += 64) { const int key = kb + lane; float s = NEG_INF;
            if (key <= q) s = dotrow(wq, KVM + (size_t)key * 2048 + h * 256, 16) + dotrow(wq + 128, KR + (size_t)key * 64, 8);
            naive_update(m, ls, o0, o1, s, KVM + (size_t)kb * 2048 + h * 256 + 128 + 2 * lane, 2048); }
        const float inv = ls > 0.f ? 1.f / ls : 0.f;
        *(unsigned*)(BR + (size_t)q * 3072 + h * 128 + 2 * lane) = pk2(o0 * inv, o1 * inv);
        WAVE_LDS_SYNC();
    }
    if (do_diff) for (int item = F.gw; item < S * 8; item += F.NGW) { const int q = item >> 3, h = item & 7;
        const float slope = exp2f(-0.5f * (float)(2 * h + 1)); const float pq = (float)F.pos[q];
        float r0[2], r1[2];
#pragma unroll
        for (int mp = 0; mp < 2; ++mp) {
            wq[lane] = bf1(Z[(size_t)q * LDZ + ZC_DQ + h * 128 + mp * 64 + lane]) * 0.125f;
            WAVE_LDS_SYNC();
            float m = -1e30f, ls = 0.f, o0 = 0.f, o1 = 0.f;
            for (int kb = 0; kb <= q; kb += 64) { const int key = kb + lane; float s = NEG_INF;
                if (key <= q) s = dotrow(wq, Z + (size_t)key * LDZ + ZC_DK + h * 128 + mp * 64, 8) - slope * fabsf(pq - (float)F.pos[key]);
                naive_update(m, ls, o0, o1, s, Z + (size_t)kb * LDZ + ZC_DV + h * 128 + 2 * lane, LDZ); }
            const float inv = ls > 0.f ? 1.f / ls : 0.f; r0[mp] = o0 * inv; r1[mp] = o1 * inv;
            WAVE_LDS_SYNC();
        }
        const float a0 = r0[0] - lam * r0[1], a1 = r1[0] - lam * r1[1];
        const float rr = 1.f / sqrtf(wave_sum(a0 * a0 + a1 * a1) * (1.f / 128.f) + 1e-6f);
        const float* gs = args.in[IN_DSUB] + (size_t)l * 128;
        *(unsigned*)(BR + (size_t)q * 3072 + 1024 + h * 128 + 2 * lane) = pk2(a0 * rr * gs[2 * lane] * (1.f - lam_init), a1 * rr * gs[2 * lane + 1] * (1.f - lam_init));
    }
    if (do_nsa) for (int item = F.gw; item < S * 2; item += F.NGW) { const int q = item >> 1, g = item & 1;
        const float pq = (float)F.pos[q]; const int cur = q >> 6; const int ncmp = q >= 31 ? ((q - 31) >> 4) + 1 : 0;
        const float sc = 0.08838834764831845f;
        wimp[lane] = 0.f; wimp[64 + lane] = 0.f;
        float oc0[4], oc1[4];
#pragma unroll
        for (int r = 0; r < 4; ++r) { const int hh = 4 * g + r; const float slope = exp2f(-(float)(hh + 1));
            const bf16_t* qr = Z + (size_t)q * LDZ + ZC_NQ + hh * 128; wq[lane] = bf1(qr[lane]) * sc; wq[64 + lane] = bf1(qr[64 + lane]) * sc;
            WAVE_LDS_SYNC();
            const bf16_t* kc = KC + ((size_t)(0 * 2 + g) * 512) * 128; const bf16_t* vc = KC + ((size_t)(1 * 2 + g) * 512) * 128;
            float m = -1e30f, ls = 0.f;
            for (int nb = 0; nb < ncmp; nb += 64) { const int n = nb + lane; float s = NEG_INF;
                if (n < ncmp) s = dotrow(wq, kc + (size_t)n * 128, 16) - slope * fabsf(pq - (float)F.pos[31 + 16 * n]);
                const float mn = fmaxf(m, wave_max(s)); ls = ls * __expf(m - mn) + wave_sum(__expf(s - mn)); m = mn; }
            const float inv = ls > 0.f ? 1.f / ls : 0.f; float o0 = 0.f, o1 = 0.f;
            for (int nb = 0; nb < ncmp; nb += 64) { const int n = nb + lane; float p = 0.f;
                if (n < ncmp) { const float s = dotrow(wq, kc + (size_t)n * 128, 16) - slope * fabsf(pq - (float)F.pos[31 + 16 * n]); p = __expf(s - m) * inv;
                    atomicAdd((float*)(wimp + (n >> 2)), p); if ((n & 3) == 3) atomicAdd((float*)(wimp + (n >> 2) + 1), p); }
                pv_norm(o0, o1, p, vc + (size_t)nb * 128 + 2 * lane, 128); }
            oc0[r] = o0; oc1[r] = o1;
            WAVE_LDS_SYNC();
        }
        unsigned long long mlo, mhi;
        { float v0, v1; { const int j0 = lane, j1 = lane + 64;
              v0 = (j0 == 0 || j0 == cur || j0 == cur - 1) ? __builtin_inff() : (j0 <= cur ? wimp[j0] : NEG_INF);
              v1 = (j1 == cur || j1 == cur - 1) ? __builtin_inff() : (j1 <= cur ? wimp[j1] : NEG_INF); }
          int c0 = 0, c1 = 0;
          for (int k = 0; k < 128; ++k) { const float vk = (k == 0 || k == cur || k == cur - 1) ? __builtin_inff() : (k <= cur ? wimp[k] : NEG_INF);
              c0 += (vk > v0 || (vk == v0 && k < lane)) ? 1 : 0; c1 += (vk > v1 || (vk == v1 && k < lane + 64)) ? 1 : 0; }
          mlo = __ballot(c0 < 16 && v0 > NEG_INF); mhi = __ballot(c1 < 16 && v1 > NEG_INF); }
        WAVE_LDS_SYNC();
#pragma unroll
        for (int r = 0; r < 4; ++r) { const int hh = 4 * g + r; const float slope = exp2f(-(float)(hh + 1));
            const bf16_t* qr = Z + (size_t)q * LDZ + ZC_NQ + hh * 128; wq[lane] = bf1(qr[lane]) * sc; wq[64 + lane] = bf1(qr[64 + lane]) * sc;
            WAVE_LDS_SYNC();
            const bf16_t* ks = Z + ZC_NKV + ((1 * 2 + 0) * 2 + g) * 128; const bf16_t* vs = Z + ZC_NKV + ((1 * 2 + 1) * 2 + g) * 128;
            float m = -1e30f, ls = 0.f, o0 = 0.f, o1 = 0.f;
            for (int j = 0; j < 128; ++j) { const bool on = j < 64 ? ((mlo >> j) & 1ull) : ((mhi >> (j - 64)) & 1ull); if (!on) continue;
                const int key = 64 * j + lane; float s = NEG_INF;
                if (key <= q) s = dotrow(wq, ks + (size_t)key * LDZ, 16) - slope * fabsf(pq - (float)F.pos[key]);
                naive_update(m, ls, o0, o1, s, vs + (size_t)(64 * j) * LDZ + 2 * lane, LDZ); }
            const float is = ls > 0.f ? 1.f / ls : 0.f; const float os0 = o0 * is, os1 = o1 * is;
            const bf16_t* kw = Z + ZC_NKV + ((2 * 2 + 0) * 2 + g) * 128; const bf16_t* vw = Z + ZC_NKV + ((2 * 2 + 1) * 2 + g) * 128;
            m = -1e30f; ls = 0.f; o0 = 0.f; o1 = 0.f;
            int kb0 = q - 511; kb0 = kb0 < 0 ? 0 : (kb0 & ~63);
            for (int kb = kb0; kb <= q; kb += 64) { const int key = kb + lane; float s = NEG_INF;
                if (key <= q && key > q - 512) s = dotrow(wq, kw + (size_t)key * LDZ, 16) - slope * fabsf(pq - (float)F.pos[key]);
                naive_update(m, ls, o0, o1, s, vw + (size_t)kb * LDZ + 2 * lane, LDZ); }
            const float iw = ls > 0.f ? 1.f / ls : 0.f; const float ow0 = o0 * iw, ow1 = o1 * iw;
            const bf16_t* gl = Z + (size_t)q * LDZ + ZC_NG + hh * 3;
            const float g0 = sigmoidf_(bf1(gl[0])), g1 = sigmoidf_(bf1(gl[1])), g2 = sigmoidf_(bf1(gl[2]));
            *(unsigned*)(BR + (size_t)q * 3072 + 2048 + hh * 128 + 2 * lane) = pk2(g0 * oc0[r] + g1 * os0 + g2 * ow0, g0 * oc1[r] + g1 * os1 + g2 * ow1);
            WAVE_LDS_SYNC();
        }
    }
}
namespace fa {
constexpr int VRS = 320;
constexpr int L_K = 0, KBUF = 25600;
constexpr int L_V = 51200, VBUF = 20480;
constexpr int L_POS = 92160, PBUF = 256;
constexpr int L_CTRL = 92672;
constexpr int L_LIST = 92928;
constexpr int L_IMP = 94208;
constexpr int L_SEL = 126976;
constexpr float LOG2E = 1.4426950408889634f;
typedef short v4i16_t __attribute__((ext_vector_type(4)));
typedef __bf16 bf16x2_t __attribute__((ext_vector_type(2)));

__device__ __forceinline__ unsigned cvtpk(float lo, float hi) { f32x2 v = {lo, hi}; bf16x2_t b = __builtin_convertvector(v, bf16x2_t); return __builtin_bit_cast(unsigned, b); }
__device__ __forceinline__ void swap32(float& a, float& b) { asm volatile("s_nop 1\n\tv_permlane32_swap_b32 %0, %1" : "+v"(a), "+v"(b)); }
__device__ __forceinline__ float swapmax(float v) { float a = v, b = v; swap32(a, b); return fmaxf(a, b); }
__device__ __forceinline__ float swapsum(float v) { float a = v, b = v; swap32(a, b); return a + b; }
__device__ __forceinline__ s16x4 vtr(const LAS unsigned char* p) { return __builtin_bit_cast(s16x4, __builtin_amdgcn_ds_read_tr16_b64_v4i16((LAS v4i16_t*)p)); }

template <int NQ, int KRS>
__device__ __forceinline__ void qk_tile(f32x16& p0, f32x16& p1, const LAS unsigned char* kl, const bf16x8 (&qf)[NQ]) {
    p0 = f32x16{}; p1 = f32x16{};
#pragma unroll
    for (int d0 = 0; d0 < NQ; ++d0) {
        const bf16x8 a0 = *(const LAS bf16x8*)(kl + d0 * 32), a1 = *(const LAS bf16x8*)(kl + 32 * KRS + d0 * 32);
        p0 = __builtin_amdgcn_mfma_f32_32x32x16_bf16(a0, qf[d0], p0, 0, 0, 0);
        p1 = __builtin_amdgcn_mfma_f32_32x32x16_bf16(a1, qf[d0], p1, 0, 0, 0);
    }
}
template <bool ALIBI>
__device__ __forceinline__ void scale_bias(f32x16& p0, f32x16& p1, float c1, float c2, float pq, const LAS float* pk) {
#pragma unroll
    for (int g4 = 0; g4 < 4; ++g4) {
        if (ALIBI) { const f32x4 pa = *(const LAS f32x4*)(pk + 8 * g4), pb = *(const LAS f32x4*)(pk + 32 + 8 * g4);
#pragma unroll
            for (int j = 0; j < 4; ++j) { p0[4 * g4 + j] = p0[4 * g4 + j] * c1 - c2 * fabsf(pq - pa[j]); p1[4 * g4 + j] = p1[4 * g4 + j] * c1 - c2 * fabsf(pq - pb[j]); } }
        else {
#pragma unroll
            for (int j = 0; j < 4; ++j) { p0[4 * g4 + j] *= c1; p1[4 * g4 + j] *= c1; } }
    }
}
__device__ __forceinline__ void mask_range(f32x16& p0, f32x16& p1, int kb4, int klo, int khi) {
#pragma unroll
    for (int r = 0; r < 16; ++r) { const int k0 = kb4 + (r & 3) + 8 * (r >> 2), k1 = k0 + 32;
        p0[r] = (k0 >= klo && k0 <= khi) ? p0[r] : -__builtin_inff(); p1[r] = (k1 >= klo && k1 <= khi) ? p1[r] : -__builtin_inff(); }
}
__device__ __forceinline__ float tile_max(const f32x16& p0, const f32x16& p1) {
    float a = fmaxf(p0[0], p1[0]);
#pragma unroll
    for (int r = 1; r < 16; ++r) a = fmaxf(a, fmaxf(p0[r], p1[r]));
    return swapmax(a);
}
__device__ __forceinline__ void softmax_step(f32x16& p0, f32x16& p1, float& m, float& l, float& alpha) {
    const float mn = fmaxf(m, tile_max(p0, p1)); alpha = __builtin_amdgcn_exp2f(m - mn); m = mn;
    float ps = 0.f;
#pragma unroll
    for (int r = 0; r < 16; ++r) { p0[r] = __builtin_amdgcn_exp2f(p0[r] - mn); p1[r] = __builtin_amdgcn_exp2f(p1[r] - mn); ps += p0[r] + p1[r]; }
    l = l * alpha + ps;
}
__device__ __forceinline__ void rescale(f32x16 (&o)[4], float alpha) {
    if (!__all(alpha == 1.f)) {
#pragma unroll
        for (int d = 0; d < 4; ++d)
#pragma unroll
            for (int r = 0; r < 16; ++r) o[d][r] *= alpha; }
}
__device__ __forceinline__ bf16x8 pack8(const f32x16& p, int b) {
    u32x4 w; w.x = cvtpk(p[b], p[b + 1]); w.y = cvtpk(p[b + 2], p[b + 3]); w.z = cvtpk(p[b + 4], p[b + 5]); w.w = cvtpk(p[b + 6], p[b + 7]); return __builtin_bit_cast(bf16x8, w);
}
__device__ __forceinline__ void pv_tile(f32x16 (&o)[4], const f32x16& p0, const f32x16& p1, const LAS unsigned char* vl) {
    bf16x8 pf[4]; pf[0] = pack8(p0, 0); pf[1] = pack8(p0, 8); pf[2] = pack8(p1, 0); pf[3] = pack8(p1, 8);
#pragma unroll
    for (int s = 0; s < 4; ++s)
#pragma unroll
        for (int d = 0; d < 4; ++d) { const s16x4 lo = vtr(vl + s * 16 * VRS + d * 64), hh = vtr(vl + s * 16 * VRS + 8 * VRS + d * 64);
            const bf16x8 vf = {lo[0], lo[1], lo[2], lo[3], hh[0], hh[1], hh[2], hh[3]};
            o[d] = __builtin_amdgcn_mfma_f32_32x32x16_bf16(vf, pf[s], o[d], 0, 0, 0); }
}
__device__ __forceinline__ void zero_o(f32x16 (&o)[4]) {
#pragma unroll
    for (int d = 0; d < 4; ++d) o[d] = f32x16{};
}

struct TileRegs { u32x4 k0, k1, k2, v0, v1; float ps; };
__device__ __forceinline__ void load128(TileRegs& R, const bf16_t* kp, size_t ks, const bf16_t* vp, size_t vs, int tid) {
    const int r = tid >> 4, c = (tid & 15) * 8;
    R.k0 = *(const u32x4*)(kp + (size_t)r * ks + c); R.k1 = *(const u32x4*)(kp + (size_t)(r + 32) * ks + c);
    if (vp) { R.v0 = *(const u32x4*)(vp + (size_t)r * vs + c); R.v1 = *(const u32x4*)(vp + (size_t)(r + 32) * vs + c); }
}
__device__ __forceinline__ void store128(const TileRegs& R, LAS unsigned char* kb, LAS unsigned char* vb, LAS float* pb, int tid, bool hasv, bool haspos) {
    const int r = tid >> 4, c16 = (tid & 15) * 16;
    *(LAS u32x4*)(kb + r * 272 + c16) = R.k0; *(LAS u32x4*)(kb + (r + 32) * 272 + c16) = R.k1;
    if (hasv) { *(LAS u32x4*)(vb + r * VRS + c16) = R.v0; *(LAS u32x4*)(vb + (r + 32) * VRS + c16) = R.v1; }
    if (haspos && tid < 64) pb[tid] = R.ps;
}
__device__ __forceinline__ void load_mla(TileRegs& R, const bf16_t* kvm  , const bf16_t* kr  , int tid) {
    u32x4 kk[3];
#pragma unroll
    for (int i = 0; i < 3; ++i) { const int c = tid + 512 * i, r = c / 24, cc = c - r * 24;
        kk[i] = cc < 16 ? *(const u32x4*)(kvm + (size_t)r * 2048 + cc * 8) : *(const u32x4*)(kr + (size_t)r * 64 + (cc - 16) * 8); }
    R.k0 = kk[0]; R.k1 = kk[1]; R.k2 = kk[2];
    const int r = tid >> 4, c = (tid & 15) * 8;
    R.v0 = *(const u32x4*)(kvm + 128 + (size_t)r * 2048 + c); R.v1 = *(const u32x4*)(kvm + 128 + (size_t)(r + 32) * 2048 + c);
}
__device__ __forceinline__ void store_mla(const TileRegs& R, LAS unsigned char* kb, LAS unsigned char* vb, int tid) {
    { const int c = tid, r = c / 24, cc = c - r * 24; *(LAS u32x4*)(kb + r * 400 + cc * 16) = R.k0; }
    { const int c = tid + 512, r = c / 24, cc = c - r * 24; *(LAS u32x4*)(kb + r * 400 + cc * 16) = R.k1; }
    { const int c = tid + 1024, r = c / 24, cc = c - r * 24; *(LAS u32x4*)(kb + r * 400 + cc * 16) = R.k2; }
    const int r = tid >> 4, c16 = (tid & 15) * 16;
    *(LAS u32x4*)(vb + r * VRS + c16) = R.v0; *(LAS u32x4*)(vb + (r + 32) * VRS + c16) = R.v1;
}
__device__ __forceinline__ void store_o(bf16_t* rowp  , const f32x16 (&o)[4], float sc) {
#pragma unroll
    for (int d = 0; d < 4; ++d)
#pragma unroll
        for (int g4 = 0; g4 < 4; ++g4) { u32x2 w; w.x = cvtpk(o[d][4 * g4] * sc, o[d][4 * g4 + 1] * sc); w.y = cvtpk(o[d][4 * g4 + 2] * sc, o[d][4 * g4 + 3] * sc);
            *(u32x2*)(rowp + 32 * d + 8 * g4) = w; }
}
__device__ __forceinline__ void addstore_o(bf16_t* rowp  , const f32x16 (&o)[4], float sc) {
#pragma unroll
    for (int d = 0; d < 4; ++d)
#pragma unroll
        for (int g4 = 0; g4 < 4; ++g4) { const unsigned long long ov = __hip_atomic_load((const unsigned long long*)(rowp + 32 * d + 8 * g4), __ATOMIC_RELAXED, __HIP_MEMORY_SCOPE_AGENT);
            u32x2 old; old.x = (unsigned)ov; old.y = (unsigned)(ov >> 32);
            u32x2 w; w.x = cvtpk(bflo(old.x) + o[d][4 * g4] * sc, bfhi(old.x) + o[d][4 * g4 + 1] * sc); w.y = cvtpk(bflo(old.y) + o[d][4 * g4 + 2] * sc, bfhi(old.y) + o[d][4 * g4 + 3] * sc);
            *(u32x2*)(rowp + 32 * d + 8 * g4) = w; }
}

__device__ __forceinline__ void mla_unit(Frame& F, int h, int qb) {
    const int tid = F.tid, lane = F.lane, w = F.wave, r32 = lane & 31, hi = lane >> 5;
    const bf16_t* QM = WSP(bf16_t, WS_QM); const bf16_t* KVM = WSP(bf16_t, WS_KVM) + h * 256; const bf16_t* KR = WSP(bf16_t, WS_KROPE); bf16_t* BR = WSP(bf16_t, WS_BR);
    const float* rc = WSP(float, WS_ROPE); const float* rs = rc + (size_t)S * 32;
    LAS unsigned char* lds = F.lds;
    const int q = 256 * qb + 32 * w + r32;
    bf16x8 qf[12];
    { const bf16_t* qrow = QM + (size_t)q * 1536 + h * 192 + 8 * hi;
#pragma unroll
      for (int d0 = 0; d0 < 8; ++d0) qf[d0] = *(const bf16x8*)(qrow + 16 * d0);
#pragma unroll
      for (int dd = 0; dd < 2; ++dd) { const u32x4 a = *(const u32x4*)(qrow + 128 + 16 * dd), b = *(const u32x4*)(qrow + 160 + 16 * dd);
          const float* cp = rc + (size_t)q * 32 + 16 * dd + 8 * hi; const float* sp = rs + (size_t)q * 32 + 16 * dd + 8 * hi;
          const f32x4 c0 = *(const f32x4*)cp, c1 = *(const f32x4*)(cp + 4), s0 = *(const f32x4*)sp, s1 = *(const f32x4*)(sp + 4);
          float x1[8], x2[8], y1[8], y2[8];
          x1[0] = bflo(a.x); x1[1] = bfhi(a.x); x1[2] = bflo(a.y); x1[3] = bfhi(a.y); x1[4] = bflo(a.z); x1[5] = bfhi(a.z); x1[6] = bflo(a.w); x1[7] = bfhi(a.w);
          x2[0] = bflo(b.x); x2[1] = bfhi(b.x); x2[2] = bflo(b.y); x2[3] = bfhi(b.y); x2[4] = bflo(b.z); x2[5] = bfhi(b.z); x2[6] = bflo(b.w); x2[7] = bfhi(b.w);
#pragma unroll
          for (int j = 0; j < 8; ++j) { const float c = j < 4 ? c0[j & 3] : c1[j & 3], s = j < 4 ? s0[j & 3] : s1[j & 3]; y1[j] = x1[j] * c - x2[j] * s; y2[j] = x1[j] * s + x2[j] * c; }
          u32x4 o1, o2; o1.x = cvtpk(y1[0], y1[1]); o1.y = cvtpk(y1[2], y1[3]); o1.z = cvtpk(y1[4], y1[5]); o1.w = cvtpk(y1[6], y1[7]);
          o2.x = cvtpk(y2[0], y2[1]); o2.y = cvtpk(y2[2], y2[3]); o2.z = cvtpk(y2[4], y2[5]); o2.w = cvtpk(y2[6], y2[7]);
          qf[8 + dd] = __builtin_bit_cast(bf16x8, o1); qf[10 + dd] = __builtin_bit_cast(bf16x8, o2); } }
    const float c1s = 0.07216878364870322f * LOG2E;
    float m = -1e30f, l = 0.f, alpha; f32x16 o[4]; zero_o(o); f32x16 p0, p1;
    const int nt = 4 * (qb + 1), mydiag = 4 * qb + (w >> 1);
    const LAS unsigned char* kl0 = lds + L_K + r32 * 400 + hi * 16;
    const LAS unsigned char* vl0 = lds + L_V + (4 * hi + ((lane & 15) >> 2)) * VRS + (16 * ((lane >> 4) & 1) + 4 * (lane & 3)) * 2;
    TileRegs R;
    load_mla(R, KVM, KR, tid);
    for (int t = 0; t < nt; ++t) { const int b = t & 1;
        store_mla(R, lds + L_K + b * KBUF, lds + L_V + b * VBUF, tid);
        __syncthreads();
        if (t + 1 < nt) load_mla(R, KVM + (size_t)(t + 1) * 64 * 2048, KR + (size_t)(t + 1) * 64 * 64, tid);
        if (t <= mydiag) {
            qk_tile<12, 400>(p0, p1, kl0 + b * KBUF, qf);
            scale_bias<false>(p0, p1, c1s, 0.f, 0.f, nullptr);
            if (t == mydiag) mask_range(p0, p1, 64 * t + 4 * hi, 0, q);
            softmax_step(p0, p1, m, l, alpha); rescale(o, alpha);
            pv_tile(o, p0, p1, vl0 + b * VBUF);
        }
    }
    l = swapsum(l); const float inv = l > 0.f ? 1.f / l : 0.f;
    store_o(BR + (size_t)q * 3072 + h * 128 + 4 * hi, o, inv);
}

__device__ __forceinline__ void diff_unit(Frame& F, const Args& args, int l_idx, int h, int qb) {
    const int tid = F.tid, lane = F.lane, w = F.wave, r32 = lane & 31, hi = lane >> 5, mp = w >> 2, wq = w & 3;
    const bf16_t* Z = WSP(bf16_t, WS_Z); bf16_t* BR = WSP(bf16_t, WS_BR);
    LAS unsigned char* lds = F.lds;
    const int q = 128 * qb + 32 * wq + r32;
    bf16x8 qf[4];
    { const bf16_t* qrow = Z + (size_t)q * LDZ + ZC_DQ + h * 128 + mp * 64 + 8 * hi;
#pragma unroll
      for (int d0 = 0; d0 < 4; ++d0) qf[d0] = *(const bf16x8*)(qrow + 16 * d0); }
    const float slope = exp2f(-0.5f * (float)(2 * h + 1));
    const float c1s = 0.125f * LOG2E, c2s = slope * LOG2E, pq = (float)F.pos[q];
    float m = -1e30f, l = 0.f, alpha; f32x16 o[4]; zero_o(o); f32x16 p0, p1;
    const int nt = 2 * (qb + 1), mydiag = 2 * qb + (wq >> 1);
    const bf16_t* kp = Z + ZC_DK + h * 128; const bf16_t* vp = Z + ZC_DV + h * 128;
    const LAS unsigned char* kl0 = lds + L_K + r32 * 272 + hi * 16 + mp * 128;
    const LAS unsigned char* vl0 = lds + L_V + (4 * hi + ((lane & 15) >> 2)) * VRS + (16 * ((lane >> 4) & 1) + 4 * (lane & 3)) * 2;
    TileRegs R;
    load128(R, kp, LDZ, vp, LDZ, tid); if (tid < 64) R.ps = (float)F.pos[tid];
    for (int t = 0; t < nt; ++t) { const int b = t & 1;
        store128(R, lds + L_K + b * KBUF, lds + L_V + b * VBUF, (LAS float*)(lds + L_POS + b * PBUF), tid, true, true);
        __syncthreads();
        if (t + 1 < nt) { load128(R, kp + (size_t)(t + 1) * 64 * LDZ, LDZ, vp + (size_t)(t + 1) * 64 * LDZ, LDZ, tid); if (tid < 64) R.ps = (float)F.pos[(t + 1) * 64 + tid]; }
        if (t <= mydiag) {
            qk_tile<4, 272>(p0, p1, kl0 + b * KBUF, qf);
            scale_bias<true>(p0, p1, c1s, c2s, pq, (const LAS float*)(lds + L_POS + b * PBUF) + 4 * hi);
            if (t == mydiag) mask_range(p0, p1, 64 * t + 4 * hi, 0, q);
            softmax_step(p0, p1, m, l, alpha); rescale(o, alpha);
            pv_tile(o, p0, p1, vl0 + b * VBUF);
        }
    }
    l = swapsum(l); const float inv = l > 0.f ? 1.f / l : 0.f;
    __syncthreads();
    LAS float* xb = (LAS float*)lds + wq * 4096 + lane;
    if (mp == 1) {
#pragma unroll
        for (int d = 0; d < 4; ++d)
#pragma unroll
            for (int r = 0; r < 16; ++r) xb[(16 * d + r) * 64] = o[d][r] * inv;
    }
    __syncthreads();
    if (mp == 0) {
        const float* lp = args.in[IN_DLAM] + (size_t)l_idx * 256;
        const float lam_init = 0.8f - 0.6f * expf(-0.3f * (float)l_idx);
        const float lam = expf(wave_sum(lp[lane] * lp[64 + lane])) - expf(wave_sum(lp[128 + lane] * lp[192 + lane])) + lam_init;
        float ss = 0.f;
#pragma unroll
        for (int d = 0; d < 4; ++d)
#pragma unroll
            for (int r = 0; r < 16; ++r) { const float a = o[d][r] * inv - lam * xb[(16 * d + r) * 64]; o[d][r] = a; ss += a * a; }
        ss = swapsum(ss);
        const float rr = (1.f - lam_init) / sqrtf(ss * (1.f / 128.f) + 1e-6f);
        const float* gs = args.in[IN_DSUB] + (size_t)l_idx * 128 + 4 * hi;
#pragma unroll
        for (int d = 0; d < 4; ++d)
#pragma unroll
            for (int g4 = 0; g4 < 4; ++g4) { const f32x4 gv = *(const f32x4*)(gs + 32 * d + 8 * g4);
#pragma unroll
                for (int j = 0; j < 4; ++j) o[d][4 * g4 + j] *= gv[j]; }
        store_o(BR + (size_t)q * 3072 + 1024 + h * 128 + 4 * hi, o, rr);
    }
}

__device__ __forceinline__ void nsa_unit(Frame& F, int g, int qb) {
    const int tid = F.tid, lane = F.lane, w = F.wave, r32 = lane & 31, hi = lane >> 5;
    const bf16_t* Z = WSP(bf16_t, WS_Z); const bf16_t* KC = WSP(bf16_t, WS_KCMP); bf16_t* BR = WSP(bf16_t, WS_BR);
    LAS unsigned char* lds = F.lds;
    const int q0 = 64 * qb, qi = 8 * w + (r32 >> 2), q = q0 + qi, hh = 4 * g + (r32 & 3);
    bf16x8 qf[8];
    { const bf16_t* qrow = Z + (size_t)q * LDZ + ZC_NQ + hh * 128 + 8 * hi;
#pragma unroll
      for (int d0 = 0; d0 < 8; ++d0) qf[d0] = *(const bf16x8*)(qrow + 16 * d0); }
    const float slope = exp2f(-(float)(hh + 1));
    const float c1s = 0.08838834764831845f * LOG2E, c2s = slope * LOG2E, pq = (float)F.pos[q];
    float g0, g1, g2; { const bf16_t* gl = Z + (size_t)q * LDZ + ZC_NG + hh * 3; g0 = sigmoidf_(bf1(gl[0])); g1 = sigmoidf_(bf1(gl[1])); g2 = sigmoidf_(bf1(gl[2])); }
    bf16_t* orow = BR + (size_t)q * 3072 + 2048 + hh * 128 + 4 * hi;
    LAS float* imp = (LAS float*)(lds + L_IMP); LAS unsigned* sel = (LAS unsigned*)(lds + L_SEL); LAS unsigned* ctrl = (LAS unsigned*)(lds + L_CTRL); LAS unsigned* list = (LAS unsigned*)(lds + L_LIST);
    const LAS unsigned char* kl0 = lds + L_K + r32 * 272 + hi * 16;
    const LAS unsigned char* vl0 = lds + L_V + (4 * hi + ((lane & 15) >> 2)) * VRS + (16 * ((lane >> 4) & 1) + 4 * (lane & 3)) * 2;
    f32x16 o[4], p0, p1; TileRegs R; float alpha;
    for (int i = tid; i < 64 * 128; i += NTHREADS) imp[i] = 0.f;
    if (tid < 4) ctrl[4 + tid] = 0u;
    const int ntc = ((4 * qb + 2) >> 6) + 1;
    const int khi_c = q >= 31 ? ((q - 31) >> 4) : -1;
    const bf16_t* kc = KC + ((size_t)(0 * 2 + g) * 512) * 128; const bf16_t* vc = KC + ((size_t)(1 * 2 + g) * 512) * 128;
    float m = -1e30f, l = 0.f;
#define CMP_POS(t) do { if (tid < 64) { int pi = 31 + 16 * ((t) * 64 + tid); pi = pi < S ? pi : S - 1; R.ps = (float)F.pos[pi]; } } while (0)
    load128(R, kc, 128, nullptr, 0, tid); CMP_POS(0);
    for (int t = 0; t < ntc; ++t) { const int b = t & 1;
        store128(R, lds + L_K + b * KBUF, nullptr, (LAS float*)(lds + L_POS + b * PBUF), tid, false, true);
        __syncthreads();
        if (t + 1 < ntc) { load128(R, kc + (size_t)(t + 1) * 64 * 128, 128, nullptr, 0, tid); CMP_POS(t + 1); }
        qk_tile<8, 272>(p0, p1, kl0 + b * KBUF, qf);
        scale_bias<true>(p0, p1, c1s, c2s, pq, (const LAS float*)(lds + L_POS + b * PBUF) + 4 * hi);
        mask_range(p0, p1, 64 * t + 4 * hi, 0, khi_c);
        softmax_step(p0, p1, m, l, alpha);
    }
    __syncthreads();
    l = swapsum(l); const float invl = l > 0.f ? 1.f / l : 0.f;
    load128(R, kc, 128, nullptr, 0, tid); CMP_POS(0);
    for (int t = 0; t < ntc; ++t) { const int b = t & 1;
        store128(R, lds + L_K + b * KBUF, nullptr, (LAS float*)(lds + L_POS + b * PBUF), tid, false, true);
        __syncthreads();
        if (t + 1 < ntc) { load128(R, kc + (size_t)(t + 1) * 64 * 128, 128, nullptr, 0, tid); CMP_POS(t + 1); }
        qk_tile<8, 272>(p0, p1, kl0 + b * KBUF, qf);
        scale_bias<true>(p0, p1, c1s, c2s, pq, (const LAS float*)(lds + L_POS + b * PBUF) + 4 * hi);
        mask_range(p0, p1, 64 * t + 4 * hi, 0, khi_c);
        LAS float* ip = imp + qi * 128 + 16 * t + hi;
#pragma unroll
        for (int k4 = 0; k4 < 4; ++k4) {
            const float e0 = __builtin_amdgcn_exp2f(p0[4 * k4] - m) * invl, e1 = __builtin_amdgcn_exp2f(p0[4 * k4 + 1] - m) * invl, e2 = __builtin_amdgcn_exp2f(p0[4 * k4 + 2] - m) * invl, e3 = __builtin_amdgcn_exp2f(p0[4 * k4 + 3] - m) * invl;
            const float f0 = __builtin_amdgcn_exp2f(p1[4 * k4] - m) * invl, f1 = __builtin_amdgcn_exp2f(p1[4 * k4 + 1] - m) * invl, f2 = __builtin_amdgcn_exp2f(p1[4 * k4 + 2] - m) * invl, f3 = __builtin_amdgcn_exp2f(p1[4 * k4 + 3] - m) * invl;
            const int j0 = 2 * k4, j1 = 8 + 2 * k4;
            __hip_atomic_fetch_add(ip + j0, (e0 + e1) + (e2 + e3), __ATOMIC_RELAXED, __HIP_MEMORY_SCOPE_WORKGROUP);
            if (16 * t + hi + j0 + 1 < 128) __hip_atomic_fetch_add(ip + j0 + 1, e3, __ATOMIC_RELAXED, __HIP_MEMORY_SCOPE_WORKGROUP);
            __hip_atomic_fetch_add(ip + j1, (f0 + f1) + (f2 + f3), __ATOMIC_RELAXED, __HIP_MEMORY_SCOPE_WORKGROUP);
            if (16 * t + hi + j1 + 1 < 128) __hip_atomic_fetch_add(ip + j1 + 1, f3, __ATOMIC_RELAXED, __HIP_MEMORY_SCOPE_WORKGROUP); }
    }
    __syncthreads();
    { unsigned u0 = 0u, u1 = 0u, u2 = 0u, u3 = 0u;
      for (int qq = 0; qq < 8; ++qq) { LAS float* iq = imp + (8 * w + qq) * 128;
          const int j0 = lane, j1 = lane + 64;
          const float v0 = (j0 == 0 || j0 == qb || j0 == qb - 1) ? __builtin_inff() : (j0 <= qb ? iq[j0] : -__builtin_inff());
          const float v1 = (j1 == qb || j1 == qb - 1) ? __builtin_inff() : (j1 <= qb ? iq[j1] : -__builtin_inff());
          WAVE_LDS_SYNC();
          iq[j0] = v0; iq[j1] = v1;
          WAVE_LDS_SYNC();
          int c0 = 0, c1 = 0;
          for (int k4 = 0; k4 <= (qb >> 2); ++k4) { const f32x4 vv = *(const LAS f32x4*)(iq + 4 * k4);
#pragma unroll
              for (int jj = 0; jj < 4; ++jj) { const int k = 4 * k4 + jj; const float vk = vv[jj];
                  c0 += (vk > v0 || (vk == v0 && k < j0)) ? 1 : 0; c1 += (vk > v1 || (vk == v1 && k < j1)) ? 1 : 0; } }
          const unsigned long long mlo = __ballot(c0 < 16 && v0 > -__builtin_inff()), mhi = __ballot(c1 < 16 && v1 > -__builtin_inff());
          const unsigned a0 = (unsigned)mlo, a1 = (unsigned)(mlo >> 32), a2 = (unsigned)mhi, a3 = (unsigned)(mhi >> 32);
          if (lane == 0) { LAS unsigned* sq = sel + (8 * w + qq) * 4; sq[0] = a0; sq[1] = a1; sq[2] = a2; sq[3] = a3; }
          u0 |= a0; u1 |= a1; u2 |= a2; u3 |= a3; }
      if (lane == 0) { __hip_atomic_fetch_or(ctrl + 4, u0, __ATOMIC_RELAXED, __HIP_MEMORY_SCOPE_WORKGROUP); __hip_atomic_fetch_or(ctrl + 5, u1, __ATOMIC_RELAXED, __HIP_MEMORY_SCOPE_WORKGROUP);
          __hip_atomic_fetch_or(ctrl + 6, u2, __ATOMIC_RELAXED, __HIP_MEMORY_SCOPE_WORKGROUP); __hip_atomic_fetch_or(ctrl + 7, u3, __ATOMIC_RELAXED, __HIP_MEMORY_SCOPE_WORKGROUP); }
      __syncthreads();
      if (tid == 0) { int n = 0;
          for (int w4 = 0; w4 < 4; ++w4) { unsigned bits = ctrl[4 + w4]; while (bits) { const int b = __builtin_ctz(bits); bits &= bits - 1u; list[n++] = (unsigned)(32 * w4 + b); } }
          ctrl[8] = (unsigned)n; }
      __syncthreads();
      zero_o(o);
      load128(R, kc, 128, vc, 128, tid); CMP_POS(0);
      for (int t = 0; t < ntc; ++t) { const int b = t & 1;
          store128(R, lds + L_K + b * KBUF, lds + L_V + b * VBUF, (LAS float*)(lds + L_POS + b * PBUF), tid, true, true);
          __syncthreads();
          if (t + 1 < ntc) { load128(R, kc + (size_t)(t + 1) * 64 * 128, 128, vc + (size_t)(t + 1) * 64 * 128, 128, tid); CMP_POS(t + 1); }
          qk_tile<8, 272>(p0, p1, kl0 + b * KBUF, qf);
          scale_bias<true>(p0, p1, c1s, c2s, pq, (const LAS float*)(lds + L_POS + b * PBUF) + 4 * hi);
          mask_range(p0, p1, 64 * t + 4 * hi, 0, khi_c);
#pragma unroll
          for (int r = 0; r < 16; ++r) { p0[r] = __builtin_amdgcn_exp2f(p0[r] - m) * invl; p1[r] = __builtin_amdgcn_exp2f(p1[r] - m) * invl; }
          pv_tile(o, p0, p1, vl0 + b * VBUF);
      }
      __syncthreads();
      store_o(orow, o, g0);
#undef CMP_POS
      const unsigned s0 = sel[qi * 4 + 0], s1 = sel[qi * 4 + 1], s2 = sel[qi * 4 + 2], s3 = sel[qi * 4 + 3];
      const int nb = (int)ctrl[8];
      const bf16_t* ks = Z + ZC_NKV + ((1 * 2 + 0) * 2 + g) * 128; const bf16_t* vs = Z + ZC_NKV + ((1 * 2 + 1) * 2 + g) * 128;
      m = -1e30f; l = 0.f; zero_o(o);
      if (nb > 0) { const int j = (int)list[0]; load128(R, ks + (size_t)j * 64 * LDZ, LDZ, vs + (size_t)j * 64 * LDZ, LDZ, tid); if (tid < 64) R.ps = (float)F.pos[64 * j + tid]; }
      for (int t = 0; t < nb; ++t) { const int b = t & 1; const int j = (int)list[t];
          store128(R, lds + L_K + b * KBUF, lds + L_V + b * VBUF, (LAS float*)(lds + L_POS + b * PBUF), tid, true, true);
          __syncthreads();
          if (t + 1 < nb) { const int jn = (int)list[t + 1]; load128(R, ks + (size_t)jn * 64 * LDZ, LDZ, vs + (size_t)jn * 64 * LDZ, LDZ, tid); if (tid < 64) R.ps = (float)F.pos[64 * jn + tid]; }
          const unsigned wsel = (j < 32 ? u0 : j < 64 ? u1 : j < 96 ? u2 : u3) >> (j & 31);
          if (wsel & 1u) {
              const unsigned mine = ((j < 32 ? s0 : j < 64 ? s1 : j < 96 ? s2 : s3) >> (j & 31)) & 1u;
              qk_tile<8, 272>(p0, p1, kl0 + b * KBUF, qf);
              scale_bias<true>(p0, p1, c1s, c2s, pq, (const LAS float*)(lds + L_POS + b * PBUF) + 4 * hi);
              mask_range(p0, p1, 64 * j + 4 * hi, 0, mine ? q : -1);
              softmax_step(p0, p1, m, l, alpha); rescale(o, alpha);
              pv_tile(o, p0, p1, vl0 + b * VBUF);
          }
      }
      __syncthreads();
      l = swapsum(l); addstore_o(orow, o, l > 0.f ? g1 / l : 0.f);
    }
    { const bf16_t* kw = Z + ZC_NKV + ((2 * 2 + 0) * 2 + g) * 128; const bf16_t* vw = Z + ZC_NKV + ((2 * 2 + 1) * 2 + g) * 128;
      const int kb0 = q0 >= 512 ? q0 - 512 : 0, nw = (q0 - kb0) / 64 + 1;
      m = -1e30f; l = 0.f; zero_o(o);
      load128(R, kw + (size_t)kb0 * LDZ, LDZ, vw + (size_t)kb0 * LDZ, LDZ, tid); if (tid < 64) R.ps = (float)F.pos[kb0 + tid];
      for (int t = 0; t < nw; ++t) { const int b = t & 1; const int kb = kb0 + 64 * t;
          store128(R, lds + L_K + b * KBUF, lds + L_V + b * VBUF, (LAS float*)(lds + L_POS + b * PBUF), tid, true, true);
          __syncthreads();
          if (t + 1 < nw) { load128(R, kw + (size_t)(kb + 64) * LDZ, LDZ, vw + (size_t)(kb + 64) * LDZ, LDZ, tid); if (tid < 64) R.ps = (float)F.pos[kb + 64 + tid]; }
          qk_tile<8, 272>(p0, p1, kl0 + b * KBUF, qf);
          scale_bias<true>(p0, p1, c1s, c2s, pq, (const LAS float*)(lds + L_POS + b * PBUF) + 4 * hi);
          if (t == 0 || t == nw - 1) mask_range(p0, p1, kb + 4 * hi, q - 511, q);
          softmax_step(p0, p1, m, l, alpha); rescale(o, alpha);
          pv_tile(o, p0, p1, vl0 + b * VBUF);
      }
      __syncthreads();
      l = swapsum(l); addstore_o(orow, o, l > 0.f ? g2 / l : 0.f);
    }
}
}

#ifndef FAST_MLA
#define FAST_MLA 1
#endif
#ifndef FAST_DIFF
#define FAST_DIFF 1
#endif
#ifndef FAST_NSA
#define FAST_NSA 1
#endif
constexpr int ATT_NITEMS = 1024;
__device__ const unsigned short ATT_ORDER[ATT_NITEMS] = {
  31,287,543,799,1055,1311,1567,1823,30,286,542,798,1054,1310,1566,1822,29,285,541,797,1053,1309,1565,1821,28,284,540,796,1052,1308,1564,1820,
  27,283,539,795,1051,1307,1563,1819,26,282,538,794,1050,1306,1562,1818,25,281,537,793,1049,1305,1561,1817,24,280,536,792,1048,1304,1560,1816,
  23,279,535,791,1047,1303,1559,1815,22,278,534,790,1046,1302,1558,1814,21,277,533,789,1045,1301,1557,1813,20,276,532,788,1044,1300,1556,1812,
  19,275,531,787,1043,1299,1555,1811,4159,4415,4671,4927,5183,5439,5695,5951,18,274,530,786,1042,1298,1554,1810,4158,4414,4670,4926,5182,5438,5694,5950,
  4157,4413,4669,4925,5181,5437,5693,5949,4156,4412,4668,4924,5180,5436,5692,5948,17,273,529,785,1041,1297,1553,1809,4155,4411,4667,4923,5179,5435,5691,5947,
  4154,4410,4666,4922,5178,5434,5690,5946,4153,4409,4665,4921,5177,5433,5689,5945,4152,4408,4664,4920,5176,5432,5688,5944,16,272,528,784,1040,1296,1552,1808,
  4151,4407,4663,4919,5175,5431,5687,5943,4150,4406,4662,4918,5174,5430,5686,5942,4149,4405,4661,4917,5173,5429,5685,5941,15,271,527,783,1039,1295,1551,1807,
  4148,4404,4660,4916,5172,5428,5684,5940,4147,4403,4659,4915,5171,5427,5683,5939,4146,4402,4658,4914,5170,5426,5682,5938,14,270,526,782,1038,1294,1550,1806,
  4145,4401,4657,4913,5169,5425,5681,5937,8319,8575,4144,4400,4656,4912,5168,5424,5680,5936,8318,8574,8317,8573,8316,8572,8315,8571,8314,8570,8313,8569,4143,4399,
  4655,4911,5167,5423,5679,5935,8312,8568,8311,8567,8310,8566,8309,8565,8308,8564,8307,8563,4142,4398,4654,4910,5166,5422,5678,5934,8306,8562,8305,8561,13,269,
  525,781,1037,1293,1549,1805,8304,8560,4141,4397,4653,4909,5165,5421,5677,5933,8303,8559,8302,8558,8301,8557,4140,4396,4652,4908,5164,5420,5676,5932,8300,8556,
  8299,8555,8298,8554,8297,8553,8296,8552,8295,8551,4139,4395,4651,4907,5163,5419,5675,5931,8294,8550,8293,8549,8292,8548,8291,8547,12,268,524,780,1036,1292,
  1548,1804,8290,8546,8289,8545,4138,4394,4650,4906,5162,5418,5674,5930,8288,8544,4137,4393,4649,4905,5161,5417,5673,5929,8287,8543,8286,8542,8285,8541,8284,8540,
  8283,8539,4136,4392,4648,4904,5160,5416,5672,5928,8282,8538,8281,8537,8280,8536,8279,8535,8278,8534,8277,8533,11,267,523,779,1035,1291,1547,1803,4135,4391,
  4647,4903,5159,5415,5671,5927,8276,8532,8275,8531,8274,8530,8273,8529,8272,8528,4134,4390,4646,4902,5158,5414,5670,5926,8271,8527,4133,4389,4645,4901,5157,5413,
  5669,5925,8270,8526,8269,8525,8268,8524,8267,8523,8266,8522,8265,8521,4132,4388,4644,4900,5156,5412,5668,5924,8264,8520,8263,8519,10,266,522,778,1034,1290,
  1546,1802,8262,8518,8261,8517,8260,8516,8259,8515,4131,4387,4643,4899,5155,5411,5667,5923,8258,8514,8257,8513,8256,8512,4130,4386,4642,4898,5154,5410,5666,5922,
  8255,8511,8254,8510,8253,8509,4129,4385,4641,4897,5153,5409,5665,5921,8252,8508,8251,8507,8250,8506,8249,8505,9,265,521,777,1033,1289,1545,1801,8248,8504,
  8247,8503,4128,4384,4640,4896,5152,5408,5664,5920,8246,8502,8245,8501,8244,8500,8243,8499,8242,8498,8241,8497,4127,4383,4639,4895,5151,5407,5663,5919,8240,8496,
  4126,4382,4638,4894,5150,5406,5662,5918,8239,8495,8238,8494,8237,8493,8236,8492,8235,8491,8,264,520,776,1032,1288,1544,1800,4125,4381,4637,4893,5149,5405,
  5661,5917,8234,8490,8233,8489,8232,8488,8231,8487,8230,8486,8229,8485,4124,4380,4636,4892,5148,5404,5660,5916,8228,8484,8227,8483,8226,8482,8225,8481,8224,8480,
  4123,4379,4635,4891,5147,5403,5659,5915,8223,8479,4122,4378,4634,4890,5146,5402,5658,5914,8222,8478,8221,8477,7,263,519,775,1031,1287,1543,1799,8220,8476,
  8219,8475,8218,8474,8217,8473,4121,4377,4633,4889,5145,5401,5657,5913,8216,8472,8215,8471,8214,8470,8213,8469,8212,8468,8211,8467,4120,4376,4632,4888,5144,5400,
  5656,5912,8210,8466,4119,4375,4631,4887,5143,5399,5655,5911,8209,8465,6,262,518,774,1030,1286,1542,1798,4118,4374,4630,4886,5142,5398,5654,5910,8208,8464,
  4117,4373,4629,4885,5141,5397,5653,5909,4116,4372,4628,4884,5140,5396,5652,5908,8207,8463,5,261,517,773,1029,1285,1541,1797,4115,4371,4627,4883,5139,5395,
  5651,5907,8206,8462,8205,8461,4114,4370,4626,4882,5138,5394,5650,5906,8204,8460,4113,4369,4625,4881,5137,5393,5649,5905,8203,8459,4112,4368,4624,4880,5136,5392,
  5648,5904,4,260,516,772,1028,1284,1540,1796,8202,8458,4111,4367,4623,4879,5135,5391,5647,5903,8201,8457,4110,4366,4622,4878,5134,5390,5646,5902,8200,8456,
  4109,4365,4621,4877,5133,5389,5645,5901,8199,8455,3,259,515,771,1027,1283,1539,1795,4108,4364,4620,4876,5132,5388,5644,5900,4107,4363,4619,4875,5131,5387,
  5643,5899,8198,8454,4106,4362,4618,4874,5130,5386,5642,5898,8197,8453,2,258,514,770,1026,1282,1538,1794,4105,4361,4617,4873,5129,5385,5641,5897,4104,4360,
  4616,4872,5128,5384,5640,5896,8196,8452,4103,4359,4615,4871,5127,5383,5639,5895,8195,8451,4102,4358,4614,4870,5126,5382,5638,5894,1,257,513,769,1025,1281,
  1537,1793,4101,4357,4613,4869,5125,5381,5637,5893,8194,8450,4100,4356,4612,4868,5124,5380,5636,5892,8193,8449,4099,4355,4611,4867,5123,5379,5635,5891,0,256,
  512,768,1024,1280,1536,1792,4098,4354,4610,4866,5122,5378,5634,5890,8192,8448,4097,4353,4609,4865,5121,5377,5633,5889,4096,4352,4608,4864,5120,5376,5632,5888,
};

__device__ __forceinline__ void attn_phase(Frame& F, const Args& args, int l) {
    LAS int* slot = (LAS int*)(F.lds + fa::L_CTRL);
    gu32* head = F.ctl + CW_QUEUE + 64 * l;
    for (;;) {
        __syncthreads();
        if (F.tid == 0) *slot = (int)__hip_atomic_fetch_add(head, 1u, __ATOMIC_RELAXED, __HIP_MEMORY_SCOPE_AGENT);
        __syncthreads();
        const int idx = *slot;
        if (idx >= ATT_NITEMS) break;
        fresh(F, args);
        const unsigned code = ATT_ORDER[idx]; const int type = code >> 12, hd = (code >> 8) & 15, qb = code & 255;
        if (type == 0) { if (FAST_MLA) fa::mla_unit(F, hd, qb); }
        else if (type == 1) { if (FAST_DIFF) fa::diff_unit(F, args, l, hd, qb); }
        else { if (FAST_NSA) fa::nsa_unit(F, hd, qb); }
    }
}

#ifndef MK_N_LAUNCHES
#define MK_N_LAUNCHES 1
#endif
constexpr int NPHASE = 2 + 9 * NL;
__global__ void __launch_bounds__(NTHREADS, 2) fwd(Args args) {
    extern __shared__ __attribute__((aligned(16))) unsigned char lds[];
    Frame F;
    F.lds = (LAS unsigned char*)lds;
    F.MISC = (volatile LAS unsigned*)(F.lds + MISC_OFF);
    F.tid = threadIdx.x; F.lane = F.tid & 63; F.wave = __builtin_amdgcn_readfirstlane(F.tid >> 6);
    F.G = gridDim.x; F.bid = blockIdx.x; F.gw = blockIdx.x * NWAVES + F.wave; F.NGW = F.G * NWAVES;
    F.pos = (const int*)args.in[IN_POS]; F.out = args.out; F.ws = (GAS unsigned char*)args.ws;
    F.ctl = (gu32*)(F.ws + WS_CTL);
    for (int u = F.tid; u < (LDS_BYTES - MISC_OFF) / 4; u += NTHREADS) ((LAS unsigned*)(F.lds + MISC_OFF))[u] = 0u;
    __syncthreads();
    const int lo = args.ph_lo, hi = args.ph_hi;
    XcdBarrier bar; bar.bar = (unsigned*)(F.ctl + CW_BAR); bar.x = 0; bar.st = F.MISC + 8;
    if (hi - lo > 1) bar = xcd_barrier_post((unsigned*)(F.ctl + CW_BAR), F.MISC + 8);
#define IN(k) (lo <= (k) && (k) < hi)
#define SEAM(k) do { if (IN(k) && IN((k) + 1)) xcd_barrier(bar); } while (0)

#define Z WSP(bf16_t, WS_Z)
#define H WSP(bf16_t, WS_H)
#define X WSP(float, WS_X)
#define Y WSP(float, WS_Y)
#define SSQ WSP(float, WS_SSQ)
#define MODL (WSP(float, WS_MOD) + (size_t)l * 6 * D)

    #ifndef SKIP_P0
    if (IN(0)) { fresh(F, args); p0_prologue(F, args); }
#endif
    SEAM(0);

    for (int l = 0; l < NL; ++l) {
        const int pb = 1 + 9 * l;
        if (IN(pb + 0)) { fresh(F, args);
            if (l == 0) ln_rows(F, args.in[IN_X], false, nullptr, nullptr, nullptr, true, MODL, MODL + D, H, SSQ);
            else ln_rows(F, Y, true, args.in[IN_LN2G] + (size_t)(l - 1) * D, args.in[IN_LN2B] + (size_t)(l - 1) * D, X, true, MODL, MODL + D, H, SSQ);
        }
        SEAM(pb + 0);
        if (IN(pb + 1)) { fresh(F, args);
            pg8::Gemm g{H, WLP(bf16_t, l, WL_IN), D, D, D, 0, 0}; pg8::PlainOrder So; So.init(S, LDZ, F.G, F.bid);
            pg8::EpiZ E{Z, SSQ};
            pg8::gemm_phase<pg8::EpiZ, pg8::PlainOrder, true>(F.lds, g, So, E, F.tid);
        }
        SEAM(pb + 1);
        if (IN(pb + 2)) {
            { fresh(F, args); pg8::Gemm g{Z + ZC_CQ, WLP(bf16_t, l, WL_UQ), 512, LDZ, 512, 0, 0}; pg8::PlainOrder So; So.init(S, 1536, F.G, F.bid);
              pg8::EpiRs E{WSP(bf16_t, WS_QM), 1536, SSQ, 0, 1.f / 512.f};
              pg8::gemm_phase<pg8::EpiRs, pg8::PlainOrder, false>(F.lds, g, So, E, F.tid); }
            { fresh(F, args); pg8::Gemm g{Z + ZC_CKV, WLP(bf16_t, l, WL_UKV), 256, LDZ, 256, 0, 0}; pg8::PlainOrder So; So.init(S, 2048, F.G, F.bid);
              pg8::EpiRs E{WSP(bf16_t, WS_KVM), 2048, SSQ, 1, 1.f / 256.f};
              pg8::gemm_phase<pg8::EpiRs, pg8::PlainOrder, false>(F.lds, g, So, E, F.tid); }
#ifndef SKIP_SIDE
            fresh(F, args); krope_job(F);
            compress_naive(F, args, l);
#endif
        }
        SEAM(pb + 2);
        if (IN(pb + 3)) { fresh(F, args); attn_phase(F, args, l);
#if !(FAST_MLA && FAST_DIFF && FAST_NSA)
            __syncthreads(); fresh(F, args); attn_naive(F, args, l, !FAST_MLA, !FAST_DIFF, !FAST_NSA);
#endif
        }
        SEAM(pb + 3);

#ifdef DIAG
        if (l == 0) {
            xcd_barrier(bar); fresh(F, args);
            attn_naive(F, args, 0, true, true, true, WS_MIX);
            xcd_barrier(bar); fresh(F, args);
            { const bf16_t* A = WSP(bf16_t, WS_BR); const bf16_t* B = WSP(bf16_t, WS_MIX); unsigned* res = (unsigned*)(F.ctl + 32768);
              for (int row = F.gw; row < S; row += F.NGW) { float mx[3] = {0.f, 0.f, 0.f};
#pragma unroll
                  for (int br = 0; br < 3; ++br) { for (int c = F.lane; c < 1024; c += 64) { const float d = fabsf(bf1(A[(size_t)row * 3072 + br * 1024 + c]) - bf1(B[(size_t)row * 3072 + br * 1024 + c])); mx[br] = fmaxf(mx[br], d); }
                      mx[br] = wave_max(mx[br]); }
                  if (F.lane == 0) { for (int br = 0; br < 3; ++br) { atomicMax(res + 64 * br, __builtin_bit_cast(unsigned, mx[br]));
                      if (mx[br] > DIAG_THR) { atomicAdd(res + 64 * (3 + br), 1u); atomicMax(res + 64 * (6 + br), 0x7fffffffu - (unsigned)row); atomicMax(res + 64 * (9 + br), (unsigned)row); } } } } }
            xcd_barrier(bar); fresh(F, args);
            { const unsigned* res = (const unsigned*)(F.ctl + 32768);
              float v[12]; for (int i = 0; i < 3; ++i) v[i] = __builtin_bit_cast(float, __hip_atomic_load(res + 64 * i, __ATOMIC_RELAXED, __HIP_MEMORY_SCOPE_AGENT));
              for (int i = 3; i < 6; ++i) v[i] = (float)__hip_atomic_load(res + 64 * i, __ATOMIC_RELAXED, __HIP_MEMORY_SCOPE_AGENT);
              for (int i = 6; i < 9; ++i) v[i] = (float)(0x7fffffffu - __hip_atomic_load(res + 64 * i, __ATOMIC_RELAXED, __HIP_MEMORY_SCOPE_AGENT));
              for (int i = 9; i < 12; ++i) v[i] = (float)__hip_atomic_load(res + 64 * i, __ATOMIC_RELAXED, __HIP_MEMORY_SCOPE_AGENT);
              const float Aval = DIAG_A, Bval = DIAG_B;
              for (size_t i = (size_t)F.bid * NTHREADS + F.tid; i < (size_t)S * D; i += (size_t)F.G * NTHREADS) F.out[i] = (i == 0) ? Aval : Bval; }
            return;
        }
#endif
        if (IN(pb + 4)) { fresh(F, args);
            pg8::Gemm g{WSP(bf16_t, WS_BR), WLP(bf16_t, l, WL_BR), 1024, 3072, 1024, 1024, (size_t)D * 1024}; pg8::SliceOrder<3> So; So.init(S, D, F.G, F.bid);
            pg8::EpiMix E{Z + ZC_MG, WSP(float, WS_MIX), WSP(bf16_t, WS_MIXB)};
            pg8::gemm_phase<pg8::EpiMix, pg8::SliceOrder<3>, true>(F.lds, g, So, E, F.tid);
        }
        SEAM(pb + 4);
        if (IN(pb + 5)) { fresh(F, args);
            pg8::Gemm g{WSP(bf16_t, WS_MIXB), WLP(bf16_t, l, WL_OUT), D, D, D, 0, 0}; pg8::PlainOrder So; So.init(S, D, F.G, F.bid);
            pg8::EpiRes E{l == 0 ? args.in[IN_X] : X, MODL + 2 * D, Y};
            pg8::gemm_phase<pg8::EpiRes, pg8::PlainOrder, false>(F.lds, g, So, E, F.tid);
        }
        SEAM(pb + 5);
        if (IN(pb + 6)) { fresh(F, args); ln_rows(F, Y, true, args.in[IN_LN1G] + (size_t)l * D, args.in[IN_LN1B] + (size_t)l * D, X, true, MODL + 3 * D, MODL + 4 * D, H, nullptr); }
        SEAM(pb + 6);
        if (IN(pb + 7)) { fresh(F, args);
            pg8::Gemm g{H, WLP(bf16_t, l, WL_FF1), D, D, D, 0, 0}; pg8::PlainOrder So; So.init(S, FF, F.G, F.bid);
            pg8::EpiRelu2 E{Z  , FF};
            pg8::gemm_phase<pg8::EpiRelu2, pg8::PlainOrder, true>(F.lds, g, So, E, F.tid);
        }
        SEAM(pb + 7);
        if (IN(pb + 8)) { fresh(F, args);
            pg8::Gemm g{Z, WLP(bf16_t, l, WL_FF2), FF, FF, FF, 0, 0}; pg8::PlainOrder So; So.init(S, D, F.G, F.bid);
            pg8::EpiRes E{X, MODL + 5 * D, Y};
            pg8::gemm_phase<pg8::EpiRes, pg8::PlainOrder, false>(F.lds, g, So, E, F.tid);
        }
        SEAM(pb + 8);
    }
    if (IN(NPHASE - 1)) { fresh(F, args); ln_rows(F, Y, true, args.in[IN_LN2G] + (size_t)(NL - 1) * D, args.in[IN_LN2B] + (size_t)(NL - 1) * D, F.out, false, nullptr, nullptr, nullptr, nullptr); }
#undef IN
#undef SEAM
#undef Z
#undef H
#undef X
#undef Y
#undef SSQ
#undef MODL
}

extern "C" void kernel_launch(void* const* d_in, const int* in_sizes, int n_in, void* d_out, int out_size, void* d_ws, size_t ws_size, hipStream_t stream) {
    static int grid = 0;
    if (grid == 0) {
        if (n_in != 23 || in_sizes[0] != S * D || out_size != S * D || ws_size < WS_END) {
            fprintf(stderr, "kernel_launch: shape mismatch: n_in %d in0 %d out %d ws %zu (need %zu)\n", n_in, n_in > 0 ? in_sizes[0] : -1, out_size, ws_size, (size_t)WS_END); grid = -1; return; }
        int dev = 0, cus = 0, per_cu = 0;
        if (hipGetDevice(&dev) != hipSuccess || hipDeviceGetAttribute(&cus, hipDeviceAttributeMultiprocessorCount, dev) != hipSuccess) { fprintf(stderr, "kernel_launch: device query failed\n"); grid = -1; return; }
        if (hipFuncSetAttribute((const void*)fwd, hipFuncAttributeMaxDynamicSharedMemorySize, LDS_BYTES) != hipSuccess) { fprintf(stderr, "kernel_launch: hipFuncSetAttribute failed\n"); grid = -1; return; }
        if (hipOccupancyMaxActiveBlocksPerMultiprocessor(&per_cu, (const void*)fwd, NTHREADS, LDS_BYTES) != hipSuccess || per_cu < 1) { fprintf(stderr, "kernel_launch: occupancy query says %d\n", per_cu); }
        (void)hipGetLastError();
        grid = cus;
    }
    if (grid < 0) return;
    if (hipMemsetAsync((char*)d_ws + WS_CTL, 0, CTL_ZERO_BYTES, stream) != hipSuccess) { fprintf(stderr, "kernel_launch: memset failed\n"); return; }
    Args a{};
    for (int i = 0; i < 23; ++i) a.in[i] = (const float*)d_in[i];
    a.out = (float*)d_out; a.ws = (unsigned char*)d_ws;
#if MK_N_LAUNCHES == 1
    a.ph_lo = 0; a.ph_hi = NPHASE;
    hipLaunchKernelGGL(fwd, dim3(grid), dim3(NTHREADS), LDS_BYTES, stream, a);
#else
    for (int p = 0; p < NPHASE; ++p) { a.ph_lo = p; a.ph_hi = p + 1; hipLaunchKernelGGL(fwd, dim3(grid), dim3(NTHREADS), LDS_BYTES, stream, a); }
#endif
    const hipError_t le = hipPeekAtLastError();
    if (le != hipSuccess) fprintf(stderr, "kernel_launch: launch failed: %s\n", hipGetErrorName(le));
}
```

```cpp
#include <hip/hip_runtime.h>
#include <cstdio>
#include <cstdint>

#define LAS __attribute__((address_space(3)))
#define GAS __attribute__((address_space(1)))
typedef unsigned short bf16_t;
typedef short bf16x8 __attribute__((ext_vector_type(8)));
typedef short s16x4 __attribute__((ext_vector_type(4)));
typedef float f32x4 __attribute__((ext_vector_type(4)));
typedef float f32x2 __attribute__((ext_vector_type(2)));
typedef float f32x16 __attribute__((ext_vector_type(16)));
typedef unsigned u32x4 __attribute__((ext_vector_type(4)));
typedef unsigned u32x2 __attribute__((ext_vector_type(2)));
typedef GAS unsigned gu32;

constexpr int S = 8192, D = 2048, NL = 4, FF = 8192;
constexpr int LDZ = 12800;
constexpr int ZC_CQ = 0, ZC_CKV = 512, ZC_DQ = 768, ZC_DK = 1792, ZC_DV = 2816, ZC_NQ = 3840, ZC_NKV = 4864, ZC_MG = 6400, ZC_KR = 12544, ZC_NG = 12608;
constexpr int DIN_SRC = 12632;
constexpr float ALPHA_RES = 1.6817928305074292f;
constexpr int NWAVES = 8, NTHREADS = 512;

__host__ __device__ __forceinline__ int zsrc(int n) {
    if (n < 768) return n;
    if (n < 6400) return n + 64;
    if (n < 12544) return n + 88;
    if (n < 12608) return n - 12544 + 768;
    if (n < 12632) return n - 12608 + 6464;
    return -1;
}

constexpr size_t MiB = 1u << 20;
constexpr size_t WS_CTL = 0, CTL_ZERO_BYTES = 1 * MiB;
constexpr size_t WS_MOD = 1 * MiB;
constexpr size_t WS_ROPE = 2 * MiB;
constexpr size_t WS_SSQ = 4 * MiB;
constexpr size_t WS_KCMP = 5 * MiB;
constexpr size_t WS_KROPE = 6 * MiB;
constexpr size_t WS_X = 8 * MiB;
constexpr size_t WS_Y = 72 * MiB;
constexpr size_t WS_MIX = 136 * MiB;
constexpr size_t WS_H = 200 * MiB;
constexpr size_t WS_MIXB = 232 * MiB;
constexpr size_t WS_QM = 264 * MiB;
constexpr size_t WS_KVM = 288 * MiB;
constexpr size_t WS_BR = 320 * MiB;
constexpr size_t WS_Z = 368 * MiB;
constexpr size_t WS_W = 568 * MiB;
constexpr size_t WL_STRIDE = 140 * MiB;
constexpr size_t WL_IN = 0, WL_FF1 = 50 * MiB, WL_FF2 = 82 * MiB, WL_BR = 114 * MiB, WL_OUT = 126 * MiB, WL_UQ = 134 * MiB, WL_UKV = 136 * MiB, WL_C1 = 137 * MiB, WL_C2 = 139 * MiB;
constexpr size_t WS_END = WS_W + NL * WL_STRIDE;

constexpr int CW_BAR = 4096;
constexpr int CW_QUEUE = 16384;

constexpr int RING_BYTES = 131072;
constexpr int MISC_OFF = RING_BYTES;
constexpr int LDS_BYTES = RING_BYTES + 1024;

#define RLX_AGENT __ATOMIC_RELAXED, __HIP_MEMORY_SCOPE_AGENT
#define LDS_WAIT() asm volatile("s_waitcnt lgkmcnt(0)" ::: "memory")
#define VM_WAIT() asm volatile("s_waitcnt vmcnt(0)" ::: "memory")
__device__ __forceinline__ unsigned f2bf(float f) { unsigned u = __builtin_bit_cast(unsigned, f); return (u + 0x7fffu + ((u >> 16) & 1u)) >> 16; }
__device__ __forceinline__ unsigned pk2(float lo, float hi) { return f2bf(lo) | (f2bf(hi) << 16); }
__device__ __forceinline__ float bflo(unsigned w) { return __builtin_bit_cast(float, w << 16); }
__device__ __forceinline__ float bfhi(unsigned w) { return __builtin_bit_cast(float, w & 0xffff0000u); }
__device__ __forceinline__ float bf1(bf16_t h) { return __builtin_bit_cast(float, ((unsigned)h) << 16); }
__device__ __forceinline__ float wave_sum(float v) {
#pragma unroll
    for (int o = 1; o < 64; o <<= 1) v += __shfl_xor(v, o);
    return v;
}
__device__ __forceinline__ float wave_max(float v) {
#pragma unroll
    for (int o = 1; o < 64; o <<= 1) v = fmaxf(v, __shfl_xor(v, o));
    return v;
}
__device__ __forceinline__ float sigmoidf_(float x) { return 1.f / (1.f + __expf(-x)); }
#define MK_N_LAUNCHES 1
namespace pg8 {
#define PG8_LAS __attribute__((address_space(3)))
constexpr int BM = 256, BK = 64, HALF = 128, HTB = HALF * BK * 2  , STAGE_BYTES = 8 * HTB, NXCD = 8, WGM = 8;

__host__ __device__ __forceinline__ int lds_byte(int r, int c) { const int st = (r >> 4) * 2 + (c >> 5), rr = r & 15, cc = c & 31, ob = rr * 64 + cc * 2; return st * 1024 + (ob ^ (((ob >> 9) & 1) << 5)); }
__host__ __device__ __forceinline__ void stage_rc(int b, int& R, int& C) { const int st = b / 1024, sb = b % 1024, swz = sb ^ (((sb >> 9) & 1) << 5); R = (st >> 1) * 16 + swz / 64; C = (st & 1) * 32 + (swz % 64) / 2; }
__host__ __device__ __forceinline__ int perm32(int rho) { const int n = rho >> 4, i = rho & 15; return 8 * (i >> 2) + 4 * n + (i & 3); }

struct Unit { int pm, pn, z; };
struct Gemm { const bf16_t* A; const bf16_t* Bt; int K, lda, ldb; size_t az, bz; };

__host__ __device__ __forceinline__ void tile_of(int wgid, int nM, int nN, int& pm, int& pn) {
    const int nwg = nM * nN;
    { const int q = nwg / NXCD, r = nwg % NXCD, xcd = wgid % NXCD, off = wgid / NXCD; wgid = (xcd < r ? xcd * (q + 1) : r * (q + 1) + (xcd - r) * q) + off; }
    const int nig = WGM * nN, gid = wgid / nig, fm = gid * WGM, gsz = (nM - fm) < WGM ? (nM - fm) : WGM;
    pm = fm + ((wgid % nig) % gsz); pn = (wgid % nig) / gsz;
}
struct PlainOrder {
    int nM, nN, nwg, G, c;
    __host__ __device__ void init(int M, int N, int G_, int c_) { nM = M / BM; nN = N / BM; nwg = nM * nN; G = G_; c = c_; }
    __host__ __device__ bool next(int i, Unit& u) const {
        const long L = (long)i * G + c; if (L >= nwg) return false;
        tile_of((int)L, nM, nN, u.pm, u.pn); u.z = 0; return true;
    }
    __device__ __forceinline__ void a_ready(const Unit&) const {}
    __device__ __forceinline__ void done(const Unit&) const {}
};
template <int NZ> struct SliceOrder {
    int nM, nN, nwg, G, c;
    __host__ __device__ void init(int M, int N, int G_, int c_) { nM = M / BM; nN = N / BM; nwg = nM * nN; G = G_; c = c_; }
    __host__ __device__ bool next(int i, Unit& u) const {
        const long L = (long)(i / NZ) * G + c; if (L >= nwg) return false;
        tile_of((int)L, nM, nN, u.pm, u.pn); u.z = i % NZ; return true;
    }
    __device__ __forceinline__ void a_ready(const Unit&) const {}
    __device__ __forceinline__ void done(const Unit&) const {}
};

__device__ __forceinline__ unsigned cvt_pk_bf16(float lo, float hi) { unsigned r; asm volatile("v_cvt_pk_bf16_f32 %0, %1, %2" : "=v"(r) : "v"(lo), "v"(hi)); return r; }


struct EpiZ {
    static constexpr bool PERM = true, AFTER_DRAIN = false;
    bf16_t* Z; float* ssq;
    __device__ __forceinline__ void operator()(const f32x4 (&acc)[2][2][4][2], const Unit& u, int wr, int wc, int fr, int fq) const {
        const int row0 = u.pm * BM + wr * 64 + fr, col0 = u.pn * BM + wc * 32 + 8 * fq;
#pragma unroll
        for (int ai = 0; ai < 2; ++ai)
#pragma unroll
            for (int m = 0; m < 4; ++m) { const int row = row0 + ai * HALF + m * 16; bf16_t* rowp = Z + (size_t)row * LDZ + col0; float ss = 0.f;
#pragma unroll
                for (int bj = 0; bj < 2; ++bj) { const f32x4 v0 = acc[ai][bj][m][0], v1 = acc[ai][bj][m][1];
                    ss += (v0[0] * v0[0] + v0[1] * v0[1]) + (v0[2] * v0[2] + v0[3] * v0[3]) + (v1[0] * v1[0] + v1[1] * v1[1]) + (v1[2] * v1[2] + v1[3] * v1[3]);
                    u32x4 w; w.x = cvt_pk_bf16(v0[0], v0[1]); w.y = cvt_pk_bf16(v0[2], v0[3]); w.z = cvt_pk_bf16(v1[0], v1[1]); w.w = cvt_pk_bf16(v1[2], v1[3]);
                    *(u32x4*)(rowp + bj * HALF) = w; }
                if (ssq && u.pn < 3) { ss += __shfl_xor(ss, 16); ss += __shfl_xor(ss, 32);
                    if (fq == 0) __hip_atomic_fetch_add(ssq + (size_t)row * 2 + (u.pn == 2 ? 1 : 0), ss, __ATOMIC_RELAXED, __HIP_MEMORY_SCOPE_AGENT); } }
    }
};
struct EpiRs {
    static constexpr bool PERM = true, AFTER_DRAIN = false;
    bf16_t* O; int ldc; const float* ssq; int which; float invK;
    __device__ __forceinline__ void operator()(const f32x4 (&acc)[2][2][4][2], const Unit& u, int wr, int wc, int fr, int fq) const {
        const int row0 = u.pm * BM + wr * 64 + fr, col0 = u.pn * BM + wc * 32 + 8 * fq;
#pragma unroll
        for (int ai = 0; ai < 2; ++ai)
#pragma unroll
            for (int m = 0; m < 4; ++m) { const int row = row0 + ai * HALF + m * 16; bf16_t* rowp = O + (size_t)row * ldc + col0;
                const float rs = 1.0f / sqrtf(ssq[(size_t)row * 2 + which] * invK + 1e-6f);
#pragma unroll
                for (int bj = 0; bj < 2; ++bj) { const f32x4 v0 = acc[ai][bj][m][0] * rs, v1 = acc[ai][bj][m][1] * rs;
                    u32x4 w; w.x = cvt_pk_bf16(v0[0], v0[1]); w.y = cvt_pk_bf16(v0[2], v0[3]); w.z = cvt_pk_bf16(v1[0], v1[1]); w.w = cvt_pk_bf16(v1[2], v1[3]);
                    *(u32x4*)(rowp + bj * HALF) = w; } }
    }
};
struct EpiRelu2 {
    static constexpr bool PERM = true, AFTER_DRAIN = false;
    bf16_t* O; int ldc;
    __device__ __forceinline__ void operator()(const f32x4 (&acc)[2][2][4][2], const Unit& u, int wr, int wc, int fr, int fq) const {
        const int row0 = u.pm * BM + wr * 64 + fr, col0 = u.pn * BM + wc * 32 + 8 * fq;
#pragma unroll
        for (int ai = 0; ai < 2; ++ai)
#pragma unroll
            for (int m = 0; m < 4; ++m) { bf16_t* rowp = O + (size_t)(row0 + ai * HALF + m * 16) * ldc + col0;
#pragma unroll
                for (int bj = 0; bj < 2; ++bj) { f32x4 v0 = acc[ai][bj][m][0], v1 = acc[ai][bj][m][1];
#pragma unroll
                    for (int j = 0; j < 4; ++j) { const float a = fmaxf(v0[j], 0.f), b = fmaxf(v1[j], 0.f); v0[j] = a * a; v1[j] = b * b; }
                    u32x4 w; w.x = cvt_pk_bf16(v0[0], v0[1]); w.y = cvt_pk_bf16(v0[2], v0[3]); w.z = cvt_pk_bf16(v1[0], v1[1]); w.w = cvt_pk_bf16(v1[2], v1[3]);
                    *(u32x4*)(rowp + bj * HALF) = w; } }
    }
};
struct EpiMix {
    static constexpr bool PERM = true, AFTER_DRAIN = false;
    const bf16_t* Zg; float* MIX; bf16_t* MIXB;
    __device__ __forceinline__ void operator()(const f32x4 (&acc)[2][2][4][2], const Unit& u, int wr, int wc, int fr, int fq) const {
        const int row0 = u.pm * BM + wr * 64 + fr, col0 = u.pn * BM + wc * 32 + 8 * fq;
#pragma unroll
        for (int ai = 0; ai < 2; ++ai)
#pragma unroll
            for (int m = 0; m < 4; ++m) { const int row = row0 + ai * HALF + m * 16;
#pragma unroll
                for (int bj = 0; bj < 2; ++bj) { const int col = col0 + bj * HALF;
                    const u32x4 gw = *(const u32x4*)(Zg + (size_t)row * LDZ + u.z * D + col);
                    f32x4 g0, g1; g0[0] = sigmoidf_(bflo(gw.x)); g0[1] = sigmoidf_(bfhi(gw.x)); g0[2] = sigmoidf_(bflo(gw.y)); g0[3] = sigmoidf_(bfhi(gw.y));
                    g1[0] = sigmoidf_(bflo(gw.z)); g1[1] = sigmoidf_(bfhi(gw.z)); g1[2] = sigmoidf_(bflo(gw.w)); g1[3] = sigmoidf_(bfhi(gw.w));
                    f32x4 v0 = acc[ai][bj][m][0] * g0, v1 = acc[ai][bj][m][1] * g1;
                    float* mp = MIX + (size_t)row * D + col;
                    if (u.z > 0) { v0 += *(const f32x4*)mp; v1 += *(const f32x4*)(mp + 4); }
                    if (u.z < 2) { *(f32x4*)mp = v0; *(f32x4*)(mp + 4) = v1; }
                    else { u32x4 w; w.x = cvt_pk_bf16(v0[0], v0[1]); w.y = cvt_pk_bf16(v0[2], v0[3]); w.z = cvt_pk_bf16(v1[0], v1[1]); w.w = cvt_pk_bf16(v1[2], v1[3]);
                        *(u32x4*)(MIXB + (size_t)row * D + col) = w; } } }
    }
};
struct EpiRes {
    static constexpr bool PERM = false, AFTER_DRAIN = false;
    const float* X; const float* gvec; float* Y;
    __device__ __forceinline__ void operator()(const f32x4 (&acc)[2][2][4][2], const Unit& u, int wr, int wc, int fr, int fq) const {
        const int row0 = u.pm * BM + wr * 64 + fr, col0 = u.pn * BM + wc * 32 + 4 * fq;
        f32x4 gv[2][2];
#pragma unroll
        for (int bj = 0; bj < 2; ++bj)
#pragma unroll
            for (int n = 0; n < 2; ++n) gv[bj][n] = *(const f32x4*)(gvec + col0 + bj * HALF + n * 16);
#pragma unroll
        for (int ai = 0; ai < 2; ++ai)
#pragma unroll
            for (int m = 0; m < 4; ++m) { const size_t ro = (size_t)(row0 + ai * HALF + m * 16) * D + col0;
#pragma unroll
                for (int bj = 0; bj < 2; ++bj)
#pragma unroll
                    for (int n = 0; n < 2; ++n) { const f32x4 xv = *(const f32x4*)(X + ro + bj * HALF + n * 16);
                        *(f32x4*)(Y + ro + bj * HALF + n * 16) = xv * ALPHA_RES + gv[bj][n] * acc[ai][bj][m][n]; } }
    }
};

template <class Epi, class Sched, bool ALIGN_EPI = false>
__device__ __forceinline__ void gemm_phase(PG8_LAS unsigned char* lds, const Gemm g, const Sched& S, const Epi& E, const int tid) {
    const int wid = __builtin_amdgcn_readfirstlane(tid >> 6), lane = tid & 63, wr = wid >> 2, wc = wid & 3, fr = lane & 15, fq = lane >> 4;
    const int K = g.K, nt = K / BK;
    unsigned voffA[2], voffB[2];
#pragma unroll
    for (int i = 0; i < 2; ++i) { int R, C; stage_rc(tid * 16 + i * 8192, R, C); const int Rb = Epi::PERM ? ((R & ~31) + perm32(R & 31)) : R;
        voffA[i] = (unsigned)(R * g.lda + C) * 2u; voffB[i] = (unsigned)(Rb * g.ldb + C) * 2u; }
    const size_t kstep = (size_t)(BK * 2);
    const size_t hstepA = (size_t)HALF * g.lda * 2, hstepB = (size_t)HALF * g.ldb * 2;
    const size_t tstepA = 2 * hstepA, tstepB = 2 * hstepB;
    const unsigned ldsw = (unsigned)wid * 1024u;
    const int aoff = lds_byte(wr * 64 + fr, fq * 8), boff = lds_byte(wc * 32 + fr, fq * 8);
#define PG8_SA(b, h) (((b) * 2 + (h)) * HTB)
#define PG8_SB(b, h) ((4 + (b) * 2 + (h)) * HTB)
#define PG8_STAGE(bufoff, gbase, voff) do { _Pragma("unroll") for (int _i = 0; _i < 2; ++_i) \
        __builtin_amdgcn_global_load_lds((const unsigned*)((const char*)(gbase) + (voff)[_i]), (PG8_LAS unsigned*)(lds + (bufoff) + ldsw + _i * 8192), 16, 0, 0); } while (0)
#define PG8_LDA(dst, b, h) do { _Pragma("unroll") for (int m = 0; m < 4; ++m) _Pragma("unroll") for (int k = 0; k < 2; ++k) dst[m][k] = *(const PG8_LAS bf16x8*)(lds + PG8_SA(b, h) + aoff + m * 2048 + k * 1024); } while (0)
#define PG8_LDB(dst, b, h) do { _Pragma("unroll") for (int n = 0; n < 2; ++n) _Pragma("unroll") for (int k = 0; k < 2; ++k) dst[n][k] = *(const PG8_LAS bf16x8*)(lds + PG8_SB(b, h) + boff + n * 2048 + k * 1024); } while (0)
#define PG8_MMA(ai, bj, At, Bt) do { __builtin_amdgcn_s_setprio(1); _Pragma("unroll") for (int m = 0; m < 4; ++m) _Pragma("unroll") for (int n = 0; n < 2; ++n) _Pragma("unroll") for (int k = 0; k < 2; ++k) \
        acc[ai][bj][m][n] = __builtin_amdgcn_mfma_f32_16x16x32_bf16(Bt[n][k], At[m][k], acc[ai][bj][m][n], 0, 0, 0); __builtin_amdgcn_s_setprio(0); } while (0)
#define PG8_WAIT_V(n) asm volatile("s_waitcnt vmcnt(" #n ")" ::: "memory")
#define PG8_WAIT_L(n) asm volatile("s_waitcnt lgkmcnt(" #n ")" ::: "memory")
#define PG8_BAR __builtin_amdgcn_s_barrier()
#define PG8_SCHED __builtin_amdgcn_sched_barrier(0)
    Unit cur, nxt; int ui = 0;
    if (!S.next(0, cur)) return;
    f32x4 acc[2][2][4][2];
#pragma unroll
    for (int a = 0; a < 2; ++a)
#pragma unroll
        for (int b = 0; b < 2; ++b)
#pragma unroll
            for (int m = 0; m < 4; ++m)
#pragma unroll
                for (int n = 0; n < 2; ++n) acc[a][b][m][n] = (f32x4){0.f, 0.f, 0.f, 0.f};
    bf16x8 At[4][2], B0[2][2], B1[2][2];
    const char* cA = (const char*)(g.A + (size_t)cur.z * g.az) + (size_t)cur.pm * tstepA; const char* cB = (const char*)(g.Bt + (size_t)cur.z * g.bz) + (size_t)cur.pn * tstepB;
    S.a_ready(cur);
    PG8_STAGE(PG8_SB(0, 0), cB, voffB); PG8_STAGE(PG8_SB(0, 1), cB + hstepB, voffB); PG8_STAGE(PG8_SA(0, 0), cA, voffA); PG8_STAGE(PG8_SA(0, 1), cA + hstepA, voffA);
    if (wr == 1) PG8_BAR;
    PG8_WAIT_V(2); PG8_BAR;
    PG8_STAGE(PG8_SB(1, 0), cB + kstep, voffB); PG8_STAGE(PG8_SA(1, 0), cA + kstep, voffA); PG8_STAGE(PG8_SB(1, 1), cB + hstepB + kstep, voffB);
    PG8_WAIT_V(6); PG8_BAR;
    for (;;) {
        const bool has_next = S.next(ui + 1, nxt);
        const char* nA = has_next ? (const char*)(g.A + (size_t)nxt.z * g.az) + (size_t)nxt.pm * tstepA : cA; const char* nB = has_next ? (const char*)(g.Bt + (size_t)nxt.z * g.bz) + (size_t)nxt.pn * tstepB : cB;
        for (int t = 0; t < nt; t += 2) {
            const bool last = (t == nt - 2);
            const char* a1 = cA + (size_t)(t + 1) * kstep;
            const char* a2 = last ? nA : cA + (size_t)(t + 2) * kstep; const char* b2 = last ? nB : cB + (size_t)(t + 2) * kstep;
            const char* a3 = a2 + kstep; const char* b3 = b2 + kstep;
            if (last && has_next) S.a_ready(nxt);
            PG8_LDB(B0, 0, 0); PG8_LDB(B1, 0, 1); PG8_SCHED; PG8_LDA(At, 0, 0); PG8_STAGE(PG8_SA(1, 1), a1 + hstepA, voffA);
            PG8_WAIT_V(8); PG8_WAIT_L(0); PG8_BAR; PG8_MMA(0, 0, At, B0); PG8_MMA(0, 1, At, B1); PG8_BAR; PG8_SCHED;
            PG8_LDA(At, 0, 1); PG8_STAGE(PG8_SB(0, 0), b2, voffB); PG8_STAGE(PG8_SB(0, 1), b2 + hstepB, voffB); PG8_STAGE(PG8_SA(0, 0), a2, voffA);
            PG8_WAIT_V(8); PG8_WAIT_L(0); PG8_BAR; PG8_MMA(1, 0, At, B0); PG8_MMA(1, 1, At, B1); PG8_BAR; PG8_SCHED;
            PG8_LDB(B0, 1, 0); PG8_LDB(B1, 1, 1); PG8_SCHED; PG8_LDA(At, 1, 0); PG8_STAGE(PG8_SA(0, 1), a2 + hstepA, voffA);
            PG8_WAIT_V(8); PG8_WAIT_L(0); PG8_BAR; PG8_MMA(0, 0, At, B0); PG8_MMA(0, 1, At, B1); PG8_BAR; PG8_SCHED;
            PG8_LDA(At, 1, 1); PG8_STAGE(PG8_SB(1, 0), b3, voffB); PG8_STAGE(PG8_SB(1, 1), b3 + hstepB, voffB); PG8_STAGE(PG8_SA(1, 0), a3, voffA);
            PG8_WAIT_V(8); PG8_WAIT_L(0); PG8_BAR; PG8_MMA(1, 0, At, B0); PG8_MMA(1, 1, At, B1); PG8_BAR; PG8_SCHED;
        }
        if constexpr (ALIGN_EPI) { if (wr == 0) PG8_BAR; }
        E(acc, cur, wr, wc, fr, fq); S.done(cur);
        if (!has_next) break;
#pragma unroll
        for (int a = 0; a < 2; ++a)
#pragma unroll
            for (int b = 0; b < 2; ++b)
#pragma unroll
                for (int m = 0; m < 4; ++m)
#pragma unroll
                    for (int n = 0; n < 2; ++n) acc[a][b][m][n] = (f32x4){0.f, 0.f, 0.f, 0.f};
        cur = nxt; cA = nA; cB = nB; ++ui;
        if constexpr (ALIGN_EPI) { if (wr == 1) PG8_BAR; }
    }
    PG8_WAIT_V(0);
    if constexpr (!ALIGN_EPI) { if (wr == 0) PG8_BAR; }
    PG8_BAR;
#undef PG8_SA
#undef PG8_SB
#undef PG8_STAGE
#undef PG8_LDA
#undef PG8_LDB
#undef PG8_MMA
#undef PG8_WAIT_V
#undef PG8_WAIT_L
#undef PG8_BAR
#undef PG8_SCHED
}
}
#define XB_TMO      128
#define XB_XCNT(j)  (256  + 64 * (j))
#define XB_XSUB(j)  (1280 + 64 * (j))
#define XB_XGEN(j)  (2304 + 64 * (j))
#define XB_TOP      3328
#define XB_TOPGEN   3392
#define XCD_BAR_WORDS 3456
#define XB_SPIN_CAP (1u << 22)

__device__ __forceinline__ unsigned xb_ld(unsigned* p)              { return __hip_atomic_load(p, __ATOMIC_RELAXED, __HIP_MEMORY_SCOPE_AGENT); }
__device__ __forceinline__ unsigned xb_add(unsigned* p, unsigned v) { return __hip_atomic_fetch_add(p, v, __ATOMIC_RELAXED, __HIP_MEMORY_SCOPE_AGENT); }
__device__ __forceinline__ unsigned xb_xcc_id() { return (unsigned)__builtin_amdgcn_s_getreg((3 << 11) | 20) & 0xFu; }
#define XB_SPIN(cond, bar) do { unsigned _sp = 0; while (cond) { __builtin_amdgcn_s_sleep(1); \
    if ((++_sp & 255u) == 0u) { if (xb_ld(&(bar)[XB_TMO])) break; if (_sp > XB_SPIN_CAP) { atomicAdd(&(bar)[XB_TMO], 1u); break; } } } } while (0)

struct XcdBarrier {
    unsigned* bar; unsigned x;
    volatile LAS unsigned* st;
};

__device__ __forceinline__ XcdBarrier xcd_barrier_post(unsigned* bar, volatile LAS unsigned* st) {
    XcdBarrier b; b.bar = bar; b.x = xb_xcc_id(); b.st = st;
    if (threadIdx.x == 0) (void)xb_add(&bar[XB_XCNT(b.x)], 1u);
    return b;
}
__device__ __forceinline__ void xcd_barrier_complete(unsigned* bar, unsigned x, unsigned& nloc, unsigned& nx) {
    const unsigned G = gridDim.x * gridDim.y * gridDim.z;
    unsigned sum, cnt, mine, sp = 0u;
    for (;;) {
        sum = 0u; cnt = 0u; mine = 0u;
#pragma unroll
        for (unsigned j = 0; j < 16; ++j) { const unsigned c = xb_ld(&bar[XB_XCNT(j)]); sum += c; cnt += (c > 0u) ? 1u : 0u; mine = (j == x) ? c : mine; }
        if (sum == G) break;
        __builtin_amdgcn_s_sleep(1);
        if ((++sp & 255u) == 0u) { if (xb_ld(&bar[XB_TMO])) break; if (sp > XB_SPIN_CAP) { atomicAdd(&bar[XB_TMO], 1u); break; } }
    }
    nloc = mine > 0u ? mine : 1u; nx = cnt > 0u ? cnt : 1u;
}

__device__ __forceinline__ void xcd_barrier(const XcdBarrier& b) {
    asm volatile("s_waitcnt vmcnt(0)" ::: "memory");
    __syncthreads();
    if (threadIdx.x == 0) {
        unsigned* bar = b.bar;
        __builtin_amdgcn_s_waitcnt(0);
        unsigned nloc = b.st[0], nx = b.st[1];
        if (nloc == 0u) { xcd_barrier_complete(bar, b.x, nloc, nx); b.st[0] = nloc; b.st[1] = nx; }
        const unsigned old = xb_add(&bar[XB_XSUB(b.x)], 1u);
        const unsigned gen = old / nloc;
        if (old + 1u == (gen + 1u) * nloc) {
            __builtin_amdgcn_fence(__ATOMIC_RELEASE, "agent");
            asm volatile("s_waitcnt vmcnt(0)" ::: "memory");
            const unsigned og = xb_add(&bar[XB_TOP], 1u);
            const unsigned tg = og / nx;
            if (og + 1u == (tg + 1u) * nx) xb_add(&bar[XB_TOPGEN], 1u);
            else XB_SPIN(xb_ld(&bar[XB_TOPGEN]) == tg, bar);
            __builtin_amdgcn_fence(__ATOMIC_ACQUIRE, "agent");
            xb_add(&bar[XB_XGEN(b.x)], 1u);
            asm volatile("s_waitcnt vmcnt(0)" ::: "memory");
        } else {
            XB_SPIN(xb_ld(&bar[XB_XGEN(b.x)]) == gen, bar);
            __builtin_amdgcn_fence(__ATOMIC_ACQUIRE, "agent");
            asm volatile("s_waitcnt vmcnt(0)" ::: "memory");
        }
    }
    __syncthreads();
}

struct Args { const float* in[23]; float* out; unsigned char* ws; int ph_lo, ph_hi; };
struct Frame {
    LAS unsigned char* lds;
    volatile LAS unsigned* MISC;
    gu32* ctl;
    int tid, lane, wave, bid, G, gw, NGW;
    const int* pos; float* out; GAS unsigned char* ws;
};
__device__ __forceinline__ void fresh(Frame& F, const Args& args) {
    int t = threadIdx.x; asm volatile("; fresh tid" : "+v"(t)); int b = blockIdx.x; asm volatile("; fresh bid" : "+s"(b));
    GAS unsigned char* w = (GAS unsigned char*)args.ws; asm volatile("; fresh ws" : "+s"(w));
    F.tid = t; F.lane = t & 63; F.wave = __builtin_amdgcn_readfirstlane(t >> 6); F.bid = b; F.gw = b * NWAVES + F.wave; F.ws = w; F.ctl = (gu32*)(w + WS_CTL);
}
#define WSP(T, off) ((T*)(F.ws + (off)))
#define WLP(T, l, off) ((T*)(F.ws + WS_W + (size_t)(l) * WL_STRIDE + (off)))
enum { IN_X = 0, IN_C, IN_POS, IN_WADA, IN_BADA, IN_WIN, IN_QNORM, IN_KVNORM, IN_WUQ, IN_WUKV, IN_DLAM, IN_DSUB, IN_CW1, IN_CB1, IN_CW2, IN_WBR, IN_WOUT, IN_LN1G, IN_LN1B, IN_WFF1, IN_WFF2, IN_LN2G, IN_LN2B };

template <class Map>
__device__ __forceinline__ void transpose_item(const float* W, int K, int Nsrc, bf16_t* WT, int Ndst, const Map& map, const float* rowscale, LAS float* scr, int item, int lane) {
    const int nblk = Ndst / 32, kb = item / nblk, nb = item % nblk, k0 = 64 * kb, n0 = 32 * nb;
    const int n4 = (lane & 7) * 4, ns = map(n0 + n4);
#pragma unroll
    for (int i = 0; i < 8; ++i) { const int kk = 8 * i + (lane >> 3); f32x4 v = {0.f, 0.f, 0.f, 0.f};
        if (ns >= 0) { v = *(const f32x4*)(W + (size_t)(k0 + kk) * Nsrc + ns); if (rowscale) v = v * rowscale[k0 + kk]; }
        *(LAS f32x4*)(scr + kk * 36 + n4) = v; }
    LDS_WAIT(); asm volatile("" ::: "memory");
    const int c = lane & 7;
#pragma unroll
    for (int j = 0; j < 4; ++j) { const int n = (lane >> 3) + 8 * j; const LAS float* s = scr + (8 * c) * 36 + n;
        u32x4 o; o.x = pk2(s[0 * 36], s[1 * 36]); o.y = pk2(s[2 * 36], s[3 * 36]); o.z = pk2(s[4 * 36], s[5 * 36]); o.w = pk2(s[6 * 36], s[7 * 36]);
        *(GAS u32x4*)(WT + (size_t)(n0 + n) * K + k0 + 8 * c) = o; }
    LDS_WAIT(); asm volatile("" ::: "memory");
}
struct MapId { __device__ __forceinline__ int operator()(int n) const { return n; } };
struct MapZ { __device__ __forceinline__ int operator()(int n) const { return zsrc(n); } };
template <class Map>
__device__ __forceinline__ void transpose_all(Frame& F, const float* W, int K, int Nsrc, bf16_t* WT, int Ndst, const Map& map, const float* rowscale, int& rot) {
    LAS float* scr = (LAS float*)(F.lds + F.wave * 16384);
    const int nitems = (K / 64) * (Ndst / 32);
    int start = F.gw - rot; start %= F.NGW; if (start < 0) start += F.NGW;
    for (int it = start; it < nitems; it += F.NGW) transpose_item(W, K, Nsrc, WT, Ndst, map, rowscale, scr, it, F.lane);
    rot = (rot + nitems) % F.NGW;
}
__device__ __forceinline__ void p0_prologue(Frame& F, const Args& args) {
    int rot = 0;
    for (int l = 0; l < NL; ++l) {
        transpose_all(F, args.in[IN_WIN] + (size_t)l * D * DIN_SRC, D, DIN_SRC, WLP(bf16_t, l, WL_IN), LDZ, MapZ(), nullptr, rot);
        transpose_all(F, args.in[IN_WFF1] + (size_t)l * D * FF, D, FF, WLP(bf16_t, l, WL_FF1), FF, MapId(), nullptr, rot);
        transpose_all(F, args.in[IN_WFF2] + (size_t)l * FF * D, FF, D, WLP(bf16_t, l, WL_FF2), D, MapId(), nullptr, rot);
        for (int n = 0; n < 3; ++n)
            transpose_all(F, args.in[IN_WBR] + ((size_t)l * 3 + n) * 1024 * D, 1024, D, WLP(bf16_t, l, WL_BR) + (size_t)n * D * 1024, D, MapId(), nullptr, rot);
        transpose_all(F, args.in[IN_WOUT] + (size_t)l * D * D, D, D, WLP(bf16_t, l, WL_OUT), D, MapId(), nullptr, rot);
        transpose_all(F, args.in[IN_WUQ] + (size_t)l * 512 * 1536, 512, 1536, WLP(bf16_t, l, WL_UQ), 1536, MapId(), args.in[IN_QNORM] + l * 512, rot);
        transpose_all(F, args.in[IN_WUKV] + (size_t)l * 256 * 2048, 256, 2048, WLP(bf16_t, l, WL_UKV), 2048, MapId(), args.in[IN_KVNORM] + l * 256, rot);
        for (int kv = 0; kv < 2; ++kv) {
            transpose_all(F, args.in[IN_CW1] + ((size_t)l * 2 + kv) * 4096 * 128, 4096, 128, WLP(bf16_t, l, WL_C1) + (size_t)kv * 128 * 4096, 128, MapId(), nullptr, rot);
            transpose_all(F, args.in[IN_CW2] + ((size_t)l * 2 + kv) * 128 * 128, 128, 128, WLP(bf16_t, l, WL_C2) + (size_t)kv * 128 * 128, 128, MapId(), nullptr, rot);
        }
    }
    __syncthreads();
    { float* rc = WSP(float, WS_ROPE); float* rs = rc + (size_t)S * 32;
      for (int idx = F.bid * NTHREADS + F.tid; idx < S * 32; idx += F.G * NTHREADS) { const int s = idx >> 5, i = idx & 31;
          const float inv = powf(10000.0f, -(float)(2 * i) / 64.0f); const float ang = (float)F.pos[s] * inv; rc[idx] = cosf(ang); rs[idx] = sinf(ang); } }
    { LAS float* cact = (LAS float*)F.lds; LAS float* red = cact + 2048;
      for (int k = F.tid; k < D; k += NTHREADS) { const float cv = args.in[IN_C][k]; cact[k] = cv / (1.f + __expf(-cv)); }
      __syncthreads();
      for (int job = F.bid; job < NL * 48; job += F.G) { const int l = job / 48, col0 = (job % 48) * 256;
          const float* wp = args.in[IN_WADA] + (size_t)l * D * (6 * D) + col0 + 4 * F.lane;
          f32x4 a = {0.f, 0.f, 0.f, 0.f};
          const int kbeg = F.wave * 256;
#pragma unroll 8
          for (int k = 0; k < 256; ++k) { const f32x4 w = *(const f32x4*)(wp + (size_t)(kbeg + k) * (6 * D)); a += w * cact[kbeg + k]; }
          *(LAS f32x4*)(red + F.wave * 256 + 4 * F.lane) = a;
          __syncthreads();
          if (F.tid < 256) { float s = args.in[IN_BADA][(size_t)l * 6 * D + col0 + F.tid];
#pragma unroll
              for (int w = 0; w < 8; ++w) s += red[w * 256 + F.tid];
              WSP(float, WS_MOD)[(size_t)l * 6 * D + col0 + F.tid] = s; }
          __syncthreads(); } }
}

__device__ __forceinline__ void ln_rows(Frame& F, const float* src, bool do_ln, const float* g, const float* b, float* xout, bool do_mod, const float* shift, const float* scale, bf16_t* hout, float* ssq_zero) {
    for (int row = F.gw; row < S; row += F.NGW) {
        const GAS f32x4* xr = (const GAS f32x4*)(src + (size_t)row * D) + F.lane;
        f32x4 v[8]; float s = 0.f;
#pragma unroll
        for (int j = 0; j < 8; ++j) { v[j] = xr[64 * j]; s += (v[j][0] + v[j][1]) + (v[j][2] + v[j][3]); }
        if (do_ln) {
            const float mean = wave_sum(s) * (1.f / D); float s2 = 0.f;
#pragma unroll
            for (int j = 0; j < 8; ++j) { v[j] = v[j] - mean; s2 += (v[j][0] * v[j][0] + v[j][1] * v[j][1]) + (v[j][2] * v[j][2] + v[j][3] * v[j][3]); }
            const float rstd = 1.f / sqrtf(wave_sum(s2) * (1.f / D) + 1e-5f);
            s = 0.f;
#pragma unroll
            for (int j = 0; j < 8; ++j) { const f32x4 gg = *((const f32x4*)g + F.lane + 64 * j), bb = *((const f32x4*)b + F.lane + 64 * j);
                v[j] = v[j] * rstd * gg + bb; *((GAS f32x4*)(xout + (size_t)row * D) + F.lane + 64 * j) = v[j]; s += (v[j][0] + v[j][1]) + (v[j][2] + v[j][3]); }
        }
        if (do_mod) {
            const float mean = wave_sum(s) * (1.f / D); float s2 = 0.f;
#pragma unroll
            for (int j = 0; j < 8; ++j) { v[j] = v[j] - mean; s2 += (v[j][0] * v[j][0] + v[j][1] * v[j][1]) + (v[j][2] * v[j][2] + v[j][3] * v[j][3]); }
            const float rstd = 1.f / sqrtf(wave_sum(s2) * (1.f / D) + 1e-5f);
#pragma unroll
            for (int j = 0; j < 8; ++j) { const f32x4 sc = *((const f32x4*)scale + F.lane + 64 * j), sh = *((const f32x4*)shift + F.lane + 64 * j);
                const f32x4 h = v[j] * rstd * (sc + 1.0f) + sh;
                u32x2 w; w.x = pk2(h[0], h[1]); w.y = pk2(h[2], h[3]);
                *((GAS u32x2*)(hout + (size_t)row * D) + F.lane + 64 * j) = w; }
        }
        if (ssq_zero && F.lane < 2) ssq_zero[(size_t)row * 2 + F.lane] = 0.f;
    }
}

__device__ __forceinline__ void krope_job(Frame& F) {
    const bf16_t* Z = WSP(bf16_t, WS_Z); bf16_t* KR = WSP(bf16_t, WS_KROPE); const float* rc = WSP(float, WS_ROPE); const float* rs = rc + (size_t)S * 32;
    for (int idx = F.bid * NTHREADS + F.tid; idx < S * 32; idx += F.G * NTHREADS) { const int s = idx >> 5, i = idx & 31;
        const float x1 = bf1(Z[(size_t)s * LDZ + ZC_KR + i]), x2 = bf1(Z[(size_t)s * LDZ + ZC_KR + 32 + i]); const float c = rc[idx], sn = rs[idx];
        KR[(size_t)s * 64 + i] = (bf16_t)f2bf(x1 * c - x2 * sn); KR[(size_t)s * 64 + 32 + i] = (bf16_t)f2bf(x1 * sn + x2 * c); }
}
__device__ __forceinline__ float gelu_tanh(float x) { const float u = 0.7978845608028654f * (x + 0.044715f * x * x * x); return 0.5f * x * (1.f + tanhf(u)); }
__device__ __forceinline__ void compress_naive(Frame& F, const Args& args, int l) {
    const bf16_t* Z = WSP(bf16_t, WS_Z); bf16_t* KC = WSP(bf16_t, WS_KCMP);
    LAS float* hs = (LAS float*)(F.lds + F.wave * 4096);
    for (int item = F.gw; item < 4 * 128; item += F.NGW) { const int inst = item >> 7, kv = inst >> 1, g = inst & 1, n0 = (item & 127) * 4;
        const float* w1 = args.in[IN_CW1] + ((size_t)l * 2 + kv) * 4096 * 128; const float* b1 = args.in[IN_CB1] + ((size_t)l * 2 + kv) * 128; const float* w2 = args.in[IN_CW2] + ((size_t)l * 2 + kv) * 128 * 128;
        const int zc = ZC_NKV + ((0 * 2 + kv) * 2 + g) * 128;
        float a[4][2];
#pragma unroll
        for (int r = 0; r < 4; ++r) { a[r][0] = 0.f; a[r][1] = 0.f; }
        for (int k = 0; k < 4096; ++k) { const int t = k >> 7, d = k & 127; const f32x2 w = *(const f32x2*)(w1 + (size_t)k * 128 + 2 * F.lane);
#pragma unroll
            for (int r = 0; r < 4; ++r) { int tok = 16 * (n0 + r) + t; tok = tok < S ? tok : S - 1; const float xv = bf1(Z[(size_t)tok * LDZ + zc + d]); a[r][0] += xv * w[0]; a[r][1] += xv * w[1]; } }
        const f32x2 bb = *(const f32x2*)(b1 + 2 * F.lane);
#pragma unroll
        for (int r = 0; r < 4; ++r) { hs[r * 128 + 2 * F.lane] = gelu_tanh(a[r][0] + bb[0]); hs[r * 128 + 2 * F.lane + 1] = gelu_tanh(a[r][1] + bb[1]); }
        LDS_WAIT(); asm volatile("" ::: "memory");
        float o[4][2];
#pragma unroll
        for (int r = 0; r < 4; ++r) { o[r][0] = 0.f; o[r][1] = 0.f; }
        for (int j = 0; j < 128; ++j) { const f32x2 w = *(const f32x2*)(w2 + (size_t)j * 128 + 2 * F.lane);
#pragma unroll
            for (int r = 0; r < 4; ++r) { const float hv = hs[r * 128 + j]; o[r][0] += hv * w[0]; o[r][1] += hv * w[1]; } }
#pragma unroll
        for (int r = 0; r < 4; ++r) { const int n = n0 + r; const unsigned pk = (n < 511) ? pk2(o[r][0], o[r][1]) : 0u;
            *(unsigned*)(KC + (((size_t)kv * 2 + g) * 512 + n) * 128 + 2 * F.lane) = pk; }
        LDS_WAIT(); asm volatile("" ::: "memory");
    }
}


__device__ __forceinline__ void compress_mfma(Frame& F, const Args& args, int l) {
    const bf16_t* Z = WSP(bf16_t, WS_Z); bf16_t* KC = WSP(bf16_t, WS_KCMP);
    const int lane = F.lane, w = F.wave, r16 = lane & 15, kq = lane >> 4;
    LAS unsigned char* hs = F.lds;
    for (int item = F.bid; item < 128; item += F.G) { const int inst = item >> 5, kv = inst >> 1, g = inst & 1, n0 = (item & 31) * 16;
        const bf16_t* w1t = WLP(bf16_t, l, WL_C1) + (size_t)kv * 128 * 4096 + (size_t)(16 * w + r16) * 4096 + 8 * kq;
        const bf16_t* w2t = WLP(bf16_t, l, WL_C2) + (size_t)kv * 128 * 128 + (size_t)(16 * w + r16) * 128 + 8 * kq;
        int tok0 = 16 * (n0 + r16);
        const bf16_t* xa = Z + ZC_NKV + ((0 * 2 + kv) * 2 + g) * 128 + 8 * kq;
        f32x4 acc = {0.f, 0.f, 0.f, 0.f};
#pragma unroll 8
        for (int ks = 0; ks < 128; ++ks) { const int t = ks >> 2; int tok = tok0 + t; tok = tok < S ? tok : S - 1;
            const bf16x8 a = *(const bf16x8*)(xa + (size_t)tok * LDZ + 32 * (ks & 3)); const bf16x8 b = *(const bf16x8*)(w1t + 32 * ks);
            acc = __builtin_amdgcn_mfma_f32_16x16x32_bf16(a, b, acc, 0, 0, 0); }
        const float bb = args.in[IN_CB1][((size_t)l * 2 + kv) * 128 + 16 * w + r16];
        __syncthreads();
#pragma unroll
        for (int r = 0; r < 4; ++r) *(LAS bf16_t*)(hs + (4 * kq + r) * 272 + (16 * w + r16) * 2) = (bf16_t)f2bf(gelu_tanh(acc[r] + bb));
        __syncthreads();
        f32x4 o = {0.f, 0.f, 0.f, 0.f};
#pragma unroll
        for (int ks = 0; ks < 4; ++ks) { const bf16x8 a = *(const LAS bf16x8*)(hs + r16 * 272 + (32 * ks + 8 * kq) * 2); const bf16x8 b = *(const bf16x8*)(w2t + 32 * ks);
            o = __builtin_amdgcn_mfma_f32_16x16x32_bf16(a, b, o, 0, 0, 0); }
#pragma unroll
        for (int r = 0; r < 4; ++r) { const int n = n0 + 4 * kq + r; KC[(((size_t)kv * 2 + g) * 512 + n) * 128 + 16 * w + r16] = n < 511 ? (bf16_t)f2bf(o[r]) : (bf16_t)0; }
    }
    __syncthreads();
}

__device__ __forceinline__ float dotrow(const LAS float* q, const bf16_t* k, int n8) {
    float a = 0.f;
    for (int i = 0; i < n8; ++i) { const u32x4 w = *(const u32x4*)(k + 8 * i); const LAS f32x4* qq = (const LAS f32x4*)(q + 8 * i); const f32x4 q0 = qq[0], q1 = qq[1];
        a += q0[0] * bflo(w.x) + q0[1] * bfhi(w.x) + q0[2] * bflo(w.y) + q0[3] * bfhi(w.y) + q1[0] * bflo(w.z) + q1[1] * bfhi(w.z) + q1[2] * bflo(w.w) + q1[3] * bfhi(w.w); }
    return a;
}
__device__ __forceinline__ void naive_update(float& m, float& l, float& o0, float& o1, float s, const bf16_t* vrow0, size_t vstride) {
    const float mn = fmaxf(m, wave_max(s)); const float alpha = __expf(m - mn); const float p = __expf(s - mn);
    l = l * alpha + wave_sum(p); o0 *= alpha; o1 *= alpha; m = mn;
    for (int kk = 0; kk < 64; ++kk) { const float pk = __builtin_bit_cast(float, __builtin_amdgcn_readlane(__builtin_bit_cast(int, p), kk));
        if (pk != 0.f) { const unsigned v = *(const unsigned*)(vrow0 + (size_t)kk * vstride); o0 += pk * bflo(v); o1 += pk * bfhi(v); } }
}
__device__ __forceinline__ void pv_norm(float& o0, float& o1, float p, const bf16_t* vrow0, size_t vstride) {
    for (int kk = 0; kk < 64; ++kk) { const float pk = __builtin_bit_cast(float, __builtin_amdgcn_readlane(__builtin_bit_cast(int, p), kk));
        if (pk != 0.f) { const unsigned v = *(const unsigned*)(vrow0 + (size_t)kk * vstride); o0 += pk * bflo(v); o1 += pk * bfhi(v); } }
}
#define WAVE_LDS_SYNC() do { LDS_WAIT(); __builtin_amdgcn_wave_barrier(); asm volatile("" ::: "memory"); } while (0)
constexpr float NEG_INF = -__builtin_inff();

__device__ __forceinline__ void attn_naive(Frame& F, const Args& args, int l, bool do_mla, bool do_diff, bool do_nsa, size_t br_off = WS_BR) {
    const bf16_t* Z = WSP(bf16_t, WS_Z); const bf16_t* QM = WSP(bf16_t, WS_QM); const bf16_t* KVM = WSP(bf16_t, WS_KVM); const bf16_t* KR = WSP(bf16_t, WS_KROPE);
    const bf16_t* KC = WSP(bf16_t, WS_KCMP); bf16_t* BR = WSP(bf16_t, br_off);
    const float* rc = WSP(float, WS_ROPE); const float* rs = rc + (size_t)S * 32;
    LAS float* wq = (LAS float*)(F.lds + F.wave * 2048);
    LAS float* wimp = wq + 256;
    const int lane = F.lane;
    const float* lp = args.in[IN_DLAM] + (size_t)l * 256;
    const float lam_init = 0.8f - 0.6f * expf(-0.3f * (float)l);
    const float lam = expf(wave_sum(lp[lane] * lp[64 + lane])) - expf(wave_sum(lp[128 + lane] * lp[192 + lane])) + lam_init;
    if (do_mla) for (int item = F.gw; item < S * 8; item += F.NGW) { const int q = item >> 3, h = item & 7;
        { const float sc = 0.07216878364870322f;
          const bf16_t* qr = QM + (size_t)q * 1536 + h * 192;
          wq[lane] = bf1(qr[lane]) * sc; wq[64 + lane] = bf1(qr[64 + lane]) * sc;
          const int i = lane & 31; const float x1 = bf1(qr[128 + i]), x2 = bf1(qr[160 + i]), c = rc[(size_t)q * 32 + i], sn = rs[(size_t)q * 32 + i];
          wq[128 + lane] = (lane < 32 ? x1 * c - x2 * sn : x1 * sn + x2 * c) * sc; }
        WAVE_LDS_SYNC();
        float m = -1e30f, ls = 0.f, o0 = 0.f, o1 = 0.f;
        for (int kb = 0; kb <= q; kb += 64) { const int key = kb + lane; float s = NEG_INF;
            if (key <= q) s = dotrow(wq, KVM + (size_t)key * 2048 + h * 256, 16) + dotrow(wq + 128, KR + (size_t)key * 64, 8);
            naive_update(m, ls, o0, o1, s, KVM + (size_t)kb * 2048 + h * 256 + 128 + 2 * lane, 2048); }
        const float inv = ls > 0.f ? 1.f / ls : 0.f;
        *(unsigned*)(BR + (size_t)q * 3072 + h * 128 + 2 * lane) = pk2(o0 * inv, o1 * inv);
        WAVE_LDS_SYNC();
    }
    if (do_diff) for (int item = F.gw; item < S * 8; item += F.NGW) { const int q = item >> 3, h = item & 7;
        const float slope = exp2f(-0.5f * (float)(2 * h + 1)); const float pq = (float)F.pos[q];
        float r0[2], r1[2];
#pragma unroll
        for (int mp = 0; mp < 2; ++mp) {
            wq[lane] = bf1(Z[(size_t)q * LDZ + ZC_DQ + h * 128 + mp * 64 + lane]) * 0.125f;
            WAVE_LDS_SYNC();
            float m = -1e30f, ls = 0.f, o0 = 0.f, o1 = 0.f;
            for (int kb = 0; kb <= q; kb += 64) { const int key = kb + lane; float s = NEG_INF;
                if (key <= q) s = dotrow(wq, Z + (size_t)key * LDZ + ZC_DK + h * 128 + mp * 64, 8) - slope * fabsf(pq - (float)F.pos[key]);
                naive_update(m, ls, o0, o1, s, Z + (size_t)kb * LDZ + ZC_DV + h * 128 + 2 * lane, LDZ); }
            const float inv = ls > 0.f ? 1.f / ls : 0.f; r0[mp] = o0 * inv; r1[mp] = o1 * inv;
            WAVE_LDS_SYNC();
        }
        const float a0 = r0[0] - lam * r0[1], a1 = r1[0] - lam * r1[1];
        const float rr = 1.f / sqrtf(wave_sum(a0 * a0 + a1 * a1) * (1.f / 128.f) + 1e-6f);
        const float* gs = args.in[IN_DSUB] + (size_t)l * 128;
        *(unsigned*)(BR + (size_t)q * 3072 + 1024 + h * 128 + 2 * lane) = pk2(a0 * rr * gs[2 * lane] * (1.f - lam_init), a1 * rr * gs[2 * lane + 1] * (1.f - lam_init));
    }
    if (do_nsa) for (int item = F.gw; item < S * 2; item += F.NGW) { const int q = item >> 1, g = item & 1;
        const float pq = (float)F.pos[q]; const int cur = q >> 6; const int ncmp = q >= 31 ? ((q - 31) >> 4) + 1 : 0;
        const float sc = 0.08838834764831845f;
        wimp[lane] = 0.f; wimp[64 + lane] = 0.f;
        float oc0[4], oc1[4];
#pragma unroll
        for (int r = 0; r < 4; ++r) { const int hh = 4 * g + r; const float slope = exp2f(-(float)(hh + 1));
            const bf16_t* qr = Z + (size_t)q * LDZ + ZC_NQ + hh * 128; wq[lane] = bf1(qr[lane]) * sc; wq[64 + lane] = bf1(qr[64 + lane]) * sc;
            WAVE_LDS_SYNC();
            const bf16_t* kc = KC + ((size_t)(0 * 2 + g) * 512) * 128; const bf16_t* vc = KC + ((size_t)(1 * 2 + g) * 512) * 128;
            float m = -1e30f, ls = 0.f;
            for (int nb = 0; nb < ncmp; nb += 64) { const int n = nb + lane; float s = NEG_INF;
                if (n < ncmp) s = dotrow(wq, kc + (size_t)n * 128, 16) - slope * fabsf(pq - (float)F.pos[31 + 16 * n]);
                const float mn = fmaxf(m, wave_max(s)); ls = ls * __expf(m - mn) + wave_sum(__expf(s - mn)); m = mn; }
            const float inv = ls > 0.f ? 1.f / ls : 0.f; float o0 = 0.f, o1 = 0.f;
            for (int nb = 0; nb < ncmp; nb += 64) { const int n = nb + lane; float p = 0.f;
                if (n < ncmp) { const float s = dotrow(wq, kc + (size_t)n * 128, 16) - slope * fabsf(pq - (float)F.pos[31 + 16 * n]); p = __expf(s - m) * inv;
                    atomicAdd((float*)(wimp + (n >> 2)), p); if ((n & 3) == 3) atomicAdd((float*)(wimp + (n >> 2) + 1), p); }
                pv_norm(o0, o1, p, vc + (size_t)nb * 128 + 2 * lane, 128); }
            oc0[r] = o0; oc1[r] = o1;
            WAVE_LDS_SYNC();
        }
        unsigned long long mlo, mhi;
        { float v0, v1; { const int j0 = lane, j1 = lane + 64;
              v0 = (j0 == 0 || j0 == cur || j0 == cur - 1) ? __builtin_inff() : (j0 <= cur ? wimp[j0] : NEG_INF);
              v1 = (j1 == cur || j1 == cur - 1) ? __builtin_inff() : (j1 <= cur ? wimp[j1] : NEG_INF); }
          int c0 = 0, c1 = 0;
          for (int k = 0; k < 128; ++k) { const float vk = (k == 0 || k == cur || k == cur - 1) ? __builtin_inff() : (k <= cur ? wimp[k] : NEG_INF);
              c0 += (vk > v0 || (vk == v0 && k < lane)) ? 1 : 0; c1 += (vk > v1 || (vk == v1 && k < lane + 64)) ? 1 : 0; }
          mlo = __ballot(c0 < 16 && v0 > NEG_INF); mhi = __ballot(c1 < 16 && v1 > NEG_INF); }
        WAVE_LDS_SYNC();
#pragma unroll
        for (int r = 0; r < 4; ++r) { const int hh = 4 * g + r; const float slope = exp2f(-(float)(hh + 1));
            const bf16_t* qr = Z + (size_t)q * LDZ + ZC_NQ + hh * 128; wq[lane] = bf1(qr[lane]) * sc; wq[64 + lane] = bf1(qr[64 + lane]) * sc;
            WAVE_LDS_SYNC();
            const bf16_t* ks = Z + ZC_NKV + ((1 * 2 + 0) * 2 + g) * 128; const bf16_t* vs = Z + ZC_NKV + ((1 * 2 + 1) * 2 + g) * 128;
            float m = -1e30f, ls = 0.f, o0 = 0.f, o1 = 0.f;
            for (int j = 0; j < 128; ++j) { const bool on = j < 64 ? ((mlo >> j) & 1ull) : ((mhi >> (j - 64)) & 1ull); if (!on) continue;
                const int key = 64 * j + lane; float s = NEG_INF;
                if (key <= q) s = dotrow(wq, ks + (size_t)key * LDZ, 16) - slope * fabsf(pq - (float)F.pos[key]);
                naive_update(m, ls, o0, o1, s, vs + (size_t)(64 * j) * LDZ + 2 * lane, LDZ); }
            const float is = ls > 0.f ? 1.f / ls : 0.f; const float os0 = o0 * is, os1 = o1 * is;
            const bf16_t* kw = Z + ZC_NKV + ((2 * 2 + 0) * 2 + g) * 128; const bf16_t* vw = Z + ZC_NKV + ((2 * 2 + 1) * 2 + g) * 128;
            m = -1e30f; ls = 0.f; o0 = 0.f; o1 = 0.f;
            int kb0 = q - 511; kb0 = kb0 < 0 ? 0 : (kb0 & ~63);
            for (int kb = kb0; kb <= q; kb += 64) { const int key = kb + lane; float s = NEG_INF;
                if (key <= q && key > q - 512) s = dotrow(wq, kw + (size_t)key * LDZ, 16) - slope * fabsf(pq - (float)F.pos[key]);
                naive_update(m, ls, o0, o1, s, vw + (size_t)kb * LDZ + 2 * lane, LDZ); }
            const float iw = ls > 0.f ? 1.f / ls : 0.f; const float ow0 = o0 * iw, ow1 = o1 * iw;
            const bf16_t* gl = Z + (size_t)q * LDZ + ZC_NG + hh * 3;
            const float g0 = sigmoidf_(bf1(gl[0])), g1 = sigmoidf_(bf1(gl[1])), g2 = sigmoidf_(bf1(gl[2]));
            *(unsigned*)(BR + (size_t)q * 3072 + 2048 + hh * 128 + 2 * lane) = pk2(g0 * oc0[r] + g1 * os0 + g2 * ow0, g0 * oc1[r] + g1 * os1 + g2 * ow1);
            WAVE_LDS_SYNC();
        }
    }
}
namespace fa {
constexpr int VRS = 320;
constexpr int L_K = 0, KBUF = 25600;
constexpr int L_V = 51200, VBUF = 20480;
constexpr int L_POS = 92160, PBUF = 256;
constexpr int L_CTRL = 92672;
constexpr int L_LIST = 92928;
constexpr int L_IMP = 94208;
constexpr int L_SEL = 126976;
constexpr float LOG2E = 1.4426950408889634f;
typedef short v4i16_t __attribute__((ext_vector_type(4)));
typedef __bf16 bf16x2_t __attribute__((ext_vector_type(2)));

__device__ __forceinline__ unsigned cvtpk(float lo, float hi) { f32x2 v = {lo, hi}; bf16x2_t b = __builtin_convertvector(v, bf16x2_t); return __builtin_bit_cast(unsigned, b); }
__device__ __forceinline__ void swap32(float& a, float& b) { asm volatile("s_nop 1\n\tv_permlane32_swap_b32 %0, %1" : "+v"(a), "+v"(b)); }
__device__ __forceinline__ float swapmax(float v) { float a = v, b = v; swap32(a, b); return fmaxf(a, b); }
__device__ __forceinline__ float swapsum(float v) { float a = v, b = v; swap32(a, b); return a + b; }
__device__ __forceinline__ s16x4 vtr(const LAS unsigned char* p) { return __builtin_bit_cast(s16x4, __builtin_amdgcn_ds_read_tr16_b64_v4i16((LAS v4i16_t*)p)); }

template <int NQ, int KRS>
__device__ __forceinline__ void qk_tile(f32x16& p0, f32x16& p1, const LAS unsigned char* kl, const bf16x8 (&qf)[NQ]) {
    p0 = f32x16{}; p1 = f32x16{};
#pragma unroll
    for (int d0 = 0; d0 < NQ; ++d0) {
        const bf16x8 a0 = *(const LAS bf16x8*)(kl + d0 * 32), a1 = *(const LAS bf16x8*)(kl + 32 * KRS + d0 * 32);
        p0 = __builtin_amdgcn_mfma_f32_32x32x16_bf16(a0, qf[d0], p0, 0, 0, 0);
        p1 = __builtin_amdgcn_mfma_f32_32x32x16_bf16(a1, qf[d0], p1, 0, 0, 0);
    }
}
template <bool ALIBI>
__device__ __forceinline__ void scale_bias(f32x16& p0, f32x16& p1, float c1, float c2, float pq, const LAS float* pk) {
#pragma unroll
    for (int g4 = 0; g4 < 4; ++g4) {
        if (ALIBI) { const f32x4 pa = *(const LAS f32x4*)(pk + 8 * g4), pb = *(const LAS f32x4*)(pk + 32 + 8 * g4);
#pragma unroll
            for (int j = 0; j < 4; ++j) { p0[4 * g4 + j] = p0[4 * g4 + j] * c1 - c2 * fabsf(pq - pa[j]); p1[4 * g4 + j] = p1[4 * g4 + j] * c1 - c2 * fabsf(pq - pb[j]); } }
        else {
#pragma unroll
            for (int j = 0; j < 4; ++j) { p0[4 * g4 + j] *= c1; p1[4 * g4 + j] *= c1; } }
    }
}
__device__ __forceinline__ void mask_range(f32x16& p0, f32x16& p1, int kb4, int klo, int khi) {
#pragma unroll
    for (int r = 0; r < 16; ++r) { const int k0 = kb4 + (r & 3) + 8 * (r >> 2), k1 = k0 + 32;
        p0[r] = (k0 >= klo && k0 <= khi) ? p0[r] : -__builtin_inff(); p1[r] = (k1 >= klo && k1 <= khi) ? p1[r] : -__builtin_inff(); }
}
__device__ __forceinline__ float tile_max(const f32x16& p0, const f32x16& p1) {
    float a = fmaxf(p0[0], p1[0]);
#pragma unroll
    for (int r = 1; r < 16; ++r) a = fmaxf(a, fmaxf(p0[r], p1[r]));
    return swapmax(a);
}
__device__ __forceinline__ void softmax_step(f32x16& p0, f32x16& p1, float& m, float& l, float& alpha) {
    const float mn = fmaxf(m, tile_max(p0, p1)); alpha = __builtin_amdgcn_exp2f(m - mn); m = mn;
    float ps = 0.f;
#pragma unroll
    for (int r = 0; r < 16; ++r) { p0[r] = __builtin_amdgcn_exp2f(p0[r] - mn); p1[r] = __builtin_amdgcn_exp2f(p1[r] - mn); ps += p0[r] + p1[r]; }
    l = l * alpha + ps;
}
__device__ __forceinline__ void rescale(f32x16 (&o)[4], float alpha) {
    if (!__all(alpha == 1.f)) {
#pragma unroll
        for (int d = 0; d < 4; ++d)
#pragma unroll
            for (int r = 0; r < 16; ++r) o[d][r] *= alpha; }
}
__device__ __forceinline__ bf16x8 pack8(const f32x16& p, int b) {
    u32x4 w; w.x = cvtpk(p[b], p[b + 1]); w.y = cvtpk(p[b + 2], p[b + 3]); w.z = cvtpk(p[b + 4], p[b + 5]); w.w = cvtpk(p[b + 6], p[b + 7]); return __builtin_bit_cast(bf16x8, w);
}
template <int NB = 2>
__device__ __forceinline__ void pv_tile(f32x16 (&o)[4], const f32x16& p0, const f32x16& p1, const LAS unsigned char* vl) {
    bf16x8 pf[4]; pf[0] = pack8(p0, 0); pf[1] = pack8(p0, 8); pf[2] = pack8(p1, 0); pf[3] = pack8(p1, 8);
#pragma unroll
    for (int s2 = 0; s2 < 4 / NB; ++s2) {
        s16x4 lo[NB][4], hh[NB][4];
#pragma unroll
        for (int si = 0; si < NB; ++si)
#pragma unroll
            for (int d = 0; d < 4; ++d) { lo[si][d] = vtr(vl + (NB * s2 + si) * 16 * VRS + d * 64); hh[si][d] = vtr(vl + (NB * s2 + si) * 16 * VRS + 8 * VRS + d * 64); }
#pragma unroll
        for (int si = 0; si < NB; ++si)
#pragma unroll
            for (int d = 0; d < 4; ++d) { const bf16x8 vf = {lo[si][d][0], lo[si][d][1], lo[si][d][2], lo[si][d][3], hh[si][d][0], hh[si][d][1], hh[si][d][2], hh[si][d][3]};
                o[d] = __builtin_amdgcn_mfma_f32_32x32x16_bf16(vf, pf[NB * s2 + si], o[d], 0, 0, 0); }
    }
}
__device__ __forceinline__ void zero_o(f32x16 (&o)[4]) {
#pragma unroll
    for (int d = 0; d < 4; ++d) o[d] = f32x16{};
}

struct TileRegs { u32x4 k0, k1, k2, v0, v1; float ps; };
__device__ __forceinline__ void load128(TileRegs& R, const bf16_t* kp, size_t ks, const bf16_t* vp, size_t vs, int tid) {
    const int r = tid >> 4, c = (tid & 15) * 8;
    R.k0 = *(const u32x4*)(kp + (size_t)r * ks + c); R.k1 = *(const u32x4*)(kp + (size_t)(r + 32) * ks + c);
    if (vp) { R.v0 = *(const u32x4*)(vp + (size_t)r * vs + c); R.v1 = *(const u32x4*)(vp + (size_t)(r + 32) * vs + c); }
}
__device__ __forceinline__ void store128(const TileRegs& R, LAS unsigned char* kb, LAS unsigned char* vb, LAS float* pb, int tid, bool hasv, bool haspos) {
    const int r = tid >> 4, c16 = (tid & 15) * 16;
    *(LAS u32x4*)(kb + r * 272 + c16) = R.k0; *(LAS u32x4*)(kb + (r + 32) * 272 + c16) = R.k1;
    if (hasv) { *(LAS u32x4*)(vb + r * VRS + c16) = R.v0; *(LAS u32x4*)(vb + (r + 32) * VRS + c16) = R.v1; }
    if (haspos && tid < 64) pb[tid] = R.ps;
}
__device__ __forceinline__ void load_mla(TileRegs& R, const bf16_t* kvm  , const bf16_t* kr  , int tid) {
    u32x4 kk[3];
#pragma unroll
    for (int i = 0; i < 3; ++i) { const int c = tid + 512 * i, r = c / 24, cc = c - r * 24;
        kk[i] = cc < 16 ? *(const u32x4*)(kvm + (size_t)r * 2048 + cc * 8) : *(const u32x4*)(kr + (size_t)r * 64 + (cc - 16) * 8); }
    R.k0 = kk[0]; R.k1 = kk[1]; R.k2 = kk[2];
    const int r = tid >> 4, c = (tid & 15) * 8;
    R.v0 = *(const u32x4*)(kvm + 128 + (size_t)r * 2048 + c); R.v1 = *(const u32x4*)(kvm + 128 + (size_t)(r + 32) * 2048 + c);
}
__device__ __forceinline__ void store_mla(const TileRegs& R, LAS unsigned char* kb, LAS unsigned char* vb, int tid) {
    { const int c = tid, r = c / 24, cc = c - r * 24; *(LAS u32x4*)(kb + r * 400 + cc * 16) = R.k0; }
    { const int c = tid + 512, r = c / 24, cc = c - r * 24; *(LAS u32x4*)(kb + r * 400 + cc * 16) = R.k1; }
    { const int c = tid + 1024, r = c / 24, cc = c - r * 24; *(LAS u32x4*)(kb + r * 400 + cc * 16) = R.k2; }
    const int r = tid >> 4, c16 = (tid & 15) * 16;
    *(LAS u32x4*)(vb + r * VRS + c16) = R.v0; *(LAS u32x4*)(vb + (r + 32) * VRS + c16) = R.v1;
}
__device__ __forceinline__ void store_o(bf16_t* rowp  , const f32x16 (&o)[4], float sc) {
#pragma unroll
    for (int d = 0; d < 4; ++d)
#pragma unroll
        for (int g4 = 0; g4 < 4; ++g4) { u32x2 w; w.x = cvtpk(o[d][4 * g4] * sc, o[d][4 * g4 + 1] * sc); w.y = cvtpk(o[d][4 * g4 + 2] * sc, o[d][4 * g4 + 3] * sc);
            *(u32x2*)(rowp + 32 * d + 8 * g4) = w; }
}
__device__ __forceinline__ void addstore_o(bf16_t* rowp  , const f32x16 (&o)[4], float sc) {
#pragma unroll
    for (int d = 0; d < 4; ++d)
#pragma unroll
        for (int g4 = 0; g4 < 4; ++g4) { const unsigned long long ov = __hip_atomic_load((const unsigned long long*)(rowp + 32 * d + 8 * g4), __ATOMIC_RELAXED, __HIP_MEMORY_SCOPE_AGENT);
            u32x2 old; old.x = (unsigned)ov; old.y = (unsigned)(ov >> 32);
            u32x2 w; w.x = cvtpk(bflo(old.x) + o[d][4 * g4] * sc, bfhi(old.x) + o[d][4 * g4 + 1] * sc); w.y = cvtpk(bflo(old.y) + o[d][4 * g4 + 2] * sc, bfhi(old.y) + o[d][4 * g4 + 3] * sc);
            *(u32x2*)(rowp + 32 * d + 8 * g4) = w; }
}

__device__ __forceinline__ void mla_unit(Frame& F, int h, int qb) {
    const int tid = F.tid, lane = F.lane, w = F.wave, r32 = lane & 31, hi = lane >> 5;
    const bf16_t* QM = WSP(bf16_t, WS_QM); const bf16_t* KVM = WSP(bf16_t, WS_KVM) + h * 256; const bf16_t* KR = WSP(bf16_t, WS_KROPE); bf16_t* BR = WSP(bf16_t, WS_BR);
    const float* rc = WSP(float, WS_ROPE); const float* rs = rc + (size_t)S * 32;
    LAS unsigned char* lds = F.lds;
    const int q = 256 * qb + 32 * w + r32;
    bf16x8 qf[12];
    { const bf16_t* qrow = QM + (size_t)q * 1536 + h * 192 + 8 * hi;
#pragma unroll
      for (int d0 = 0; d0 < 8; ++d0) qf[d0] = *(const bf16x8*)(qrow + 16 * d0);
#pragma unroll
      for (int dd = 0; dd < 2; ++dd) { const u32x4 a = *(const u32x4*)(qrow + 128 + 16 * dd), b = *(const u32x4*)(qrow + 160 + 16 * dd);
          const float* cp = rc + (size_t)q * 32 + 16 * dd + 8 * hi; const float* sp = rs + (size_t)q * 32 + 16 * dd + 8 * hi;
          const f32x4 c0 = *(const f32x4*)cp, c1 = *(const f32x4*)(cp + 4), s0 = *(const f32x4*)sp, s1 = *(const f32x4*)(sp + 4);
          float x1[8], x2[8], y1[8], y2[8];
          x1[0] = bflo(a.x); x1[1] = bfhi(a.x); x1[2] = bflo(a.y); x1[3] = bfhi(a.y); x1[4] = bflo(a.z); x1[5] = bfhi(a.z); x1[6] = bflo(a.w); x1[7] = bfhi(a.w);
          x2[0] = bflo(b.x); x2[1] = bfhi(b.x); x2[2] = bflo(b.y); x2[3] = bfhi(b.y); x2[4] = bflo(b.z); x2[5] = bfhi(b.z); x2[6] = bflo(b.w); x2[7] = bfhi(b.w);
#pragma unroll
          for (int j = 0; j < 8; ++j) { const float c = j < 4 ? c0[j & 3] : c1[j & 3], s = j < 4 ? s0[j & 3] : s1[j & 3]; y1[j] = x1[j] * c - x2[j] * s; y2[j] = x1[j] * s + x2[j] * c; }
          u32x4 o1, o2; o1.x = cvtpk(y1[0], y1[1]); o1.y = cvtpk(y1[2], y1[3]); o1.z = cvtpk(y1[4], y1[5]); o1.w = cvtpk(y1[6], y1[7]);
          o2.x = cvtpk(y2[0], y2[1]); o2.y = cvtpk(y2[2], y2[3]); o2.z = cvtpk(y2[4], y2[5]); o2.w = cvtpk(y2[6], y2[7]);
          qf[8 + dd] = __builtin_bit_cast(bf16x8, o1); qf[10 + dd] = __builtin_bit_cast(bf16x8, o2); } }
    const float c1s = 0.07216878364870322f * LOG2E;
    float m = -1e30f, l = 0.f, alpha; f32x16 o[4]; zero_o(o); f32x16 p0, p1;
    const int nt = 4 * (qb + 1), mydiag = 4 * qb + (w >> 1);
    const LAS unsigned char* kl0 = lds + L_K + r32 * 400 + hi * 16;
    const LAS unsigned char* vl0 = lds + L_V + (4 * hi + ((lane & 15) >> 2)) * VRS + (16 * ((lane >> 4) & 1) + 4 * (lane & 3)) * 2;
    TileRegs R;
    load_mla(R, KVM, KR, tid);
    for (int t = 0; t < nt; ++t) { const int b = t & 1;
        store_mla(R, lds + L_K + b * KBUF, lds + L_V + b * VBUF, tid);
        __syncthreads();
        if (t + 1 < nt) load_mla(R, KVM + (size_t)(t + 1) * 64 * 2048, KR + (size_t)(t + 1) * 64 * 64, tid);
        if (t <= mydiag) {
            qk_tile<12, 400>(p0, p1, kl0 + b * KBUF, qf);
            scale_bias<false>(p0, p1, c1s, 0.f, 0.f, nullptr);
            if (t == mydiag) mask_range(p0, p1, 64 * t + 4 * hi, 0, q);
            softmax_step(p0, p1, m, l, alpha); rescale(o, alpha);
            pv_tile(o, p0, p1, vl0 + b * VBUF);
        }
    }
    l = swapsum(l); const float inv = l > 0.f ? 1.f / l : 0.f;
    store_o(BR + (size_t)q * 3072 + h * 128 + 4 * hi, o, inv);
}

__device__ __forceinline__ void diff_unit(Frame& F, const Args& args, int l_idx, int h, int qb) {
    const int tid = F.tid, lane = F.lane, w = F.wave, r32 = lane & 31, hi = lane >> 5, mp = w >> 2, wq = w & 3;
    const bf16_t* Z = WSP(bf16_t, WS_Z); bf16_t* BR = WSP(bf16_t, WS_BR);
    LAS unsigned char* lds = F.lds;
    const int q = 128 * qb + 32 * wq + r32;
    bf16x8 qf[4];
    { const bf16_t* qrow = Z + (size_t)q * LDZ + ZC_DQ + h * 128 + mp * 64 + 8 * hi;
#pragma unroll
      for (int d0 = 0; d0 < 4; ++d0) qf[d0] = *(const bf16x8*)(qrow + 16 * d0); }
    const float slope = exp2f(-0.5f * (float)(2 * h + 1));
    const float c1s = 0.125f * LOG2E, c2s = slope * LOG2E, pq = (float)F.pos[q];
    float m = -1e30f, l = 0.f, alpha; f32x16 o[4]; zero_o(o); f32x16 p0, p1;
    const int nt = 2 * (qb + 1), mydiag = 2 * qb + (wq >> 1);
    const bf16_t* kp = Z + ZC_DK + h * 128; const bf16_t* vp = Z + ZC_DV + h * 128;
    const LAS unsigned char* kl0 = lds + L_K + r32 * 272 + hi * 16 + mp * 128;
    const LAS unsigned char* vl0 = lds + L_V + (4 * hi + ((lane & 15) >> 2)) * VRS + (16 * ((lane >> 4) & 1) + 4 * (lane & 3)) * 2;
    TileRegs R;
    load128(R, kp, LDZ, vp, LDZ, tid); if (tid < 64) R.ps = (float)F.pos[tid];
    for (int t = 0; t < nt; ++t) { const int b = t & 1;
        store128(R, lds + L_K + b * KBUF, lds + L_V + b * VBUF, (LAS float*)(lds + L_POS + b * PBUF), tid, true, true);
        __syncthreads();
        if (t + 1 < nt) { load128(R, kp + (size_t)(t + 1) * 64 * LDZ, LDZ, vp + (size_t)(t + 1) * 64 * LDZ, LDZ, tid); if (tid < 64) R.ps = (float)F.pos[(t + 1) * 64 + tid]; }
        if (t <= mydiag) {
            qk_tile<4, 272>(p0, p1, kl0 + b * KBUF, qf);
            scale_bias<true>(p0, p1, c1s, c2s, pq, (const LAS float*)(lds + L_POS + b * PBUF) + 4 * hi);
            if (t == mydiag) mask_range(p0, p1, 64 * t + 4 * hi, 0, q);
            softmax_step(p0, p1, m, l, alpha); rescale(o, alpha);
            pv_tile(o, p0, p1, vl0 + b * VBUF);
        }
    }
    l = swapsum(l); const float inv = l > 0.f ? 1.f / l : 0.f;
    __syncthreads();
    LAS float* xb = (LAS float*)lds + wq * 4096 + lane;
    if (mp == 1) {
#pragma unroll
        for (int d = 0; d < 4; ++d)
#pragma unroll
            for (int r = 0; r < 16; ++r) xb[(16 * d + r) * 64] = o[d][r] * inv;
    }
    __syncthreads();
    if (mp == 0) {
        const float* lp = args.in[IN_DLAM] + (size_t)l_idx * 256;
        const float lam_init = 0.8f - 0.6f * expf(-0.3f * (float)l_idx);
        const float lam = expf(wave_sum(lp[lane] * lp[64 + lane])) - expf(wave_sum(lp[128 + lane] * lp[192 + lane])) + lam_init;
        float ss = 0.f;
#pragma unroll
        for (int d = 0; d < 4; ++d)
#pragma unroll
            for (int r = 0; r < 16; ++r) { const float a = o[d][r] * inv - lam * xb[(16 * d + r) * 64]; o[d][r] = a; ss += a * a; }
        ss = swapsum(ss);
        const float rr = (1.f - lam_init) / sqrtf(ss * (1.f / 128.f) + 1e-6f);
        const float* gs = args.in[IN_DSUB] + (size_t)l_idx * 128 + 4 * hi;
#pragma unroll
        for (int d = 0; d < 4; ++d)
#pragma unroll
            for (int g4 = 0; g4 < 4; ++g4) { const f32x4 gv = *(const f32x4*)(gs + 32 * d + 8 * g4);
#pragma unroll
                for (int j = 0; j < 4; ++j) o[d][4 * g4 + j] *= gv[j]; }
        store_o(BR + (size_t)q * 3072 + 1024 + h * 128 + 4 * hi, o, rr);
    }
}

__device__ __forceinline__ void nsa_unit(Frame& F, int g, int qb) {
    const int tid = F.tid, lane = F.lane, w = F.wave, r32 = lane & 31, hi = lane >> 5;
    const bf16_t* Z = WSP(bf16_t, WS_Z); const bf16_t* KC = WSP(bf16_t, WS_KCMP); bf16_t* BR = WSP(bf16_t, WS_BR);
    LAS unsigned char* lds = F.lds;
    const int q0 = 64 * qb, qi = 8 * w + (r32 >> 2), q = q0 + qi, hh = 4 * g + (r32 & 3);
    bf16x8 qf[8];
    { const bf16_t* qrow = Z + (size_t)q * LDZ + ZC_NQ + hh * 128 + 8 * hi;
#pragma unroll
      for (int d0 = 0; d0 < 8; ++d0) qf[d0] = *(const bf16x8*)(qrow + 16 * d0); }
    const float slope = exp2f(-(float)(hh + 1));
    const float c1s = 0.08838834764831845f * LOG2E, c2s = slope * LOG2E, pq = (float)F.pos[q];
    float g0, g1, g2; { const bf16_t* gl = Z + (size_t)q * LDZ + ZC_NG + hh * 3; g0 = sigmoidf_(bf1(gl[0])); g1 = sigmoidf_(bf1(gl[1])); g2 = sigmoidf_(bf1(gl[2])); }
    bf16_t* orow = BR + (size_t)q * 3072 + 2048 + hh * 128 + 4 * hi;
    LAS float* imp = (LAS float*)(lds + L_IMP); LAS unsigned* sel = (LAS unsigned*)(lds + L_SEL); LAS unsigned* ctrl = (LAS unsigned*)(lds + L_CTRL); LAS unsigned* list = (LAS unsigned*)(lds + L_LIST);
    const LAS unsigned char* kl0 = lds + L_K + r32 * 272 + hi * 16;
    const LAS unsigned char* vl0 = lds + L_V + (4 * hi + ((lane & 15) >> 2)) * VRS + (16 * ((lane >> 4) & 1) + 4 * (lane & 3)) * 2;
    f32x16 o[4], p0, p1; TileRegs R; float alpha;
    for (int i = tid; i < 64 * 128; i += NTHREADS) imp[i] = 0.f;
    if (tid < 4) ctrl[4 + tid] = 0u;
    const int ntc = ((4 * qb + 2) >> 6) + 1;
    const int khi_c = q >= 31 ? ((q - 31) >> 4) : -1;
    const bf16_t* kc = KC + ((size_t)(0 * 2 + g) * 512) * 128; const bf16_t* vc = KC + ((size_t)(1 * 2 + g) * 512) * 128;
    float m = -1e30f, l = 0.f;
#define CMP_POS(t) do { if (tid < 64) { int pi = 31 + 16 * ((t) * 64 + tid); pi = pi < S ? pi : S - 1; R.ps = (float)F.pos[pi]; } } while (0)
    load128(R, kc, 128, nullptr, 0, tid); CMP_POS(0);
    for (int t = 0; t < ntc; ++t) { const int b = t & 1;
        store128(R, lds + L_K + b * KBUF, nullptr, (LAS float*)(lds + L_POS + b * PBUF), tid, false, true);
        __syncthreads();
        if (t + 1 < ntc) { load128(R, kc + (size_t)(t + 1) * 64 * 128, 128, nullptr, 0, tid); CMP_POS(t + 1); }
        qk_tile<8, 272>(p0, p1, kl0 + b * KBUF, qf);
        scale_bias<true>(p0, p1, c1s, c2s, pq, (const LAS float*)(lds + L_POS + b * PBUF) + 4 * hi);
        mask_range(p0, p1, 64 * t + 4 * hi, 0, khi_c);
        softmax_step(p0, p1, m, l, alpha);
    }
    __syncthreads();
    l = swapsum(l); const float invl = l > 0.f ? 1.f / l : 0.f;
    load128(R, kc, 128, nullptr, 0, tid); CMP_POS(0);
    for (int t = 0; t < ntc; ++t) { const int b = t & 1;
        store128(R, lds + L_K + b * KBUF, nullptr, (LAS float*)(lds + L_POS + b * PBUF), tid, false, true);
        __syncthreads();
        if (t + 1 < ntc) { load128(R, kc + (size_t)(t + 1) * 64 * 128, 128, nullptr, 0, tid); CMP_POS(t + 1); }
        qk_tile<8, 272>(p0, p1, kl0 + b * KBUF, qf);
        scale_bias<true>(p0, p1, c1s, c2s, pq, (const LAS float*)(lds + L_POS + b * PBUF) + 4 * hi);
        mask_range(p0, p1, 64 * t + 4 * hi, 0, khi_c);
        LAS float* ip = imp + qi * 128 + 16 * t + hi;
#pragma unroll
        for (int k4 = 0; k4 < 4; ++k4) {
            const float e0 = __builtin_amdgcn_exp2f(p0[4 * k4] - m) * invl, e1 = __builtin_amdgcn_exp2f(p0[4 * k4 + 1] - m) * invl, e2 = __builtin_amdgcn_exp2f(p0[4 * k4 + 2] - m) * invl, e3 = __builtin_amdgcn_exp2f(p0[4 * k4 + 3] - m) * invl;
            const float f0 = __builtin_amdgcn_exp2f(p1[4 * k4] - m) * invl, f1 = __builtin_amdgcn_exp2f(p1[4 * k4 + 1] - m) * invl, f2 = __builtin_amdgcn_exp2f(p1[4 * k4 + 2] - m) * invl, f3 = __builtin_amdgcn_exp2f(p1[4 * k4 + 3] - m) * invl;
            const int j0 = 2 * k4, j1 = 8 + 2 * k4;
            __hip_atomic_fetch_add(ip + j0, (e0 + e1) + (e2 + e3), __ATOMIC_RELAXED, __HIP_MEMORY_SCOPE_WORKGROUP);
            if (16 * t + hi + j0 + 1 < 128) __hip_atomic_fetch_add(ip + j0 + 1, e3, __ATOMIC_RELAXED, __HIP_MEMORY_SCOPE_WORKGROUP);
            __hip_atomic_fetch_add(ip + j1, (f0 + f1) + (f2 + f3), __ATOMIC_RELAXED, __HIP_MEMORY_SCOPE_WORKGROUP);
            if (16 * t + hi + j1 + 1 < 128) __hip_atomic_fetch_add(ip + j1 + 1, f3, __ATOMIC_RELAXED, __HIP_MEMORY_SCOPE_WORKGROUP); }
    }
    __syncthreads();
    { unsigned u0 = 0u, u1 = 0u, u2 = 0u, u3 = 0u;
      for (int qq = 0; qq < 8; ++qq) { LAS float* iq = imp + (8 * w + qq) * 128;
          const int j0 = lane, j1 = lane + 64;
          const float v0 = (j0 == 0 || j0 == qb || j0 == qb - 1) ? __builtin_inff() : (j0 <= qb ? iq[j0] : -__builtin_inff());
          const float v1 = (j1 == qb || j1 == qb - 1) ? __builtin_inff() : (j1 <= qb ? iq[j1] : -__builtin_inff());
          WAVE_LDS_SYNC();
          iq[j0] = v0; iq[j1] = v1;
          WAVE_LDS_SYNC();
          int c0 = 0, c1 = 0;
          for (int k4 = 0; k4 <= (qb >> 2); ++k4) { const f32x4 vv = *(const LAS f32x4*)(iq + 4 * k4);
#pragma unroll
              for (int jj = 0; jj < 4; ++jj) { const int k = 4 * k4 + jj; const float vk = vv[jj];
                  c0 += (vk > v0 || (vk == v0 && k < j0)) ? 1 : 0; c1 += (vk > v1 || (vk == v1 && k < j1)) ? 1 : 0; } }
          const unsigned long long mlo = __ballot(c0 < 16 && v0 > -__builtin_inff()), mhi = __ballot(c1 < 16 && v1 > -__builtin_inff());
          const unsigned a0 = (unsigned)mlo, a1 = (unsigned)(mlo >> 32), a2 = (unsigned)mhi, a3 = (unsigned)(mhi >> 32);
          if (lane == 0) { LAS unsigned* sq = sel + (8 * w + qq) * 4; sq[0] = a0; sq[1] = a1; sq[2] = a2; sq[3] = a3; }
          u0 |= a0; u1 |= a1; u2 |= a2; u3 |= a3; }
      if (lane == 0) { __hip_atomic_fetch_or(ctrl + 4, u0, __ATOMIC_RELAXED, __HIP_MEMORY_SCOPE_WORKGROUP); __hip_atomic_fetch_or(ctrl + 5, u1, __ATOMIC_RELAXED, __HIP_MEMORY_SCOPE_WORKGROUP);
          __hip_atomic_fetch_or(ctrl + 6, u2, __ATOMIC_RELAXED, __HIP_MEMORY_SCOPE_WORKGROUP); __hip_atomic_fetch_or(ctrl + 7, u3, __ATOMIC_RELAXED, __HIP_MEMORY_SCOPE_WORKGROUP); }
      __syncthreads();
      if (tid == 0) { int n = 0;
          for (int w4 = 0; w4 < 4; ++w4) { unsigned bits = ctrl[4 + w4]; while (bits) { const int b = __builtin_ctz(bits); bits &= bits - 1u; list[n++] = (unsigned)(32 * w4 + b); } }
          ctrl[8] = (unsigned)n; }
      __syncthreads();
      zero_o(o);
      load128(R, kc, 128, vc, 128, tid); CMP_POS(0);
      for (int t = 0; t < ntc; ++t) { const int b = t & 1;
          store128(R, lds + L_K + b * KBUF, lds + L_V + b * VBUF, (LAS float*)(lds + L_POS + b * PBUF), tid, true, true);
          __syncthreads();
          if (t + 1 < ntc) { load128(R, kc + (size_t)(t + 1) * 64 * 128, 128, vc + (size_t)(t + 1) * 64 * 128, 128, tid); CMP_POS(t + 1); }
          qk_tile<8, 272>(p0, p1, kl0 + b * KBUF, qf);
          scale_bias<true>(p0, p1, c1s, c2s, pq, (const LAS float*)(lds + L_POS + b * PBUF) + 4 * hi);
          mask_range(p0, p1, 64 * t + 4 * hi, 0, khi_c);
#pragma unroll
          for (int r = 0; r < 16; ++r) { p0[r] = __builtin_amdgcn_exp2f(p0[r] - m) * invl; p1[r] = __builtin_amdgcn_exp2f(p1[r] - m) * invl; }
          pv_tile<1>(o, p0, p1, vl0 + b * VBUF);
      }
      __syncthreads();
      store_o(orow, o, g0);
#undef CMP_POS
      const unsigned s0 = sel[qi * 4 + 0], s1 = sel[qi * 4 + 1], s2 = sel[qi * 4 + 2], s3 = sel[qi * 4 + 3];
      const int nb = (int)ctrl[8];
      const bf16_t* ks = Z + ZC_NKV + ((1 * 2 + 0) * 2 + g) * 128; const bf16_t* vs = Z + ZC_NKV + ((1 * 2 + 1) * 2 + g) * 128;
      m = -1e30f; l = 0.f; zero_o(o);
      if (nb > 0) { const int j = (int)list[0]; load128(R, ks + (size_t)j * 64 * LDZ, LDZ, vs + (size_t)j * 64 * LDZ, LDZ, tid); if (tid < 64) R.ps = (float)F.pos[64 * j + tid]; }
      for (int t = 0; t < nb; ++t) { const int b = t & 1; const int j = (int)list[t];
          store128(R, lds + L_K + b * KBUF, lds + L_V + b * VBUF, (LAS float*)(lds + L_POS + b * PBUF), tid, true, true);
          __syncthreads();
          if (t + 1 < nb) { const int jn = (int)list[t + 1]; load128(R, ks + (size_t)jn * 64 * LDZ, LDZ, vs + (size_t)jn * 64 * LDZ, LDZ, tid); if (tid < 64) R.ps = (float)F.pos[64 * jn + tid]; }
          const unsigned wsel = (j < 32 ? u0 : j < 64 ? u1 : j < 96 ? u2 : u3) >> (j & 31);
          if (wsel & 1u) {
              const unsigned mine = ((j < 32 ? s0 : j < 64 ? s1 : j < 96 ? s2 : s3) >> (j & 31)) & 1u;
              qk_tile<8, 272>(p0, p1, kl0 + b * KBUF, qf);
              scale_bias<true>(p0, p1, c1s, c2s, pq, (const LAS float*)(lds + L_POS + b * PBUF) + 4 * hi);
              mask_range(p0, p1, 64 * j + 4 * hi, 0, mine ? q : -1);
              softmax_step(p0, p1, m, l, alpha); rescale(o, alpha);
              pv_tile<1>(o, p0, p1, vl0 + b * VBUF);
          }
      }
      __syncthreads();
      l = swapsum(l); addstore_o(orow, o, l > 0.f ? g1 / l : 0.f);
    }
    { const bf16_t* kw = Z + ZC_NKV + ((2 * 2 + 0) * 2 + g) * 128; const bf16_t* vw = Z + ZC_NKV + ((2 * 2 + 1) * 2 + g) * 128;
      const int kb0 = q0 >= 512 ? q0 - 512 : 0, nw = (q0 - kb0) / 64 + 1;
      m = -1e30f; l = 0.f; zero_o(o);
      load128(R, kw + (size_t)kb0 * LDZ, LDZ, vw + (size_t)kb0 * LDZ, LDZ, tid); if (tid < 64) R.ps = (float)F.pos[kb0 + tid];
      for (int t = 0; t < nw; ++t) { const int b = t & 1; const int kb = kb0 + 64 * t;
          store128(R, lds + L_K + b * KBUF, lds + L_V + b * VBUF, (LAS float*)(lds + L_POS + b * PBUF), tid, true, true);
          __syncthreads();
          if (t + 1 < nw) { load128(R, kw + (size_t)(kb + 64) * LDZ, LDZ, vw + (size_t)(kb + 64) * LDZ, LDZ, tid); if (tid < 64) R.ps = (float)F.pos[kb + 64 + tid]; }
          qk_tile<8, 272>(p0, p1, kl0 + b * KBUF, qf);
          scale_bias<true>(p0, p1, c1s, c2s, pq, (const LAS float*)(lds + L_POS + b * PBUF) + 4 * hi);
          if (t == 0 || t == nw - 1) mask_range(p0, p1, kb + 4 * hi, q - 511, q);
          softmax_step(p0, p1, m, l, alpha); rescale(o, alpha);
          pv_tile<1>(o, p0, p1, vl0 + b * VBUF);
      }
      __syncthreads();
      l = swapsum(l); addstore_o(orow, o, l > 0.f ? g2 / l : 0.f);
    }
}
}

#ifndef FAST_MLA
#define FAST_MLA 1
#endif
#ifndef FAST_DIFF
#define FAST_DIFF 1
#endif
#ifndef FAST_NSA
#define FAST_NSA 1
#endif
constexpr int ATT_NITEMS = 1024;
__device__ const unsigned short ATT_ORDER[ATT_NITEMS] = {
  31,287,543,799,1055,1311,1567,1823,30,286,542,798,1054,1310,1566,1822,29,285,541,797,1053,1309,1565,1821,28,284,540,796,1052,1308,1564,1820,
  27,283,539,795,1051,1307,1563,1819,26,282,538,794,1050,1306,1562,1818,25,281,537,793,1049,1305,1561,1817,24,280,536,792,1048,1304,1560,1816,
  23,279,535,791,1047,1303,1559,1815,22,278,534,790,1046,1302,1558,1814,21,277,533,789,1045,1301,1557,1813,20,276,532,788,1044,1300,1556,1812,
  19,275,531,787,1043,1299,1555,1811,4159,4415,4671,4927,5183,5439,5695,5951,18,274,530,786,1042,1298,1554,1810,4158,4414,4670,4926,5182,5438,5694,5950,
  4157,4413,4669,4925,5181,5437,5693,5949,4156,4412,4668,4924,5180,5436,5692,5948,17,273,529,785,1041,1297,1553,1809,4155,4411,4667,4923,5179,5435,5691,5947,
  4154,4410,4666,4922,5178,5434,5690,5946,4153,4409,4665,4921,5177,5433,5689,5945,4152,4408,4664,4920,5176,5432,5688,5944,16,272,528,784,1040,1296,1552,1808,
  4151,4407,4663,4919,5175,5431,5687,5943,4150,4406,4662,4918,5174,5430,5686,5942,4149,4405,4661,4917,5173,5429,5685,5941,15,271,527,783,1039,1295,1551,1807,
  4148,4404,4660,4916,5172,5428,5684,5940,4147,4403,4659,4915,5171,5427,5683,5939,4146,4402,4658,4914,5170,5426,5682,5938,14,270,526,782,1038,1294,1550,1806,
  4145,4401,4657,4913,5169,5425,5681,5937,8319,8575,4144,4400,4656,4912,5168,5424,5680,5936,8318,8574,8317,8573,8316,8572,8315,8571,8314,8570,8313,8569,4143,4399,
  4655,4911,5167,5423,5679,5935,8312,8568,8311,8567,8310,8566,8309,8565,8308,8564,8307,8563,4142,4398,4654,4910,5166,5422,5678,5934,8306,8562,8305,8561,13,269,
  525,781,1037,1293,1549,1805,8304,8560,4141,4397,4653,4909,5165,5421,5677,5933,8303,8559,8302,8558,8301,8557,4140,4396,4652,4908,5164,5420,5676,5932,8300,8556,
  8299,8555,8298,8554,8297,8553,8296,8552,8295,8551,4139,4395,4651,4907,5163,5419,5675,5931,8294,8550,8293,8549,8292,8548,8291,8547,12,268,524,780,1036,1292,
  1548,1804,8290,8546,8289,8545,4138,4394,4650,4906,5162,5418,5674,5930,8288,8544,4137,4393,4649,4905,5161,5417,5673,5929,8287,8543,8286,8542,8285,8541,8284,8540,
  8283,8539,4136,4392,4648,4904,5160,5416,5672,5928,8282,8538,8281,8537,8280,8536,8279,8535,8278,8534,8277,8533,11,267,523,779,1035,1291,1547,1803,4135,4391,
  4647,4903,5159,5415,5671,5927,8276,8532,8275,8531,8274,8530,8273,8529,8272,8528,4134,4390,4646,4902,5158,5414,5670,5926,8271,8527,4133,4389,4645,4901,5157,5413,
  5669,5925,8270,8526,8269,8525,8268,8524,8267,8523,8266,8522,8265,8521,4132,4388,4644,4900,5156,5412,5668,5924,8264,8520,8263,8519,10,266,522,778,1034,1290,
  1546,1802,8262,8518,8261,8517,8260,8516,8259,8515,4131,4387,4643,4899,5155,5411,5667,5923,8258,8514,8257,8513,8256,8512,4130,4386,4642,4898,5154,5410,5666,5922,
  8255,8511,8254,8510,8253,8509,4129,4385,4641,4897,5153,5409,5665,5921,8252,8508,8251,8507,8250,8506,8249,8505,9,265,521,777,1033,1289,1545,1801,8248,8504,
  8247,8503,4128,4384,4640,4896,5152,5408,5664,5920,8246,8502,8245,8501,8244,8500,8243,8499,8242,8498,8241,8497,4127,4383,4639,4895,5151,5407,5663,5919,8240,8496,
  4126,4382,4638,4894,5150,5406,5662,5918,8239,8495,8238,8494,8237,8493,8236,8492,8235,8491,8,264,520,776,1032,1288,1544,1800,4125,4381,4637,4893,5149,5405,
  5661,5917,8234,8490,8233,8489,8232,8488,8231,8487,8230,8486,8229,8485,4124,4380,4636,4892,5148,5404,5660,5916,8228,8484,8227,8483,8226,8482,8225,8481,8224,8480,
  4123,4379,4635,4891,5147,5403,5659,5915,8223,8479,4122,4378,4634,4890,5146,5402,5658,5914,8222,8478,8221,8477,7,263,519,775,1031,1287,1543,1799,8220,8476,
  8219,8475,8218,8474,8217,8473,4121,4377,4633,4889,5145,5401,5657,5913,8216,8472,8215,8471,8214,8470,8213,8469,8212,8468,8211,8467,4120,4376,4632,4888,5144,5400,
  5656,5912,8210,8466,4119,4375,4631,4887,5143,5399,5655,5911,8209,8465,6,262,518,774,1030,1286,1542,1798,4118,4374,4630,4886,5142,5398,5654,5910,8208,8464,
  4117,4373,4629,4885,5141,5397,5653,5909,4116,4372,4628,4884,5140,5396,5652,5908,8207,8463,5,261,517,773,1029,1285,1541,1797,4115,4371,4627,4883,5139,5395,
  5651,5907,8206,8462,8205,8461,4114,4370,4626,4882,5138,5394,5650,5906,8204,8460,4113,4369,4625,4881,5137,5393,5649,5905,8203,8459,4112,4368,4624,4880,5136,5392,
  5648,5904,4,260,516,772,1028,1284,1540,1796,8202,8458,4111,4367,4623,4879,5135,5391,5647,5903,8201,8457,4110,4366,4622,4878,5134,5390,5646,5902,8200,8456,
  4109,4365,4621,4877,5133,5389,5645,5901,8199,8455,3,259,515,771,1027,1283,1539,1795,4108,4364,4620,4876,5132,5388,5644,5900,4107,4363,4619,4875,5131,5387,
  5643,5899,8198,8454,4106,4362,4618,4874,5130,5386,5642,5898,8197,8453,2,258,514,770,1026,1282,1538,1794,4105,4361,4617,4873,5129,5385,5641,5897,4104,4360,
  4616,4872,5128,5384,5640,5896,8196,8452,4103,4359,4615,4871,5127,5383,5639,5895,8195,8451,4102,4358,4614,4870,5126,5382,5638,5894,1,257,513,769,1025,1281,
  1537,1793,4101,4357,4613,4869,5125,5381,5637,5893,8194,8450,4100,4356,4612,4868,5124,5380,5636,5892,8193,8449,4099,4355,4611,4867,5123,5379,5635,5891,0,256,
  512,768,1024,1280,1536,1792,4098,4354,4610,4866,5122,5378,5634,5890,8192,8448,4097,4353,4609,4865,5121,5377,5633,5889,4096,4352,4608,4864,5120,5376,5632,5888,
};

__device__ __forceinline__ void attn_phase(Frame& F, const Args& args, int l) {
    LAS int* slot = (LAS int*)(F.lds + fa::L_CTRL);
    gu32* head = F.ctl + CW_QUEUE + 64 * l;
    for (;;) {
        __syncthreads();
        if (F.tid == 0) *slot = (int)__hip_atomic_fetch_add(head, 1u, __ATOMIC_RELAXED, __HIP_MEMORY_SCOPE_AGENT);
        __syncthreads();
        const int idx = *slot;
        if (idx >= ATT_NITEMS) break;
        fresh(F, args);
        const unsigned code = ATT_ORDER[idx]; const int type = code >> 12, hd = (code >> 8) & 15, qb = code & 255;
#ifndef ATT_REP_MASK
#define ATT_REP_MASK 0
#endif
        for (int rep = 0; rep <= ((ATT_REP_MASK >> type) & 1); ++rep) {
            if (rep) { __syncthreads(); fresh(F, args); }
            if (type == 0) { if (FAST_MLA) fa::mla_unit(F, hd, qb); }
            else if (type == 1) { if (FAST_DIFF) fa::diff_unit(F, args, l, hd, qb); }
            else { if (FAST_NSA) fa::nsa_unit(F, hd, qb); }
        }
    }
}

#ifndef MK_N_LAUNCHES
#define MK_N_LAUNCHES 1
#endif
constexpr int NPHASE = 2 + 9 * NL;
__global__ void __launch_bounds__(NTHREADS, 2) fwd(Args args) {
    extern __shared__ __attribute__((aligned(16))) unsigned char lds[];
    Frame F;
    F.lds = (LAS unsigned char*)lds;
    F.MISC = (volatile LAS unsigned*)(F.lds + MISC_OFF);
    F.tid = threadIdx.x; F.lane = F.tid & 63; F.wave = __builtin_amdgcn_readfirstlane(F.tid >> 6);
    F.G = gridDim.x; F.bid = blockIdx.x; F.gw = blockIdx.x * NWAVES + F.wave; F.NGW = F.G * NWAVES;
    F.pos = (const int*)args.in[IN_POS]; F.out = args.out; F.ws = (GAS unsigned char*)args.ws;
    F.ctl = (gu32*)(F.ws + WS_CTL);
    for (int u = F.tid; u < (LDS_BYTES - MISC_OFF) / 4; u += NTHREADS) ((LAS unsigned*)(F.lds + MISC_OFF))[u] = 0u;
    __syncthreads();
    const int lo = args.ph_lo, hi = args.ph_hi;
    XcdBarrier bar; bar.bar = (unsigned*)(F.ctl + CW_BAR); bar.x = 0; bar.st = F.MISC + 8;
    if (hi - lo > 1) bar = xcd_barrier_post((unsigned*)(F.ctl + CW_BAR), F.MISC + 8);
#define IN(k) (lo <= (k) && (k) < hi)
#ifndef PH_REP_MASK
#define PH_REP_MASK 0
#endif
#define REPLOOP(k) for (int rep = 0; rep <= ((PH_REP_MASK >> (k)) & 1); ++rep)
#ifdef PROF
#define TSP ((unsigned long long*)((unsigned char*)args.ws + WS_CTL + 512 * 1024))
#define STAMP(k) do { if (blockIdx.x == 0 && threadIdx.x == 0) __hip_atomic_store(TSP + (k), (unsigned long long)wall_clock64(), __ATOMIC_RELAXED, __HIP_MEMORY_SCOPE_AGENT); } while (0)
#else
#define STAMP(k) do { } while (0)
#endif
#define SEAM(k) do { if (IN(k) && IN((k) + 1)) xcd_barrier(bar); STAMP((k) + 1); } while (0)

#define Z WSP(bf16_t, WS_Z)
#define H WSP(bf16_t, WS_H)
#define X WSP(float, WS_X)
#define Y WSP(float, WS_Y)
#define SSQ WSP(float, WS_SSQ)
#define MODL (WSP(float, WS_MOD) + (size_t)l * 6 * D)

    #ifndef SKIP_P0
    STAMP(0);
    if (IN(0)) REPLOOP(9) { __syncthreads(); fresh(F, args); p0_prologue(F, args); }
#endif
    SEAM(0);

    for (int l = 0; l < NL; ++l) {
        const int pb = 1 + 9 * l;
        if (IN(pb + 0)) REPLOOP(0) { fresh(F, args);
            if (l == 0) ln_rows(F, args.in[IN_X], false, nullptr, nullptr, nullptr, true, MODL, MODL + D, H, SSQ);
            else ln_rows(F, Y, true, args.in[IN_LN2G] + (size_t)(l - 1) * D, args.in[IN_LN2B] + (size_t)(l - 1) * D, X, true, MODL, MODL + D, H, SSQ);
        }
        SEAM(pb + 0);
        if (IN(pb + 1)) REPLOOP(1) { fresh(F, args);
            pg8::Gemm g{H, WLP(bf16_t, l, WL_IN), D, D, D, 0, 0}; pg8::PlainOrder So; So.init(S, LDZ, F.G, F.bid);
            pg8::EpiZ E{Z, rep ? nullptr : SSQ};
            pg8::gemm_phase<pg8::EpiZ, pg8::PlainOrder, true>(F.lds, g, So, E, F.tid);
        }
        SEAM(pb + 1);
        if (IN(pb + 2)) REPLOOP(2) {
            { fresh(F, args); pg8::Gemm g{Z + ZC_CQ, WLP(bf16_t, l, WL_UQ), 512, LDZ, 512, 0, 0}; pg8::PlainOrder So; So.init(S, 1536, F.G, F.bid);
              pg8::EpiRs E{WSP(bf16_t, WS_QM), 1536, SSQ, 0, 1.f / 512.f};
              pg8::gemm_phase<pg8::EpiRs, pg8::PlainOrder, false>(F.lds, g, So, E, F.tid); }
            { fresh(F, args); pg8::Gemm g{Z + ZC_CKV, WLP(bf16_t, l, WL_UKV), 256, LDZ, 256, 0, 0}; pg8::PlainOrder So; So.init(S, 2048, F.G, F.bid);
              pg8::EpiRs E{WSP(bf16_t, WS_KVM), 2048, SSQ, 1, 1.f / 256.f};
              pg8::gemm_phase<pg8::EpiRs, pg8::PlainOrder, false>(F.lds, g, So, E, F.tid); }
#ifndef SKIP_SIDE
            fresh(F, args); krope_job(F);
#ifdef NAIVE_COMPRESS
            compress_naive(F, args, l);
#else
            compress_mfma(F, args, l);
#endif
#endif
        }
        SEAM(pb + 2);
        if (IN(pb + 3)) { fresh(F, args); attn_phase(F, args, l);
#if !(FAST_MLA && FAST_DIFF && FAST_NSA)
            __syncthreads(); fresh(F, args); attn_naive(F, args, l, !FAST_MLA, !FAST_DIFF, !FAST_NSA);
#endif
        }
        SEAM(pb + 3);

#ifdef DIAG
        if (l == 0) {
            xcd_barrier(bar); fresh(F, args);
            attn_naive(F, args, 0, true, true, true, WS_MIX);
            xcd_barrier(bar); fresh(F, args);
            { const bf16_t* A = WSP(bf16_t, WS_BR); const bf16_t* B = WSP(bf16_t, WS_MIX); unsigned* res = (unsigned*)(F.ctl + 32768);
              for (int row = F.gw; row < S; row += F.NGW) { float mx[3] = {0.f, 0.f, 0.f};
#pragma unroll
                  for (int br = 0; br < 3; ++br) { for (int c = F.lane; c < 1024; c += 64) { const float d = fabsf(bf1(A[(size_t)row * 3072 + br * 1024 + c]) - bf1(B[(size_t)row * 3072 + br * 1024 + c])); mx[br] = fmaxf(mx[br], d); }
                      mx[br] = wave_max(mx[br]); }
                  if (F.lane == 0) { for (int br = 0; br < 3; ++br) { atomicMax(res + 64 * br, __builtin_bit_cast(unsigned, mx[br]));
                      if (mx[br] > DIAG_THR) { atomicAdd(res + 64 * (3 + br), 1u); atomicMax(res + 64 * (6 + br), 0x7fffffffu - (unsigned)row); atomicMax(res + 64 * (9 + br), (unsigned)row); } } } } }
            xcd_barrier(bar); fresh(F, args);
            { const unsigned* res = (const unsigned*)(F.ctl + 32768);
              float v[12]; for (int i = 0; i < 3; ++i) v[i] = __builtin_bit_cast(float, __hip_atomic_load(res + 64 * i, __ATOMIC_RELAXED, __HIP_MEMORY_SCOPE_AGENT));
              for (int i = 3; i < 6; ++i) v[i] = (float)__hip_atomic_load(res + 64 * i, __ATOMIC_RELAXED, __HIP_MEMORY_SCOPE_AGENT);
              for (int i = 6; i < 9; ++i) v[i] = (float)(0x7fffffffu - __hip_atomic_load(res + 64 * i, __ATOMIC_RELAXED, __HIP_MEMORY_SCOPE_AGENT));
              for (int i = 9; i < 12; ++i) v[i] = (float)__hip_atomic_load(res + 64 * i, __ATOMIC_RELAXED, __HIP_MEMORY_SCOPE_AGENT);
              const float Aval = DIAG_A, Bval = DIAG_B;
              for (size_t i = (size_t)F.bid * NTHREADS + F.tid; i < (size_t)S * D; i += (size_t)F.G * NTHREADS) F.out[i] = (i == 0) ? Aval : Bval; }
            return;
        }
#endif
        if (IN(pb + 4)) REPLOOP(4) { fresh(F, args);
            pg8::Gemm g{WSP(bf16_t, WS_BR), WLP(bf16_t, l, WL_BR), 1024, 3072, 1024, 1024, (size_t)D * 1024}; pg8::SliceOrder<3> So; So.init(S, D, F.G, F.bid);
            pg8::EpiMix E{Z + ZC_MG, WSP(float, WS_MIX), WSP(bf16_t, WS_MIXB)};
            pg8::gemm_phase<pg8::EpiMix, pg8::SliceOrder<3>, true>(F.lds, g, So, E, F.tid);
        }
        SEAM(pb + 4);
        if (IN(pb + 5)) REPLOOP(5) { fresh(F, args);
            pg8::Gemm g{WSP(bf16_t, WS_MIXB), WLP(bf16_t, l, WL_OUT), D, D, D, 0, 0}; pg8::PlainOrder So; So.init(S, D, F.G, F.bid);
            pg8::EpiRes E{l == 0 ? args.in[IN_X] : X, MODL + 2 * D, Y};
            pg8::gemm_phase<pg8::EpiRes, pg8::PlainOrder, false>(F.lds, g, So, E, F.tid);
        }
        SEAM(pb + 5);
        if (IN(pb + 6)) REPLOOP(6) { fresh(F, args); ln_rows(F, Y, true, args.in[IN_LN1G] + (size_t)l * D, args.in[IN_LN1B] + (size_t)l * D, X, true, MODL + 3 * D, MODL + 4 * D, H, nullptr); }
        SEAM(pb + 6);
        if (IN(pb + 7)) REPLOOP(7) { fresh(F, args);
            pg8::Gemm g{H, WLP(bf16_t, l, WL_FF1), D, D, D, 0, 0}; pg8::PlainOrder So; So.init(S, FF, F.G, F.bid);
            pg8::EpiRelu2 E{Z  , FF};
            pg8::gemm_phase<pg8::EpiRelu2, pg8::PlainOrder, true>(F.lds, g, So, E, F.tid);
        }
        SEAM(pb + 7);
        if (IN(pb + 8)) REPLOOP(8) { fresh(F, args);
            pg8::Gemm g{Z, WLP(bf16_t, l, WL_FF2), FF, FF, FF, 0, 0}; pg8::PlainOrder So; So.init(S, D, F.G, F.bid);
            pg8::EpiRes E{X, MODL + 5 * D, Y};
            pg8::gemm_phase<pg8::EpiRes, pg8::PlainOrder, false>(F.lds, g, So, E, F.tid);
        }
        SEAM(pb + 8);
    }
    if (IN(NPHASE - 1)) { fresh(F, args); ln_rows(F, Y, true, args.in[IN_LN2G] + (size_t)(NL - 1) * D, args.in[IN_LN2B] + (size_t)(NL - 1) * D, F.out, false, nullptr, nullptr, nullptr, nullptr); }

#ifdef PROF
    STAMP(NPHASE);
    xcd_barrier(bar); fresh(F, args);
    {
#define TLD(i) __hip_atomic_load(TSP + (i), __ATOMIC_RELAXED, __HIP_MEMORY_SCOPE_AGENT)
#define TS(k) ((float)((TLD(2 + (k)) - TLD(1 + (k))) + (TLD(11 + (k)) - TLD(10 + (k))) + (TLD(20 + (k)) - TLD(19 + (k))) + (TLD(29 + (k)) - TLD(28 + (k)))) * 0.01f)
#define TPRO ((float)(TLD(1) - TLD(0)) * 0.01f)
#define TFIN ((float)(TLD(NPHASE) - TLD(NPHASE - 1)) * 0.01f)
#define TALL ((float)(TLD(NPHASE) - TLD(0)) * 0.01f)
      const float Bval = PROF_B, Aval = PROF_A + Bval + 100.f;
      for (size_t i = (size_t)F.bid * NTHREADS + F.tid; i < (size_t)S * D; i += (size_t)F.G * NTHREADS) F.out[i] = (i == 0) ? Aval : Bval; }
#endif
#undef IN
#undef SEAM
#undef Z
#undef H
#undef X
#undef Y
#undef SSQ
#undef MODL
}

extern "C" void kernel_launch(void* const* d_in, const int* in_sizes, int n_in, void* d_out, int out_size, void* d_ws, size_t ws_size, hipStream_t stream) {
    static int grid = 0;
    if (grid == 0) {
        if (n_in != 23 || in_sizes[0] != S * D || out_size != S * D || ws_size < WS_END) {
            fprintf(stderr, "kernel_launch: shape mismatch: n_in %d in0 %d out %d ws %zu (need %zu)\n", n_in, n_in > 0 ? in_sizes[0] : -1, out_size, ws_size, (size_t)WS_END); grid = -1; return; }
        int dev = 0, cus = 0, per_cu = 0;
        if (hipGetDevice(&dev) != hipSuccess || hipDeviceGetAttribute(&cus, hipDeviceAttributeMultiprocessorCount, dev) != hipSuccess) { fprintf(stderr, "kernel_launch: device query failed\n"); grid = -1; return; }
        if (hipFuncSetAttribute((const void*)fwd, hipFuncAttributeMaxDynamicSharedMemorySize, LDS_BYTES) != hipSuccess) { fprintf(stderr, "kernel_launch: hipFuncSetAttribute failed\n"); grid = -1; return; }
        if (hipOccupancyMaxActiveBlocksPerMultiprocessor(&per_cu, (const void*)fwd, NTHREADS, LDS_BYTES) != hipSuccess || per_cu < 1) { fprintf(stderr, "kernel_launch: occupancy query says %d\n", per_cu); }
        (void)hipGetLastError();
        grid = cus;
    }
    if (grid < 0) return;
    if (hipMemsetAsync((char*)d_ws + WS_CTL, 0, CTL_ZERO_BYTES, stream) != hipSuccess) { fprintf(stderr, "kernel_launch: memset failed\n"); return; }
    Args a{};
    for (int i = 0; i < 23; ++i) a.in[i] = (const float*)d_in[i];
    a.out = (float*)d_out; a.ws = (unsigned char*)d_ws;
#if MK_N_LAUNCHES == 1
    a.ph_lo = 0; a.ph_hi = NPHASE;
    hipLaunchKernelGGL(fwd, dim3(grid), dim3(NTHREADS), LDS_BYTES, stream, a);
#else
#ifndef HOST_REP_MASK
#define HOST_REP_MASK 0
#endif
    for (int p = 0; p < NPHASE; ++p) {
        const int type = (p == 0) ? 9 : (p == NPHASE - 1) ? 10 : (p - 1) % 9;
        const int reps = 1 + ((HOST_REP_MASK >> type) & 1);
        for (int r = 0; r < reps; ++r) {
            if (r > 0 && type == 1) { a.ph_lo = p - 1; a.ph_hi = p; hipLaunchKernelGGL(fwd, dim3(grid), dim3(NTHREADS), LDS_BYTES, stream, a); }
            a.ph_lo = p; a.ph_hi = p + 1; hipLaunchKernelGGL(fwd, dim3(grid), dim3(NTHREADS), LDS_BYTES, stream, a); }
    }
#endif
    const hipError_t le = hipPeekAtLastError();
    if (le != hipSuccess) fprintf(stderr, "kernel_launch: launch failed: %s\n", hipGetErrorName(le));
}
```

```cpp
#include <hip/hip_runtime.h>
#include <cstdio>
#include <cstdint>

#define LAS __attribute__((address_space(3)))
#define GAS __attribute__((address_space(1)))
typedef unsigned short bf16_t;
typedef short bf16x8 __attribute__((ext_vector_type(8)));
typedef short s16x4 __attribute__((ext_vector_type(4)));
typedef float f32x4 __attribute__((ext_vector_type(4)));
typedef float f32x2 __attribute__((ext_vector_type(2)));
typedef float f32x16 __attribute__((ext_vector_type(16)));
typedef unsigned u32x4 __attribute__((ext_vector_type(4)));
typedef unsigned u32x2 __attribute__((ext_vector_type(2)));
typedef GAS unsigned gu32;

constexpr int S = 8192, D = 2048, NL = 4, FF = 8192;
constexpr int LDZ = 12800;
constexpr int ZC_CQ = 0, ZC_CKV = 512, ZC_DQ = 768, ZC_DK = 1792, ZC_DV = 2816, ZC_NQ = 3840, ZC_NKV = 4864, ZC_MG = 6400, ZC_KR = 12544, ZC_NG = 12608;
constexpr int DIN_SRC = 12632;
constexpr float ALPHA_RES = 1.6817928305074292f;
constexpr int NWAVES = 8, NTHREADS = 512;

__host__ __device__ __forceinline__ int zsrc(int n) {
    if (n < 768) return n;
    if (n < 6400) return n + 64;
    if (n < 12544) return n + 88;
    if (n < 12608) return n - 12544 + 768;
    if (n < 12632) return n - 12608 + 6464;
    return -1;
}

constexpr size_t MiB = 1u << 20;
constexpr size_t WS_CTL = 0, CTL_ZERO_BYTES = 1 * MiB;
constexpr size_t WS_MOD = 1 * MiB;
constexpr size_t WS_ROPE = 2 * MiB;
constexpr size_t WS_SSQ = 4 * MiB;
constexpr size_t WS_TPOS = 4 * MiB + 128 * 1024;
constexpr size_t WS_KCMP = 5 * MiB;
constexpr size_t WS_KROPE = 6 * MiB;
constexpr size_t WS_X = 8 * MiB;
constexpr size_t WS_Y = 72 * MiB;
constexpr size_t WS_MIX = 136 * MiB;
constexpr size_t WS_H = 200 * MiB;
constexpr size_t WS_MIXB = 232 * MiB;
constexpr size_t WS_QM = 264 * MiB;
constexpr size_t WS_KVM = 288 * MiB;
constexpr size_t WS_BR = 320 * MiB;
constexpr size_t WS_Z = 368 * MiB;
constexpr size_t WS_W = 568 * MiB;
constexpr size_t WL_STRIDE = 140 * MiB;
constexpr size_t WL_IN = 0, WL_FF1 = 50 * MiB, WL_FF2 = 82 * MiB, WL_BR = 114 * MiB, WL_OUT = 126 * MiB, WL_UQ = 134 * MiB, WL_UKV = 136 * MiB, WL_C1 = 137 * MiB, WL_C2 = 139 * MiB;
constexpr size_t WS_END = WS_W + NL * WL_STRIDE;

constexpr int CW_BAR = 4096;
constexpr int CW_NRM = 24576;
constexpr int CW_QUEUE = 16384;

constexpr int RING_BYTES = 131072;
constexpr int MISC_OFF = RING_BYTES;
constexpr int LDS_BYTES = RING_BYTES + 1024;

#define RLX_AGENT __ATOMIC_RELAXED, __HIP_MEMORY_SCOPE_AGENT
#define LDS_WAIT() asm volatile("s_waitcnt lgkmcnt(0)" ::: "memory")
#define VM_WAIT() asm volatile("s_waitcnt vmcnt(0)" ::: "memory")
__device__ __forceinline__ unsigned f2bf(float f) { unsigned u = __builtin_bit_cast(unsigned, f); return (u + 0x7fffu + ((u >> 16) & 1u)) >> 16; }
__device__ __forceinline__ unsigned pk2(float lo, float hi) { return f2bf(lo) | (f2bf(hi) << 16); }
__device__ __forceinline__ float bflo(unsigned w) { return __builtin_bit_cast(float, w << 16); }
__device__ __forceinline__ float bfhi(unsigned w) { return __builtin_bit_cast(float, w & 0xffff0000u); }
__device__ __forceinline__ float bf1(bf16_t h) { return __builtin_bit_cast(float, ((unsigned)h) << 16); }
__device__ __forceinline__ float wave_sum(float v) {
#pragma unroll
    for (int o = 1; o < 64; o <<= 1) v += __shfl_xor(v, o);
    return v;
}
__device__ __forceinline__ float wave_max(float v) {
#pragma unroll
    for (int o = 1; o < 64; o <<= 1) v = fmaxf(v, __shfl_xor(v, o));
    return v;
}
__device__ __forceinline__ float sigmoidf_(float x) { return 1.f / (1.f + __expf(-x)); }
#define MK_N_LAUNCHES 1
namespace pg8 {
#define PG8_LAS __attribute__((address_space(3)))
constexpr int BM = 256, BK = 64, HALF = 128, HTB = HALF * BK * 2  , STAGE_BYTES = 8 * HTB, NXCD = 8, WGM = 8;

__host__ __device__ __forceinline__ int lds_byte(int r, int c) { const int st = (r >> 4) * 2 + (c >> 5), rr = r & 15, cc = c & 31, ob = rr * 64 + cc * 2; return st * 1024 + (ob ^ (((ob >> 9) & 1) << 5)); }
__host__ __device__ __forceinline__ void stage_rc(int b, int& R, int& C) { const int st = b / 1024, sb = b % 1024, swz = sb ^ (((sb >> 9) & 1) << 5); R = (st >> 1) * 16 + swz / 64; C = (st & 1) * 32 + (swz % 64) / 2; }
__host__ __device__ __forceinline__ int perm32(int rho) { const int n = rho >> 4, i = rho & 15; return 8 * (i >> 2) + 4 * n + (i & 3); }

struct Unit { int pm, pn, z; };
struct Gemm { const bf16_t* A; const bf16_t* Bt; int K, lda, ldb; size_t az, bz; };

__host__ __device__ __forceinline__ void tile_of(int wgid, int nM, int nN, int& pm, int& pn) {
    const int nwg = nM * nN;
    { const int q = nwg / NXCD, r = nwg % NXCD, xcd = wgid % NXCD, off = wgid / NXCD; wgid = (xcd < r ? xcd * (q + 1) : r * (q + 1) + (xcd - r) * q) + off; }
    const int nig = WGM * nN, gid = wgid / nig, fm = gid * WGM, gsz = (nM - fm) < WGM ? (nM - fm) : WGM;
    pm = fm + ((wgid % nig) % gsz); pn = (wgid % nig) / gsz;
}
struct PlainOrder {
    int nM, nN, nwg, G, c;
    __host__ __device__ void init(int M, int N, int G_, int c_) { nM = M / BM; nN = N / BM; nwg = nM * nN; G = G_; c = c_; }
    __host__ __device__ bool next(int i, Unit& u) const {
        const long L = (long)i * G + c; if (L >= nwg) return false;
        tile_of((int)L, nM, nN, u.pm, u.pn); u.z = 0; return true;
    }
    __device__ __forceinline__ void a_ready(const Unit&) const {}
    __device__ __forceinline__ void done(const Unit&) const {}
};
template <int NZ> struct SliceOrder {
    int nM, nN, nwg, G, c;
    __host__ __device__ void init(int M, int N, int G_, int c_) { nM = M / BM; nN = N / BM; nwg = nM * nN; G = G_; c = c_; }
    __host__ __device__ bool next(int i, Unit& u) const {
        const long L = (long)(i / NZ) * G + c; if (L >= nwg) return false;
        tile_of((int)L, nM, nN, u.pm, u.pn); u.z = i % NZ; return true;
    }
    __device__ __forceinline__ void a_ready(const Unit&) const {}
    __device__ __forceinline__ void done(const Unit&) const {}
};

__device__ __forceinline__ float fsig(float x) { return __builtin_amdgcn_rcpf(1.f + __builtin_amdgcn_exp2f(-1.4426950408889634f * x)); }
__device__ __forceinline__ unsigned cvt_pk_bf16(float lo, float hi) { unsigned r; asm volatile("v_cvt_pk_bf16_f32 %0, %1, %2" : "=v"(r) : "v"(lo), "v"(hi)); return r; }


struct EpiZ {
    static constexpr bool PERM = true, AFTER_DRAIN = false;
    bf16_t* Z; float* ssq;
    __device__ __forceinline__ void operator()(const f32x4 (&acc)[2][2][4][2], const Unit& u, int wr, int wc, int fr, int fq) const {
        const int row0 = u.pm * BM + wr * 64 + fr, col0 = u.pn * BM + wc * 32 + 8 * fq;
#pragma unroll
        for (int ai = 0; ai < 2; ++ai)
#pragma unroll
            for (int m = 0; m < 4; ++m) { const int row = row0 + ai * HALF + m * 16; bf16_t* rowp = Z + (size_t)row * LDZ + col0; float ss = 0.f;
#pragma unroll
                for (int bj = 0; bj < 2; ++bj) { const f32x4 v0 = acc[ai][bj][m][0], v1 = acc[ai][bj][m][1];
                    ss += (v0[0] * v0[0] + v0[1] * v0[1]) + (v0[2] * v0[2] + v0[3] * v0[3]) + (v1[0] * v1[0] + v1[1] * v1[1]) + (v1[2] * v1[2] + v1[3] * v1[3]);
                    u32x4 w; w.x = cvt_pk_bf16(v0[0], v0[1]); w.y = cvt_pk_bf16(v0[2], v0[3]); w.z = cvt_pk_bf16(v1[0], v1[1]); w.w = cvt_pk_bf16(v1[2], v1[3]);
                    *(u32x4*)(rowp + bj * HALF) = w; }
                if (ssq && u.pn < 3) { ss += __shfl_xor(ss, 16); ss += __shfl_xor(ss, 32);
                    if (fq == 0) __hip_atomic_fetch_add(ssq + (size_t)row * 2 + (u.pn == 2 ? 1 : 0), ss, __ATOMIC_RELAXED, __HIP_MEMORY_SCOPE_AGENT); } }
    }
};
struct EpiRs {
    static constexpr bool PERM = true, AFTER_DRAIN = false;
    bf16_t* O; int ldc; const float* ssq; int which; float invK;
    __device__ __forceinline__ void operator()(const f32x4 (&acc)[2][2][4][2], const Unit& u, int wr, int wc, int fr, int fq) const {
        const int row0 = u.pm * BM + wr * 64 + fr, col0 = u.pn * BM + wc * 32 + 8 * fq;
#pragma unroll
        for (int ai = 0; ai < 2; ++ai)
#pragma unroll
            for (int m = 0; m < 4; ++m) { const int row = row0 + ai * HALF + m * 16; bf16_t* rowp = O + (size_t)row * ldc + col0;
                const float rs = 1.0f / sqrtf(ssq[(size_t)row * 2 + which] * invK + 1e-6f);
#pragma unroll
                for (int bj = 0; bj < 2; ++bj) { const f32x4 v0 = acc[ai][bj][m][0] * rs, v1 = acc[ai][bj][m][1] * rs;
                    u32x4 w; w.x = cvt_pk_bf16(v0[0], v0[1]); w.y = cvt_pk_bf16(v0[2], v0[3]); w.z = cvt_pk_bf16(v1[0], v1[1]); w.w = cvt_pk_bf16(v1[2], v1[3]);
                    *(u32x4*)(rowp + bj * HALF) = w; } }
    }
};
struct EpiRelu2 {
    static constexpr bool PERM = true, AFTER_DRAIN = false;
    bf16_t* O; int ldc;
    __device__ __forceinline__ void operator()(const f32x4 (&acc)[2][2][4][2], const Unit& u, int wr, int wc, int fr, int fq) const {
        const int row0 = u.pm * BM + wr * 64 + fr, col0 = u.pn * BM + wc * 32 + 8 * fq;
#pragma unroll
        for (int ai = 0; ai < 2; ++ai)
#pragma unroll
            for (int m = 0; m < 4; ++m) { bf16_t* rowp = O + (size_t)(row0 + ai * HALF + m * 16) * ldc + col0;
#pragma unroll
                for (int bj = 0; bj < 2; ++bj) { f32x4 v0 = acc[ai][bj][m][0], v1 = acc[ai][bj][m][1];
#pragma unroll
                    for (int j = 0; j < 4; ++j) { const float a = fmaxf(v0[j], 0.f), b = fmaxf(v1[j], 0.f); v0[j] = a * a; v1[j] = b * b; }
                    u32x4 w; w.x = cvt_pk_bf16(v0[0], v0[1]); w.y = cvt_pk_bf16(v0[2], v0[3]); w.z = cvt_pk_bf16(v1[0], v1[1]); w.w = cvt_pk_bf16(v1[2], v1[3]);
                    *(u32x4*)(rowp + bj * HALF) = w; } }
    }
};
struct EpiMix {
    static constexpr bool PERM = true, AFTER_DRAIN = false;
    const bf16_t* Zg; bf16_t* MIXB;
    __device__ __forceinline__ void operator()(const f32x4 (&acc)[2][2][4][2], const Unit& u, int wr, int wc, int fr, int fq) const {
        const int row0 = u.pm * BM + wr * 64 + fr, col0 = u.pn * BM + wc * 32 + 8 * fq;
#pragma unroll
        for (int ai = 0; ai < 2; ++ai) {
            u32x4 gw[4][2], mw[4][2];
#pragma unroll
            for (int m = 0; m < 4; ++m)
#pragma unroll
                for (int bj = 0; bj < 2; ++bj) { const int row = row0 + ai * HALF + m * 16, col = col0 + bj * HALF;
                    gw[m][bj] = *(const u32x4*)(Zg + (size_t)row * LDZ + u.z * D + col);
                    if (u.z > 0) { const unsigned long long* mp = (const unsigned long long*)(MIXB + (size_t)row * D + col);
                        const unsigned long long a = __hip_atomic_load(mp, __ATOMIC_RELAXED, __HIP_MEMORY_SCOPE_AGENT), b = __hip_atomic_load(mp + 1, __ATOMIC_RELAXED, __HIP_MEMORY_SCOPE_AGENT);
                        mw[m][bj] = (u32x4){(unsigned)a, (unsigned)(a >> 32), (unsigned)b, (unsigned)(b >> 32)}; }
                    else mw[m][bj] = (u32x4){0u, 0u, 0u, 0u}; }
#pragma unroll
            for (int m = 0; m < 4; ++m)
#pragma unroll
                for (int bj = 0; bj < 2; ++bj) { const int row = row0 + ai * HALF + m * 16, col = col0 + bj * HALF; const u32x4 g = gw[m][bj], o = mw[m][bj];
                    f32x4 v0 = acc[ai][bj][m][0], v1 = acc[ai][bj][m][1];
                    v0[0] = v0[0] * fsig(bflo(g.x)) + bflo(o.x); v0[1] = v0[1] * fsig(bfhi(g.x)) + bfhi(o.x); v0[2] = v0[2] * fsig(bflo(g.y)) + bflo(o.y); v0[3] = v0[3] * fsig(bfhi(g.y)) + bfhi(o.y);
                    v1[0] = v1[0] * fsig(bflo(g.z)) + bflo(o.z); v1[1] = v1[1] * fsig(bfhi(g.z)) + bfhi(o.z); v1[2] = v1[2] * fsig(bflo(g.w)) + bflo(o.w); v1[3] = v1[3] * fsig(bfhi(g.w)) + bfhi(o.w);
                    u32x4 w; w.x = cvt_pk_bf16(v0[0], v0[1]); w.y = cvt_pk_bf16(v0[2], v0[3]); w.z = cvt_pk_bf16(v1[0], v1[1]); w.w = cvt_pk_bf16(v1[2], v1[3]);
                    *(u32x4*)(MIXB + (size_t)row * D + col) = w; }
        }
    }
};
struct EpiRes {
    static constexpr bool PERM = false, AFTER_DRAIN = false;
    const float* X; const float* gvec; float* Y;
    __device__ __forceinline__ void operator()(const f32x4 (&acc)[2][2][4][2], const Unit& u, int wr, int wc, int fr, int fq) const {
        const int row0 = u.pm * BM + wr * 64 + fr, col0 = u.pn * BM + wc * 32 + 4 * fq;
        f32x4 gv[2][2];
#pragma unroll
        for (int bj = 0; bj < 2; ++bj)
#pragma unroll
            for (int n = 0; n < 2; ++n) gv[bj][n] = *(const f32x4*)(gvec + col0 + bj * HALF + n * 16);
#pragma unroll
        for (int ai = 0; ai < 2; ++ai)
#pragma unroll
            for (int m = 0; m < 4; ++m) { const size_t ro = (size_t)(row0 + ai * HALF + m * 16) * D + col0;
#pragma unroll
                for (int bj = 0; bj < 2; ++bj)
#pragma unroll
                    for (int n = 0; n < 2; ++n) { const f32x4 xv = *(const f32x4*)(X + ro + bj * HALF + n * 16);
                        *(f32x4*)(Y + ro + bj * HALF + n * 16) = xv * ALPHA_RES + gv[bj][n] * acc[ai][bj][m][n]; } }
    }
};

template <class Epi, class Sched, bool ALIGN_EPI = false>
__device__ __forceinline__ void gemm_phase(PG8_LAS unsigned char* lds, const Gemm g, const Sched& S, const Epi& E, const int tid) {
    const int wid = __builtin_amdgcn_readfirstlane(tid >> 6), lane = tid & 63, wr = wid >> 2, wc = wid & 3, fr = lane & 15, fq = lane >> 4;
    const int K = g.K, nt = K / BK;
    unsigned voffA[2], voffB[2];
#pragma unroll
    for (int i = 0; i < 2; ++i) { int R, C; stage_rc(tid * 16 + i * 8192, R, C); const int Rb = Epi::PERM ? ((R & ~31) + perm32(R & 31)) : R;
        voffA[i] = (unsigned)(R * g.lda + C) * 2u; voffB[i] = (unsigned)(Rb * g.ldb + C) * 2u; }
    const size_t kstep = (size_t)(BK * 2);
    const size_t hstepA = (size_t)HALF * g.lda * 2, hstepB = (size_t)HALF * g.ldb * 2;
    const size_t tstepA = 2 * hstepA, tstepB = 2 * hstepB;
    const unsigned ldsw = (unsigned)wid * 1024u;
    const int aoff = lds_byte(wr * 64 + fr, fq * 8), boff = lds_byte(wc * 32 + fr, fq * 8);
#define PG8_SA(b, h) (((b) * 2 + (h)) * HTB)
#define PG8_SB(b, h) ((4 + (b) * 2 + (h)) * HTB)
#define PG8_STAGE(bufoff, gbase, voff) do { _Pragma("unroll") for (int _i = 0; _i < 2; ++_i) \
        __builtin_amdgcn_global_load_lds((const unsigned*)((const char*)(gbase) + (voff)[_i]), (PG8_LAS unsigned*)(lds + (bufoff) + ldsw + _i * 8192), 16, 0, 0); } while (0)
#define PG8_LDA(dst, b, h) do { _Pragma("unroll") for (int m = 0; m < 4; ++m) _Pragma("unroll") for (int k = 0; k < 2; ++k) dst[m][k] = *(const PG8_LAS bf16x8*)(lds + PG8_SA(b, h) + aoff + m * 2048 + k * 1024); } while (0)
#define PG8_LDB(dst, b, h) do { _Pragma("unroll") for (int n = 0; n < 2; ++n) _Pragma("unroll") for (int k = 0; k < 2; ++k) dst[n][k] = *(const PG8_LAS bf16x8*)(lds + PG8_SB(b, h) + boff + n * 2048 + k * 1024); } while (0)
#define PG8_MMA(ai, bj, At, Bt) do { __builtin_amdgcn_s_setprio(1); _Pragma("unroll") for (int m = 0; m < 4; ++m) _Pragma("unroll") for (int n = 0; n < 2; ++n) _Pragma("unroll") for (int k = 0; k < 2; ++k) \
        acc[ai][bj][m][n] = __builtin_amdgcn_mfma_f32_16x16x32_bf16(Bt[n][k], At[m][k], acc[ai][bj][m][n], 0, 0, 0); __builtin_amdgcn_s_setprio(0); } while (0)
#define PG8_WAIT_V(n) asm volatile("s_waitcnt vmcnt(" #n ")" ::: "memory")
#define PG8_WAIT_L(n) asm volatile("s_waitcnt lgkmcnt(" #n ")" ::: "memory")
#define PG8_BAR __builtin_amdgcn_s_barrier()
#define PG8_SCHED __builtin_amdgcn_sched_barrier(0)
    Unit cur, nxt; int ui = 0;
    if (!S.next(0, cur)) return;
    f32x4 acc[2][2][4][2];
#pragma unroll
    for (int a = 0; a < 2; ++a)
#pragma unroll
        for (int b = 0; b < 2; ++b)
#pragma unroll
            for (int m = 0; m < 4; ++m)
#pragma unroll
                for (int n = 0; n < 2; ++n) acc[a][b][m][n] = (f32x4){0.f, 0.f, 0.f, 0.f};
    bf16x8 At[4][2], B0[2][2], B1[2][2];
    const char* cA = (const char*)(g.A + (size_t)cur.z * g.az) + (size_t)cur.pm * tstepA; const char* cB = (const char*)(g.Bt + (size_t)cur.z * g.bz) + (size_t)cur.pn * tstepB;
    S.a_ready(cur);
    PG8_STAGE(PG8_SB(0, 0), cB, voffB); PG8_STAGE(PG8_SB(0, 1), cB + hstepB, voffB); PG8_STAGE(PG8_SA(0, 0), cA, voffA); PG8_STAGE(PG8_SA(0, 1), cA + hstepA, voffA);
    if (wr == 1) PG8_BAR;
    PG8_WAIT_V(2); PG8_BAR;
    PG8_STAGE(PG8_SB(1, 0), cB + kstep, voffB); PG8_STAGE(PG8_SA(1, 0), cA + kstep, voffA); PG8_STAGE(PG8_SB(1, 1), cB + hstepB + kstep, voffB);
    PG8_WAIT_V(6); PG8_BAR;
    for (;;) {
        const bool has_next = S.next(ui + 1, nxt);
        const char* nA = has_next ? (const char*)(g.A + (size_t)nxt.z * g.az) + (size_t)nxt.pm * tstepA : cA; const char* nB = has_next ? (const char*)(g.Bt + (size_t)nxt.z * g.bz) + (size_t)nxt.pn * tstepB : cB;
        for (int t = 0; t < nt; t += 2) {
            const bool last = (t == nt - 2);
            const char* a1 = cA + (size_t)(t + 1) * kstep;
            const char* a2 = last ? nA : cA + (size_t)(t + 2) * kstep; const char* b2 = last ? nB : cB + (size_t)(t + 2) * kstep;
            const char* a3 = a2 + kstep; const char* b3 = b2 + kstep;
            if (last && has_next) S.a_ready(nxt);
            PG8_LDB(B0, 0, 0); PG8_LDB(B1, 0, 1); PG8_SCHED; PG8_LDA(At, 0, 0); PG8_STAGE(PG8_SA(1, 1), a1 + hstepA, voffA);
            PG8_WAIT_V(8); PG8_WAIT_L(0); PG8_BAR; PG8_MMA(0, 0, At, B0); PG8_MMA(0, 1, At, B1); PG8_BAR; PG8_SCHED;
            PG8_LDA(At, 0, 1); PG8_STAGE(PG8_SB(0, 0), b2, voffB); PG8_STAGE(PG8_SB(0, 1), b2 + hstepB, voffB); PG8_STAGE(PG8_SA(0, 0), a2, voffA);
            PG8_WAIT_V(8); PG8_WAIT_L(0); PG8_BAR; PG8_MMA(1, 0, At, B0); PG8_MMA(1, 1, At, B1); PG8_BAR; PG8_SCHED;
            PG8_LDB(B0, 1, 0); PG8_LDB(B1, 1, 1); PG8_SCHED; PG8_LDA(At, 1, 0); PG8_STAGE(PG8_SA(0, 1), a2 + hstepA, voffA);
            PG8_WAIT_V(8); PG8_WAIT_L(0); PG8_BAR; PG8_MMA(0, 0, At, B0); PG8_MMA(0, 1, At, B1); PG8_BAR; PG8_SCHED;
            PG8_LDA(At, 1, 1); PG8_STAGE(PG8_SB(1, 0), b3, voffB); PG8_STAGE(PG8_SB(1, 1), b3 + hstepB, voffB); PG8_STAGE(PG8_SA(1, 0), a3, voffA);
            PG8_WAIT_V(8); PG8_WAIT_L(0); PG8_BAR; PG8_MMA(1, 0, At, B0); PG8_MMA(1, 1, At, B1); PG8_BAR; PG8_SCHED;
        }
        if constexpr (ALIGN_EPI) { if (wr == 0) PG8_BAR; }
        E(acc, cur, wr, wc, fr, fq); S.done(cur);
        if (!has_next) break;
#pragma unroll
        for (int a = 0; a < 2; ++a)
#pragma unroll
            for (int b = 0; b < 2; ++b)
#pragma unroll
                for (int m = 0; m < 4; ++m)
#pragma unroll
                    for (int n = 0; n < 2; ++n) acc[a][b][m][n] = (f32x4){0.f, 0.f, 0.f, 0.f};
        cur = nxt; cA = nA; cB = nB; ++ui;
        if constexpr (ALIGN_EPI) { if (wr == 1) PG8_BAR; }
    }
    PG8_WAIT_V(0);
    if constexpr (!ALIGN_EPI) { if (wr == 0) PG8_BAR; }
    PG8_BAR;
#undef PG8_SA
#undef PG8_SB
#undef PG8_STAGE
#undef PG8_LDA
#undef PG8_LDB
#undef PG8_MMA
#undef PG8_WAIT_V
#undef PG8_WAIT_L
#undef PG8_BAR
#undef PG8_SCHED
}
}
#define XB_TMO      128
#define XB_XCNT(j)  (256  + 64 * (j))
#define XB_XSUB(j)  (1280 + 64 * (j))
#define XB_XGEN(j)  (2304 + 64 * (j))
#define XB_TOP      3328
#define XB_TOPGEN   3392
#define XCD_BAR_WORDS 3456
#define XB_SPIN_CAP (1u << 22)

__device__ __forceinline__ unsigned xb_ld(unsigned* p)              { return __hip_atomic_load(p, __ATOMIC_RELAXED, __HIP_MEMORY_SCOPE_AGENT); }
__device__ __forceinline__ unsigned xb_add(unsigned* p, unsigned v) { return __hip_atomic_fetch_add(p, v, __ATOMIC_RELAXED, __HIP_MEMORY_SCOPE_AGENT); }
__device__ __forceinline__ unsigned xb_xcc_id() { return (unsigned)__builtin_amdgcn_s_getreg((3 << 11) | 20) & 0xFu; }
#define XB_SPIN(cond, bar) do { unsigned _sp = 0; while (cond) { __builtin_amdgcn_s_sleep(1); \
    if ((++_sp & 255u) == 0u) { if (xb_ld(&(bar)[XB_TMO])) break; if (_sp > XB_SPIN_CAP) { atomicAdd(&(bar)[XB_TMO], 1u); break; } } } } while (0)

struct XcdBarrier {
    unsigned* bar; unsigned x;
    volatile LAS unsigned* st;
};

__device__ __forceinline__ XcdBarrier xcd_barrier_post(unsigned* bar, volatile LAS unsigned* st) {
    XcdBarrier b; b.bar = bar; b.x = xb_xcc_id(); b.st = st;
    if (threadIdx.x == 0) (void)xb_add(&bar[XB_XCNT(b.x)], 1u);
    return b;
}
__device__ __forceinline__ void xcd_barrier_complete(unsigned* bar, unsigned x, unsigned& nloc, unsigned& nx) {
    const unsigned G = gridDim.x * gridDim.y * gridDim.z;
    unsigned sum, cnt, mine, sp = 0u;
    for (;;) {
        sum = 0u; cnt = 0u; mine = 0u;
#pragma unroll
        for (unsigned j = 0; j < 16; ++j) { const unsigned c = xb_ld(&bar[XB_XCNT(j)]); sum += c; cnt += (c > 0u) ? 1u : 0u; mine = (j == x) ? c : mine; }
        if (sum == G) break;
        __builtin_amdgcn_s_sleep(1);
        if ((++sp & 255u) == 0u) { if (xb_ld(&bar[XB_TMO])) break; if (sp > XB_SPIN_CAP) { atomicAdd(&bar[XB_TMO], 1u); break; } }
    }
    nloc = mine > 0u ? mine : 1u; nx = cnt > 0u ? cnt : 1u;
}

__device__ __forceinline__ void xcd_barrier(const XcdBarrier& b) {
    asm volatile("s_waitcnt vmcnt(0)" ::: "memory");
    __syncthreads();
    if (threadIdx.x == 0) {
        unsigned* bar = b.bar;
        __builtin_amdgcn_s_waitcnt(0);
        unsigned nloc = b.st[0], nx = b.st[1];
        if (nloc == 0u) { xcd_barrier_complete(bar, b.x, nloc, nx); b.st[0] = nloc; b.st[1] = nx; }
        const unsigned old = xb_add(&bar[XB_XSUB(b.x)], 1u);
        const unsigned gen = old / nloc;
        if (old + 1u == (gen + 1u) * nloc) {
            __builtin_amdgcn_fence(__ATOMIC_RELEASE, "agent");
            asm volatile("s_waitcnt vmcnt(0)" ::: "memory");
            const unsigned og = xb_add(&bar[XB_TOP], 1u);
            const unsigned tg = og / nx;
            if (og + 1u == (tg + 1u) * nx) xb_add(&bar[XB_TOPGEN], 1u);
            else XB_SPIN(xb_ld(&bar[XB_TOPGEN]) == tg, bar);
            __builtin_amdgcn_fence(__ATOMIC_ACQUIRE, "agent");
            xb_add(&bar[XB_XGEN(b.x)], 1u);
            asm volatile("s_waitcnt vmcnt(0)" ::: "memory");
        } else {
            XB_SPIN(xb_ld(&bar[XB_XGEN(b.x)]) == gen, bar);
            __builtin_amdgcn_fence(__ATOMIC_ACQUIRE, "agent");
            asm volatile("s_waitcnt vmcnt(0)" ::: "memory");
        }
    }
    __syncthreads();
}

struct Args { const float* in[23]; float* out; unsigned char* ws; int ph_lo, ph_hi; };
struct Frame {
    LAS unsigned char* lds;
    volatile LAS unsigned* MISC;
    gu32* ctl;
    int tid, lane, wave, bid, G, gw, NGW;
    const int* pos; float* out; GAS unsigned char* ws;
};
__device__ __forceinline__ void fresh(Frame& F, const Args& args) {
    int t = threadIdx.x; asm volatile("; fresh tid" : "+v"(t)); int b = blockIdx.x; asm volatile("; fresh bid" : "+s"(b));
    GAS unsigned char* w = (GAS unsigned char*)args.ws; asm volatile("; fresh ws" : "+s"(w));
    F.tid = t; F.lane = t & 63; F.wave = __builtin_amdgcn_readfirstlane(t >> 6); F.bid = b; F.gw = b * NWAVES + F.wave; F.ws = w; F.ctl = (gu32*)(w + WS_CTL);
}
#define WSP(T, off) ((T*)(F.ws + (off)))
#define WLP(T, l, off) ((T*)(F.ws + WS_W + (size_t)(l) * WL_STRIDE + (off)))
enum { IN_X = 0, IN_C, IN_POS, IN_WADA, IN_BADA, IN_WIN, IN_QNORM, IN_KVNORM, IN_WUQ, IN_WUKV, IN_DLAM, IN_DSUB, IN_CW1, IN_CB1, IN_CW2, IN_WBR, IN_WOUT, IN_LN1G, IN_LN1B, IN_WFF1, IN_WFF2, IN_LN2G, IN_LN2B };

template <class Map>
__device__ __forceinline__ void transpose_item(const float* W, int K, int Nsrc, bf16_t* WT, int Ndst, const Map& map, const float* rowscale, LAS float* scr, int item, int lane) {
    const int nblk = Ndst / 32, kb = item / nblk, nb = item % nblk, k0 = 64 * kb, n0 = 32 * nb;
    const int n4 = (lane & 7) * 4, ns = map(n0 + n4);
#pragma unroll
    for (int i = 0; i < 8; ++i) { const int kk = 8 * i + (lane >> 3); f32x4 v = {0.f, 0.f, 0.f, 0.f};
        if (ns >= 0) { v = *(const f32x4*)(W + (size_t)(k0 + kk) * Nsrc + ns); if (rowscale) v = v * rowscale[k0 + kk]; }
        *(LAS f32x4*)(scr + kk * 36 + n4) = v; }
    LDS_WAIT(); asm volatile("" ::: "memory");
    const int c = lane & 7;
#pragma unroll
    for (int j = 0; j < 4; ++j) { const int n = (lane >> 3) + 8 * j; const LAS float* s = scr + (8 * c) * 36 + n;
        u32x4 o; o.x = pk2(s[0 * 36], s[1 * 36]); o.y = pk2(s[2 * 36], s[3 * 36]); o.z = pk2(s[4 * 36], s[5 * 36]); o.w = pk2(s[6 * 36], s[7 * 36]);
        *(GAS u32x4*)(WT + (size_t)(n0 + n) * K + k0 + 8 * c) = o; }
    LDS_WAIT(); asm volatile("" ::: "memory");
}
struct MapId { __device__ __forceinline__ int operator()(int n) const { return n; } };
struct MapZ { __device__ __forceinline__ int operator()(int n) const { return zsrc(n); } };
template <class Map>
__device__ __forceinline__ void transpose_all(Frame& F, const float* W, int K, int Nsrc, bf16_t* WT, int Ndst, const Map& map, const float* rowscale, int& rot) {
    LAS float* scr = (LAS float*)(F.lds + F.wave * 16384);
    const int nitems = (K / 64) * (Ndst / 32);
    int start = F.gw - rot; start %= F.NGW; if (start < 0) start += F.NGW;
    for (int it = start; it < nitems; it += F.NGW) transpose_item(W, K, Nsrc, WT, Ndst, map, rowscale, scr, it, F.lane);
    rot = (rot + nitems) % F.NGW;
}
__device__ __forceinline__ void p0_prologue(Frame& F, const Args& args) {
    int rot = 0;
    for (int l = 0; l < NL; ++l) {
        transpose_all(F, args.in[IN_WIN] + (size_t)l * D * DIN_SRC, D, DIN_SRC, WLP(bf16_t, l, WL_IN), LDZ, MapZ(), nullptr, rot);
        transpose_all(F, args.in[IN_WFF1] + (size_t)l * D * FF, D, FF, WLP(bf16_t, l, WL_FF1), FF, MapId(), nullptr, rot);
        transpose_all(F, args.in[IN_WFF2] + (size_t)l * FF * D, FF, D, WLP(bf16_t, l, WL_FF2), D, MapId(), nullptr, rot);
        for (int n = 0; n < 3; ++n)
            transpose_all(F, args.in[IN_WBR] + ((size_t)l * 3 + n) * 1024 * D, 1024, D, WLP(bf16_t, l, WL_BR) + (size_t)n * D * 1024, D, MapId(), nullptr, rot);
        transpose_all(F, args.in[IN_WOUT] + (size_t)l * D * D, D, D, WLP(bf16_t, l, WL_OUT), D, MapId(), nullptr, rot);
        transpose_all(F, args.in[IN_WUQ] + (size_t)l * 512 * 1536, 512, 1536, WLP(bf16_t, l, WL_UQ), 1536, MapId(), args.in[IN_QNORM] + l * 512, rot);
        transpose_all(F, args.in[IN_WUKV] + (size_t)l * 256 * 2048, 256, 2048, WLP(bf16_t, l, WL_UKV), 2048, MapId(), args.in[IN_KVNORM] + l * 256, rot);
        for (int kv = 0; kv < 2; ++kv) {
            transpose_all(F, args.in[IN_CW1] + ((size_t)l * 2 + kv) * 4096 * 128, 4096, 128, WLP(bf16_t, l, WL_C1) + (size_t)kv * 128 * 4096, 128, MapId(), nullptr, rot);
            transpose_all(F, args.in[IN_CW2] + ((size_t)l * 2 + kv) * 128 * 128, 128, 128, WLP(bf16_t, l, WL_C2) + (size_t)kv * 128 * 128, 128, MapId(), nullptr, rot);
        }
    }
    __syncthreads();
    { float* rc = WSP(float, WS_ROPE); float* rs = rc + (size_t)S * 32;
      for (int idx = F.bid * NTHREADS + F.tid; idx < S * 32; idx += F.G * NTHREADS) { const int s = idx >> 5, i = idx & 31;
          const float inv = powf(10000.0f, -(float)(2 * i) / 64.0f); const float ang = (float)F.pos[s] * inv; rc[idx] = cosf(ang); rs[idx] = sinf(ang); } }
    if (F.bid == 0 && F.tid < 128) { float mn = 3.0e38f, mx = -3.0e38f; for (int i = 0; i < 64; ++i) { const float p = (float)F.pos[F.tid * 64 + i]; mn = fminf(mn, p); mx = fmaxf(mx, p); }
        WSP(float, WS_TPOS)[F.tid] = mn; WSP(float, WS_TPOS)[128 + F.tid] = mx; }
    { LAS float* cact = (LAS float*)F.lds; LAS float* red = cact + 2048;
      for (int k = F.tid; k < D; k += NTHREADS) { const float cv = args.in[IN_C][k]; cact[k] = cv / (1.f + __expf(-cv)); }
      __syncthreads();
      for (int job = F.bid; job < NL * 48; job += F.G) { const int l = job / 48, col0 = (job % 48) * 256;
          const float* wp = args.in[IN_WADA] + (size_t)l * D * (6 * D) + col0 + 4 * F.lane;
          f32x4 a = {0.f, 0.f, 0.f, 0.f};
          const int kbeg = F.wave * 256;
#pragma unroll 8
          for (int k = 0; k < 256; ++k) { const f32x4 w = *(const f32x4*)(wp + (size_t)(kbeg + k) * (6 * D)); a += w * cact[kbeg + k]; }
          *(LAS f32x4*)(red + F.wave * 256 + 4 * F.lane) = a;
          __syncthreads();
          if (F.tid < 256) { float s = args.in[IN_BADA][(size_t)l * 6 * D + col0 + F.tid];
#pragma unroll
              for (int w = 0; w < 8; ++w) s += red[w * 256 + F.tid];
              WSP(float, WS_MOD)[(size_t)l * 6 * D + col0 + F.tid] = s; }
          __syncthreads(); } }
}

__device__ __forceinline__ void ln_rows(Frame& F, const float* src, bool do_ln, const float* g, const float* b, float* xout, bool do_mod, const float* shift, const float* scale, bf16_t* hout, float* ssq_zero) {
    for (int row = F.gw; row < S; row += F.NGW) {
        const GAS f32x4* xr = (const GAS f32x4*)(src + (size_t)row * D) + F.lane;
        f32x4 v[8]; float s = 0.f;
#pragma unroll
        for (int j = 0; j < 8; ++j) { v[j] = xr[64 * j]; s += (v[j][0] + v[j][1]) + (v[j][2] + v[j][3]); }
        if (do_ln) {
            const float mean = wave_sum(s) * (1.f / D); float s2 = 0.f;
#pragma unroll
            for (int j = 0; j < 8; ++j) { v[j] = v[j] - mean; s2 += (v[j][0] * v[j][0] + v[j][1] * v[j][1]) + (v[j][2] * v[j][2] + v[j][3] * v[j][3]); }
            const float rstd = 1.f / sqrtf(wave_sum(s2) * (1.f / D) + 1e-5f);
            s = 0.f;
#pragma unroll
            for (int j = 0; j < 8; ++j) { const f32x4 gg = *((const f32x4*)g + F.lane + 64 * j), bb = *((const f32x4*)b + F.lane + 64 * j);
                v[j] = v[j] * rstd * gg + bb; *((GAS f32x4*)(xout + (size_t)row * D) + F.lane + 64 * j) = v[j]; s += (v[j][0] + v[j][1]) + (v[j][2] + v[j][3]); }
        }
        if (do_mod) {
            const float mean = wave_sum(s) * (1.f / D); float s2 = 0.f;
#pragma unroll
            for (int j = 0; j < 8; ++j) { v[j] = v[j] - mean; s2 += (v[j][0] * v[j][0] + v[j][1] * v[j][1]) + (v[j][2] * v[j][2] + v[j][3] * v[j][3]); }
            const float rstd = 1.f / sqrtf(wave_sum(s2) * (1.f / D) + 1e-5f);
#pragma unroll
            for (int j = 0; j < 8; ++j) { const f32x4 sc = *((const f32x4*)scale + F.lane + 64 * j), sh = *((const f32x4*)shift + F.lane + 64 * j);
                const f32x4 h = v[j] * rstd * (sc + 1.0f) + sh;
                u32x2 w; w.x = pk2(h[0], h[1]); w.y = pk2(h[2], h[3]);
                *((GAS u32x2*)(hout + (size_t)row * D) + F.lane + 64 * j) = w; }
        }
        if (ssq_zero && F.lane < 2) ssq_zero[(size_t)row * 2 + F.lane] = 0.f;
    }
}

__device__ __forceinline__ void krope_job(Frame& F) {
    const bf16_t* Z = WSP(bf16_t, WS_Z); bf16_t* KR = WSP(bf16_t, WS_KROPE); const float* rc = WSP(float, WS_ROPE); const float* rs = rc + (size_t)S * 32;
    for (int idx = F.bid * NTHREADS + F.tid; idx < S * 32; idx += F.G * NTHREADS) { const int s = idx >> 5, i = idx & 31;
        const float x1 = bf1(Z[(size_t)s * LDZ + ZC_KR + i]), x2 = bf1(Z[(size_t)s * LDZ + ZC_KR + 32 + i]); const float c = rc[idx], sn = rs[idx];
        KR[(size_t)s * 64 + i] = (bf16_t)f2bf(x1 * c - x2 * sn); KR[(size_t)s * 64 + 32 + i] = (bf16_t)f2bf(x1 * sn + x2 * c); }
}

__device__ __forceinline__ void diffnorm_job(Frame& F, int l) {
    const bf16_t* Z = WSP(bf16_t, WS_Z); LAS unsigned* red = (LAS unsigned*)F.lds;
    if (F.tid < 32) red[F.tid] = 0u;
    __syncthreads();
    float mx = 0.f;
    for (int row = F.gw; row < S; row += F.NGW) { const bf16_t* p = Z + (size_t)row * LDZ + ZC_DQ + 32 * F.lane;
        float ss = 0.f;
#pragma unroll
        for (int i = 0; i < 4; ++i) { const u32x4 w = *(const u32x4*)(p + 8 * i);
            ss += bflo(w.x) * bflo(w.x) + bfhi(w.x) * bfhi(w.x) + bflo(w.y) * bflo(w.y) + bfhi(w.y) * bfhi(w.y) + bflo(w.z) * bflo(w.z) + bfhi(w.z) * bfhi(w.z) + bflo(w.w) * bflo(w.w) + bfhi(w.w) * bfhi(w.w); }
        ss += __shfl_xor(ss, 1); mx = fmaxf(mx, ss); }
    if ((F.lane & 1) == 0) __hip_atomic_fetch_max(red + (F.lane >> 1), __builtin_bit_cast(unsigned, mx), __ATOMIC_RELAXED, __HIP_MEMORY_SCOPE_WORKGROUP);
    __syncthreads();
    if (F.tid < 32) __hip_atomic_fetch_max((unsigned*)(F.ctl + CW_NRM + 32 * l) + F.tid, red[F.tid], __ATOMIC_RELAXED, __HIP_MEMORY_SCOPE_AGENT);
    __syncthreads();
}
__device__ __forceinline__ float gelu_tanh(float x) { const float u = 0.7978845608028654f * (x + 0.044715f * x * x * x); return 0.5f * x * (1.f + tanhf(u)); }
__device__ __forceinline__ void compress_naive(Frame& F, const Args& args, int l) {
    const bf16_t* Z = WSP(bf16_t, WS_Z); bf16_t* KC = WSP(bf16_t, WS_KCMP);
    LAS float* hs = (LAS float*)(F.lds + F.wave * 4096);
    for (int item = F.gw; item < 4 * 128; item += F.NGW) { const int inst = item >> 7, kv = inst >> 1, g = inst & 1, n0 = (item & 127) * 4;
        const float* w1 = args.in[IN_CW1] + ((size_t)l * 2 + kv) * 4096 * 128; const float* b1 = args.in[IN_CB1] + ((size_t)l * 2 + kv) * 128; const float* w2 = args.in[IN_CW2] + ((size_t)l * 2 + kv) * 128 * 128;
        const int zc = ZC_NKV + ((0 * 2 + kv) * 2 + g) * 128;
        float a[4][2];
#pragma unroll
        for (int r = 0; r < 4; ++r) { a[r][0] = 0.f; a[r][1] = 0.f; }
        for (int k = 0; k < 4096; ++k) { const int t = k >> 7, d = k & 127; const f32x2 w = *(const f32x2*)(w1 + (size_t)k * 128 + 2 * F.lane);
#pragma unroll
            for (int r = 0; r < 4; ++r) { int tok = 16 * (n0 + r) + t; tok = tok < S ? tok : S - 1; const float xv = bf1(Z[(size_t)tok * LDZ + zc + d]); a[r][0] += xv * w[0]; a[r][1] += xv * w[1]; } }
        const f32x2 bb = *(const f32x2*)(b1 + 2 * F.lane);
#pragma unroll
        for (int r = 0; r < 4; ++r) { hs[r * 128 + 2 * F.lane] = gelu_tanh(a[r][0] + bb[0]); hs[r * 128 + 2 * F.lane + 1] = gelu_tanh(a[r][1] + bb[1]); }
        LDS_WAIT(); asm volatile("" ::: "memory");
        float o[4][2];
#pragma unroll
        for (int r = 0; r < 4; ++r) { o[r][0] = 0.f; o[r][1] = 0.f; }
        for (int j = 0; j < 128; ++j) { const f32x2 w = *(const f32x2*)(w2 + (size_t)j * 128 + 2 * F.lane);
#pragma unroll
            for (int r = 0; r < 4; ++r) { const float hv = hs[r * 128 + j]; o[r][0] += hv * w[0]; o[r][1] += hv * w[1]; } }
#pragma unroll
        for (int r = 0; r < 4; ++r) { const int n = n0 + r; const unsigned pk = (n < 511) ? pk2(o[r][0], o[r][1]) : 0u;
            *(unsigned*)(KC + (((size_t)kv * 2 + g) * 512 + n) * 128 + 2 * F.lane) = pk; }
        LDS_WAIT(); asm volatile("" ::: "memory");
    }
}


__device__ __forceinline__ void compress_mfma(Frame& F, const Args& args, int l) {
    const bf16_t* Z = WSP(bf16_t, WS_Z); bf16_t* KC = WSP(bf16_t, WS_KCMP);
    const int lane = F.lane, w = F.wave, r16 = lane & 15, kq = lane >> 4;
    LAS unsigned char* hs = F.lds;
    for (int item = F.bid; item < 128; item += F.G) { const int inst = item >> 5, kv = inst >> 1, g = inst & 1, n0 = (item & 31) * 16;
        const bf16_t* w1t = WLP(bf16_t, l, WL_C1) + (size_t)kv * 128 * 4096 + (size_t)(16 * w + r16) * 4096 + 8 * kq;
        const bf16_t* w2t = WLP(bf16_t, l, WL_C2) + (size_t)kv * 128 * 128 + (size_t)(16 * w + r16) * 128 + 8 * kq;
        int tok0 = 16 * (n0 + r16);
        const bf16_t* xa = Z + ZC_NKV + ((0 * 2 + kv) * 2 + g) * 128 + 8 * kq;
        f32x4 acc = {0.f, 0.f, 0.f, 0.f};
#pragma unroll 8
        for (int ks = 0; ks < 128; ++ks) { const int t = ks >> 2; int tok = tok0 + t; tok = tok < S ? tok : S - 1;
            const bf16x8 a = *(const bf16x8*)(xa + (size_t)tok * LDZ + 32 * (ks & 3)); const bf16x8 b = *(const bf16x8*)(w1t + 32 * ks);
            acc = __builtin_amdgcn_mfma_f32_16x16x32_bf16(a, b, acc, 0, 0, 0); }
        const float bb = args.in[IN_CB1][((size_t)l * 2 + kv) * 128 + 16 * w + r16];
        __syncthreads();
#pragma unroll
        for (int r = 0; r < 4; ++r) *(LAS bf16_t*)(hs + (4 * kq + r) * 272 + (16 * w + r16) * 2) = (bf16_t)f2bf(gelu_tanh(acc[r] + bb));
        __syncthreads();
        f32x4 o = {0.f, 0.f, 0.f, 0.f};
#pragma unroll
        for (int ks = 0; ks < 4; ++ks) { const bf16x8 a = *(const LAS bf16x8*)(hs + r16 * 272 + (32 * ks + 8 * kq) * 2); const bf16x8 b = *(const bf16x8*)(w2t + 32 * ks);
            o = __builtin_amdgcn_mfma_f32_16x16x32_bf16(a, b, o, 0, 0, 0); }
#pragma unroll
        for (int r = 0; r < 4; ++r) { const int n = n0 + 4 * kq + r; KC[(((size_t)kv * 2 + g) * 512 + n) * 128 + 16 * w + r16] = n < 511 ? (bf16_t)f2bf(o[r]) : (bf16_t)0; }
    }
    __syncthreads();
}

__device__ __forceinline__ float dotrow(const LAS float* q, const bf16_t* k, int n8) {
    float a = 0.f;
    for (int i = 0; i < n8; ++i) { const u32x4 w = *(const u32x4*)(k + 8 * i); const LAS f32x4* qq = (const LAS f32x4*)(q + 8 * i); const f32x4 q0 = qq[0], q1 = qq[1];
        a += q0[0] * bflo(w.x) + q0[1] * bfhi(w.x) + q0[2] * bflo(w.y) + q0[3] * bfhi(w.y) + q1[0] * bflo(w.z) + q1[1] * bfhi(w.z) + q1[2] * bflo(w.w) + q1[3] * bfhi(w.w); }
    return a;
}
__device__ __forceinline__ void naive_update(float& m, float& l, float& o0, float& o1, float s, const bf16_t* vrow0, size_t vstride) {
    const float mn = fmaxf(m, wave_max(s)); const float alpha = __expf(m - mn); const float p = __expf(s - mn);
    l = l * alpha + wave_sum(p); o0 *= alpha; o1 *= alpha; m = mn;
    for (int kk = 0; kk < 64; ++kk) { const float pk = __builtin_bit_cast(float, __builtin_amdgcn_readlane(__builtin_bit_cast(int, p), kk));
        if (pk != 0.f) { const unsigned v = *(const unsigned*)(vrow0 + (size_t)kk * vstride); o0 += pk * bflo(v); o1 += pk * bfhi(v); } }
}
__device__ __forceinline__ void pv_norm(float& o0, float& o1, float p, const bf16_t* vrow0, size_t vstride) {
    for (int kk = 0; kk < 64; ++kk) { const float pk = __builtin_bit_cast(float, __builtin_amdgcn_readlane(__builtin_bit_cast(int, p), kk));
        if (pk != 0.f) { const unsigned v = *(const unsigned*)(vrow0 + (size_t)kk * vstride); o0 += pk * bflo(v); o1 += pk * bfhi(v); } }
}
#define WAVE_LDS_SYNC() do { LDS_WAIT(); __builtin_amdgcn_wave_barrier(); asm volatile("" ::: "memory"); } while (0)
constexpr float NEG_INF = -__builtin_inff();

__device__ __forceinline__ void attn_naive(Frame& F, const Args& args, int l, bool do_mla, bool do_diff, bool do_nsa, size_t br_off = WS_BR) {
    const bf16_t* Z = WSP(bf16_t, WS_Z); const bf16_t* QM = WSP(bf16_t, WS_QM); const bf16_t* KVM = WSP(bf16_t, WS_KVM); const bf16_t* KR = WSP(bf16_t, WS_KROPE);
    const bf16_t* KC = WSP(bf16_t, WS_KCMP); bf16_t* BR = WSP(bf16_t, br_off);
    const float* rc = WSP(float, WS_ROPE); const float* rs = rc + (size_t)S * 32;
    LAS float* wq = (LAS float*)(F.lds + F.wave * 2048);
    LAS float* wimp = wq + 256;
    const int lane = F.lane;
    const float* lp = args.in[IN_DLAM] + (size_t)l * 256;
    const float lam_init = 0.8f - 0.6f * expf(-0.3f * (float)l);
    const float lam = expf(wave_sum(lp[lane] * lp[64 + lane])) - expf(wave_sum(lp[128 + lane] * lp[192 + lane])) + lam_init;
    if (do_mla) for (int item = F.gw; item < S * 8; item += F.NGW) { const int q = item >> 3, h = item & 7;
        { const float sc = 0.07216878364870322f;
          const bf16_t* qr = QM + (size_t)q * 1536 + h * 192;
          wq[lane] = bf1(qr[lane]) * sc; wq[64 + lane] = bf1(qr[64 + lane]) * sc;
          const int i = lane & 31; const float x1 = bf1(qr[128 + i]), x2 = bf1(qr[160 + i]), c = rc[(size_t)q * 32 + i], sn = rs[(size_t)q * 32 + i];
          wq[128 + lane] = (lane < 32 ? x1 * c - x2 * sn : x1 * sn + x2 * c) * sc; }
        WAVE_LDS_SYNC();
        float m = -1e30f, ls = 0.f, o0 = 0.f, o1 = 0.f;
        for (int kb = 0; kb <= q; kb += 64) { const int key = kb + lane; float s = NEG_INF;
            if (key <= q) s = dotrow(wq, KVM + (size_t)key * 2048 + h * 256, 16) + dotrow(wq + 128, KR + (size_t)key * 64, 8);
            naive_update(m, ls, o0, o1, s, KVM + (size_t)kb * 2048 + h * 256 + 128 + 2 * lane, 2048); }
        const float inv = ls > 0.f ? 1.f / ls : 0.f;
        *(unsigned*)(BR + (size_t)q * 3072 + h * 128 + 2 * lane) = pk2(o0 * inv, o1 * inv);
        WAVE_LDS_SYNC();
    }
    if (do_diff) for (int item = F.gw; item < S * 8; item += F.NGW) { const int q = item >> 3, h = item & 7;
        const float slope = exp2f(-0.5f * (float)(2 * h + 1)); const float pq = (float)F.pos[q];
        float r0[2], r1[2];
#pragma unroll
        for (int mp = 0; mp < 2; ++mp) {
            wq[lane] = bf1(Z[(size_t)q * LDZ + ZC_DQ + h * 128 + mp * 64 + lane]) * 0.125f;
            WAVE_LDS_SYNC();
            float m = -1e30f, ls = 0.f, o0 = 0.f, o1 = 0.f;
            for (int kb = 0; kb <= q; kb += 64) { const int key = kb + lane; float s = NEG_INF;
                if (key <= q) s = dotrow(wq, Z + (size_t)key * LDZ + ZC_DK + h * 128 + mp * 64, 8) - slope * fabsf(pq - (float)F.pos[key]);
                naive_update(m, ls, o0, o1, s, Z + (size_t)kb * LDZ + ZC_DV + h * 128 + 2 * lane, LDZ); }
            const float inv = ls > 0.f ? 1.f / ls : 0.f; r0[mp] = o0 * inv; r1[mp] = o1 * inv;
            WAVE_LDS_SYNC();
        }
        const float a0 = r0[0] - lam * r0[1], a1 = r1[0] - lam * r1[1];
        const float rr = 1.f / sqrtf(wave_sum(a0 * a0 + a1 * a1) * (1.f / 128.f) + 1e-6f);
        const float* gs = args.in[IN_DSUB] + (size_t)l * 128;
        *(unsigned*)(BR + (size_t)q * 3072 + 1024 + h * 128 + 2 * lane) = pk2(a0 * rr * gs[2 * lane] * (1.f - lam_init), a1 * rr * gs[2 * lane + 1] * (1.f - lam_init));
    }
    if (do_nsa) for (int item = F.gw; item < S * 2; item += F.NGW) { const int q = item >> 1, g = item & 1;
        const float pq = (float)F.pos[q]; const int cur = q >> 6; const int ncmp = q >= 31 ? ((q - 31) >> 4) + 1 : 0;
        const float sc = 0.08838834764831845f;
        wimp[lane] = 0.f; wimp[64 + lane] = 0.f;
        float oc0[4], oc1[4];
#pragma unroll
        for (int r = 0; r < 4; ++r) { const int hh = 4 * g + r; const float slope = exp2f(-(float)(hh + 1));
            const bf16_t* qr = Z + (size_t)q * LDZ + ZC_NQ + hh * 128; wq[lane] = bf1(qr[lane]) * sc; wq[64 + lane] = bf1(qr[64 + lane]) * sc;
            WAVE_LDS_SYNC();
            const bf16_t* kc = KC + ((size_t)(0 * 2 + g) * 512) * 128; const bf16_t* vc = KC + ((size_t)(1 * 2 + g) * 512) * 128;
            float m = -1e30f, ls = 0.f;
            for (int nb = 0; nb < ncmp; nb += 64) { const int n = nb + lane; float s = NEG_INF;
                if (n < ncmp) s = dotrow(wq, kc + (size_t)n * 128, 16) - slope * fabsf(pq - (float)F.pos[31 + 16 * n]);
                const float mn = fmaxf(m, wave_max(s)); ls = ls * __expf(m - mn) + wave_sum(__expf(s - mn)); m = mn; }
            const float inv = ls > 0.f ? 1.f / ls : 0.f; float o0 = 0.f, o1 = 0.f;
            for (int nb = 0; nb < ncmp; nb += 64) { const int n = nb + lane; float p = 0.f;
                if (n < ncmp) { const float s = dotrow(wq, kc + (size_t)n * 128, 16) - slope * fabsf(pq - (float)F.pos[31 + 16 * n]); p = __expf(s - m) * inv;
                    atomicAdd((float*)(wimp + (n >> 2)), p); if ((n & 3) == 3) atomicAdd((float*)(wimp + (n >> 2) + 1), p); }
                pv_norm(o0, o1, p, vc + (size_t)nb * 128 + 2 * lane, 128); }
            oc0[r] = o0; oc1[r] = o1;
            WAVE_LDS_SYNC();
        }
        unsigned long long mlo, mhi;
        { float v0, v1; { const int j0 = lane, j1 = lane + 64;
              v0 = (j0 == 0 || j0 == cur || j0 == cur - 1) ? __builtin_inff() : (j0 <= cur ? wimp[j0] : NEG_INF);
              v1 = (j1 == cur || j1 == cur - 1) ? __builtin_inff() : (j1 <= cur ? wimp[j1] : NEG_INF); }
          int c0 = 0, c1 = 0;
          for (int k = 0; k < 128; ++k) { const float vk = (k == 0 || k == cur || k == cur - 1) ? __builtin_inff() : (k <= cur ? wimp[k] : NEG_INF);
              c0 += (vk > v0 || (vk == v0 && k < lane)) ? 1 : 0; c1 += (vk > v1 || (vk == v1 && k < lane + 64)) ? 1 : 0; }
          mlo = __ballot(c0 < 16 && v0 > NEG_INF); mhi = __ballot(c1 < 16 && v1 > NEG_INF); }
        WAVE_LDS_SYNC();
#pragma unroll
        for (int r = 0; r < 4; ++r) { const int hh = 4 * g + r; const float slope = exp2f(-(float)(hh + 1));
            const bf16_t* qr = Z + (size_t)q * LDZ + ZC_NQ + hh * 128; wq[lane] = bf1(qr[lane]) * sc; wq[64 + lane] = bf1(qr[64 + lane]) * sc;
            WAVE_LDS_SYNC();
            const bf16_t* ks = Z + ZC_NKV + ((1 * 2 + 0) * 2 + g) * 128; const bf16_t* vs = Z + ZC_NKV + ((1 * 2 + 1) * 2 + g) * 128;
            float m = -1e30f, ls = 0.f, o0 = 0.f, o1 = 0.f;
            for (int j = 0; j < 128; ++j) { const bool on = j < 64 ? ((mlo >> j) & 1ull) : ((mhi >> (j - 64)) & 1ull); if (!on) continue;
                const int key = 64 * j + lane; float s = NEG_INF;
                if (key <= q) s = dotrow(wq, ks + (size_t)key * LDZ, 16) - slope * fabsf(pq - (float)F.pos[key]);
                naive_update(m, ls, o0, o1, s, vs + (size_t)(64 * j) * LDZ + 2 * lane, LDZ); }
            const float is = ls > 0.f ? 1.f / ls : 0.f; const float os0 = o0 * is, os1 = o1 * is;
            const bf16_t* kw = Z + ZC_NKV + ((2 * 2 + 0) * 2 + g) * 128; const bf16_t* vw = Z + ZC_NKV + ((2 * 2 + 1) * 2 + g) * 128;
            m = -1e30f; ls = 0.f; o0 = 0.f; o1 = 0.f;
            int kb0 = q - 511; kb0 = kb0 < 0 ? 0 : (kb0 & ~63);
            for (int kb = kb0; kb <= q; kb += 64) { const int key = kb + lane; float s = NEG_INF;
                if (key <= q && key > q - 512) s = dotrow(wq, kw + (size_t)key * LDZ, 16) - slope * fabsf(pq - (float)F.pos[key]);
                naive_update(m, ls, o0, o1, s, vw + (size_t)kb * LDZ + 2 * lane, LDZ); }
            const float iw = ls > 0.f ? 1.f / ls : 0.f; const float ow0 = o0 * iw, ow1 = o1 * iw;
            const bf16_t* gl = Z + (size_t)q * LDZ + ZC_NG + hh * 3;
            const float g0 = sigmoidf_(bf1(gl[0])), g1 = sigmoidf_(bf1(gl[1])), g2 = sigmoidf_(bf1(gl[2]));
            *(unsigned*)(BR + (size_t)q * 3072 + 2048 + hh * 128 + 2 * lane) = pk2(g0 * oc0[r] + g1 * os0 + g2 * ow0, g0 * oc1[r] + g1 * os1 + g2 * ow1);
            WAVE_LDS_SYNC();
        }
    }
}
namespace fa {
constexpr int VRS = 320;
constexpr int L_K = 0, KBUF = 25600;
constexpr int L_V = 51200, VBUF = 20480;
constexpr int L_POS = 92160, PBUF = 256;
constexpr int L_CTRL = 92672;
constexpr int L_LIST = 92928;
constexpr int L_IMP = 94208;
constexpr int L_SEL = 126976;
constexpr float LOG2E = 1.4426950408889634f;
typedef short v4i16_t __attribute__((ext_vector_type(4)));
typedef __bf16 bf16x2_t __attribute__((ext_vector_type(2)));

__device__ __forceinline__ unsigned cvtpk(float lo, float hi) { f32x2 v = {lo, hi}; bf16x2_t b = __builtin_convertvector(v, bf16x2_t); return __builtin_bit_cast(unsigned, b); }
__device__ __forceinline__ void swap32(float& a, float& b) { asm volatile("s_nop 1\n\tv_permlane32_swap_b32 %0, %1" : "+v"(a), "+v"(b)); }
__device__ __forceinline__ float swapmax(float v) { float a = v, b = v; swap32(a, b); return fmaxf(a, b); }
__device__ __forceinline__ float swapsum(float v) { float a = v, b = v; swap32(a, b); return a + b; }
__device__ __forceinline__ s16x4 vtr(const LAS unsigned char* p) { return __builtin_bit_cast(s16x4, __builtin_amdgcn_ds_read_tr16_b64_v4i16((LAS v4i16_t*)p)); }

template <int NQ, int KRS>
__device__ __forceinline__ void qk_tile(f32x16& p0, f32x16& p1, const LAS unsigned char* kl, const bf16x8 (&qf)[NQ]) {
    p0 = f32x16{}; p1 = f32x16{};
#pragma unroll
    for (int d0 = 0; d0 < NQ; ++d0) {
        const bf16x8 a0 = *(const LAS bf16x8*)(kl + d0 * 32), a1 = *(const LAS bf16x8*)(kl + 32 * KRS + d0 * 32);
        p0 = __builtin_amdgcn_mfma_f32_32x32x16_bf16(a0, qf[d0], p0, 0, 0, 0);
        p1 = __builtin_amdgcn_mfma_f32_32x32x16_bf16(a1, qf[d0], p1, 0, 0, 0);
    }
}
template <bool ALIBI>
__device__ __forceinline__ void scale_bias(f32x16& p0, f32x16& p1, float c1, float c2, float pq, const LAS float* pk) {
#pragma unroll
    for (int g4 = 0; g4 < 4; ++g4) {
        if (ALIBI) { const f32x4 pa = *(const LAS f32x4*)(pk + 8 * g4), pb = *(const LAS f32x4*)(pk + 32 + 8 * g4);
#pragma unroll
            for (int j = 0; j < 4; ++j) { p0[4 * g4 + j] = p0[4 * g4 + j] * c1 - c2 * fabsf(pq - pa[j]); p1[4 * g4 + j] = p1[4 * g4 + j] * c1 - c2 * fabsf(pq - pb[j]); } }
        else {
#pragma unroll
            for (int j = 0; j < 4; ++j) { p0[4 * g4 + j] *= c1; p1[4 * g4 + j] *= c1; } }
    }
}
__device__ __forceinline__ void mask_range(f32x16& p0, f32x16& p1, int kb4, int klo, int khi) {
#pragma unroll
    for (int r = 0; r < 16; ++r) { const int k0 = kb4 + (r & 3) + 8 * (r >> 2), k1 = k0 + 32;
        p0[r] = (k0 >= klo && k0 <= khi) ? p0[r] : -__builtin_inff(); p1[r] = (k1 >= klo && k1 <= khi) ? p1[r] : -__builtin_inff(); }
}
__device__ __forceinline__ float tile_max(const f32x16& p0, const f32x16& p1) {
    float a = fmaxf(p0[0], p1[0]);
#pragma unroll
    for (int r = 1; r < 16; ++r) a = fmaxf(a, fmaxf(p0[r], p1[r]));
    return swapmax(a);
}
__device__ __forceinline__ void softmax_step(f32x16& p0, f32x16& p1, float& m, float& l, float& alpha, float c1 = 1.f) {
    const float mn = fmaxf(m, c1 * tile_max(p0, p1)); alpha = __builtin_amdgcn_exp2f(m - mn); m = mn;
    p0 = p0 * c1 - mn; p1 = p1 * c1 - mn;
#pragma unroll
    for (int r = 0; r < 16; ++r) { p0[r] = __builtin_amdgcn_exp2f(p0[r]); p1[r] = __builtin_amdgcn_exp2f(p1[r]); }
    f32x16 sv = p0 + p1; f32x2 s2 = {0.f, 0.f};
#pragma unroll
    for (int r = 0; r < 16; r += 2) s2 += (f32x2){sv[r], sv[r + 1]};
    l = l * alpha + (s2[0] + s2[1]);
}
__device__ __forceinline__ void rescale(f32x16 (&o)[4], float alpha) {
    if (!__all(alpha == 1.f)) {
#pragma unroll
        for (int d = 0; d < 4; ++d)
#pragma unroll
            for (int r = 0; r < 16; ++r) o[d][r] *= alpha; }
}
__device__ __forceinline__ bf16x8 pack8(const f32x16& p, int b) {
    u32x4 w; w.x = cvtpk(p[b], p[b + 1]); w.y = cvtpk(p[b + 2], p[b + 3]); w.z = cvtpk(p[b + 4], p[b + 5]); w.w = cvtpk(p[b + 6], p[b + 7]); return __builtin_bit_cast(bf16x8, w);
}
template <int NB = 2>
__device__ __forceinline__ void pv_tile(f32x16 (&o)[4], const f32x16& p0, const f32x16& p1, const LAS unsigned char* vl) {
    bf16x8 pf[4]; pf[0] = pack8(p0, 0); pf[1] = pack8(p0, 8); pf[2] = pack8(p1, 0); pf[3] = pack8(p1, 8);
#pragma unroll
    for (int s2 = 0; s2 < 4 / NB; ++s2) {
        s16x4 lo[NB][4], hh[NB][4];
#pragma unroll
        for (int si = 0; si < NB; ++si)
#pragma unroll
            for (int d = 0; d < 4; ++d) { lo[si][d] = vtr(vl + (NB * s2 + si) * 16 * VRS + d * 64); hh[si][d] = vtr(vl + (NB * s2 + si) * 16 * VRS + 8 * VRS + d * 64); }
#pragma unroll
        for (int si = 0; si < NB; ++si)
#pragma unroll
            for (int d = 0; d < 4; ++d) { const bf16x8 vf = {lo[si][d][0], lo[si][d][1], lo[si][d][2], lo[si][d][3], hh[si][d][0], hh[si][d][1], hh[si][d][2], hh[si][d][3]};
                o[d] = __builtin_amdgcn_mfma_f32_32x32x16_bf16(vf, pf[NB * s2 + si], o[d], 0, 0, 0); }
    }
}
__device__ __forceinline__ void zero_o(f32x16 (&o)[4]) {
#pragma unroll
    for (int d = 0; d < 4; ++d) o[d] = f32x16{};
}

struct TileRegs { u32x4 k0, k1, k2, v0, v1; float ps; };
__device__ __forceinline__ void load128(TileRegs& R, const bf16_t* kp, size_t ks, const bf16_t* vp, size_t vs, int tid) {
    const int r = tid >> 4, c = (tid & 15) * 8;
    R.k0 = *(const u32x4*)(kp + (size_t)r * ks + c); R.k1 = *(const u32x4*)(kp + (size_t)(r + 32) * ks + c);
    if (vp) { R.v0 = *(const u32x4*)(vp + (size_t)r * vs + c); R.v1 = *(const u32x4*)(vp + (size_t)(r + 32) * vs + c); }
}
__device__ __forceinline__ void store128(const TileRegs& R, LAS unsigned char* kb, LAS unsigned char* vb, LAS float* pb, int tid, bool hasv, bool haspos) {
    const int r = tid >> 4, c16 = (tid & 15) * 16;
    *(LAS u32x4*)(kb + r * 272 + c16) = R.k0; *(LAS u32x4*)(kb + (r + 32) * 272 + c16) = R.k1;
    if (hasv) { *(LAS u32x4*)(vb + r * VRS + c16) = R.v0; *(LAS u32x4*)(vb + (r + 32) * VRS + c16) = R.v1; }
    if (haspos && tid < 64) pb[tid] = R.ps;
}
__device__ __forceinline__ void load_mla(TileRegs& R, const bf16_t* kvm  , const bf16_t* kr  , int tid) {
    u32x4 kk[3];
#pragma unroll
    for (int i = 0; i < 3; ++i) { const int c = tid + 512 * i, r = c / 24, cc = c - r * 24;
        kk[i] = cc < 16 ? *(const u32x4*)(kvm + (size_t)r * 2048 + cc * 8) : *(const u32x4*)(kr + (size_t)r * 64 + (cc - 16) * 8); }
    R.k0 = kk[0]; R.k1 = kk[1]; R.k2 = kk[2];
    const int r = tid >> 4, c = (tid & 15) * 8;
    R.v0 = *(const u32x4*)(kvm + 128 + (size_t)r * 2048 + c); R.v1 = *(const u32x4*)(kvm + 128 + (size_t)(r + 32) * 2048 + c);
}
__device__ __forceinline__ void store_mla(const TileRegs& R, LAS unsigned char* kb, LAS unsigned char* vb, int tid) {
    { const int c = tid, r = c / 24, cc = c - r * 24; *(LAS u32x4*)(kb + r * 400 + cc * 16) = R.k0; }
    { const int c = tid + 512, r = c / 24, cc = c - r * 24; *(LAS u32x4*)(kb + r * 400 + cc * 16) = R.k1; }
    { const int c = tid + 1024, r = c / 24, cc = c - r * 24; *(LAS u32x4*)(kb + r * 400 + cc * 16) = R.k2; }
    const int r = tid >> 4, c16 = (tid & 15) * 16;
    *(LAS u32x4*)(vb + r * VRS + c16) = R.v0; *(LAS u32x4*)(vb + (r + 32) * VRS + c16) = R.v1;
}
__device__ __forceinline__ void store_o(bf16_t* rowp  , const f32x16 (&o)[4], float sc) {
#pragma unroll
    for (int d = 0; d < 4; ++d)
#pragma unroll
        for (int g4 = 0; g4 < 4; ++g4) { u32x2 w; w.x = cvtpk(o[d][4 * g4] * sc, o[d][4 * g4 + 1] * sc); w.y = cvtpk(o[d][4 * g4 + 2] * sc, o[d][4 * g4 + 3] * sc);
            *(u32x2*)(rowp + 32 * d + 8 * g4) = w; }
}
__device__ __forceinline__ void addstore_o(bf16_t* rowp  , const f32x16 (&o)[4], float sc) {
#pragma unroll
    for (int d = 0; d < 4; ++d)
#pragma unroll
        for (int g4 = 0; g4 < 4; ++g4) { const unsigned long long ov = __hip_atomic_load((const unsigned long long*)(rowp + 32 * d + 8 * g4), __ATOMIC_RELAXED, __HIP_MEMORY_SCOPE_AGENT);
            u32x2 old; old.x = (unsigned)ov; old.y = (unsigned)(ov >> 32);
            u32x2 w; w.x = cvtpk(bflo(old.x) + o[d][4 * g4] * sc, bfhi(old.x) + o[d][4 * g4 + 1] * sc); w.y = cvtpk(bflo(old.y) + o[d][4 * g4 + 2] * sc, bfhi(old.y) + o[d][4 * g4 + 3] * sc);
            *(u32x2*)(rowp + 32 * d + 8 * g4) = w; }
}

__device__ __forceinline__ void mla_unit(Frame& F, int h, int qb) {
    const int tid = F.tid, lane = F.lane, w = F.wave, r32 = lane & 31, hi = lane >> 5;
    const bf16_t* QM = WSP(bf16_t, WS_QM); const bf16_t* KVM = WSP(bf16_t, WS_KVM) + h * 256; const bf16_t* KR = WSP(bf16_t, WS_KROPE); bf16_t* BR = WSP(bf16_t, WS_BR);
    const float* rc = WSP(float, WS_ROPE); const float* rs = rc + (size_t)S * 32;
    LAS unsigned char* lds = F.lds;
    const int q = 256 * qb + 32 * w + r32;
    bf16x8 qf[12];
    { const bf16_t* qrow = QM + (size_t)q * 1536 + h * 192 + 8 * hi;
#pragma unroll
      for (int d0 = 0; d0 < 8; ++d0) qf[d0] = *(const bf16x8*)(qrow + 16 * d0);
#pragma unroll
      for (int dd = 0; dd < 2; ++dd) { const u32x4 a = *(const u32x4*)(qrow + 128 + 16 * dd), b = *(const u32x4*)(qrow + 160 + 16 * dd);
          const float* cp = rc + (size_t)q * 32 + 16 * dd + 8 * hi; const float* sp = rs + (size_t)q * 32 + 16 * dd + 8 * hi;
          const f32x4 c0 = *(const f32x4*)cp, c1 = *(const f32x4*)(cp + 4), s0 = *(const f32x4*)sp, s1 = *(const f32x4*)(sp + 4);
          float x1[8], x2[8], y1[8], y2[8];
          x1[0] = bflo(a.x); x1[1] = bfhi(a.x); x1[2] = bflo(a.y); x1[3] = bfhi(a.y); x1[4] = bflo(a.z); x1[5] = bfhi(a.z); x1[6] = bflo(a.w); x1[7] = bfhi(a.w);
          x2[0] = bflo(b.x); x2[1] = bfhi(b.x); x2[2] = bflo(b.y); x2[3] = bfhi(b.y); x2[4] = bflo(b.z); x2[5] = bfhi(b.z); x2[6] = bflo(b.w); x2[7] = bfhi(b.w);
#pragma unroll
          for (int j = 0; j < 8; ++j) { const float c = j < 4 ? c0[j & 3] : c1[j & 3], s = j < 4 ? s0[j & 3] : s1[j & 3]; y1[j] = x1[j] * c - x2[j] * s; y2[j] = x1[j] * s + x2[j] * c; }
          u32x4 o1, o2; o1.x = cvtpk(y1[0], y1[1]); o1.y = cvtpk(y1[2], y1[3]); o1.z = cvtpk(y1[4], y1[5]); o1.w = cvtpk(y1[6], y1[7]);
          o2.x = cvtpk(y2[0], y2[1]); o2.y = cvtpk(y2[2], y2[3]); o2.z = cvtpk(y2[4], y2[5]); o2.w = cvtpk(y2[6], y2[7]);
          qf[8 + dd] = __builtin_bit_cast(bf16x8, o1); qf[10 + dd] = __builtin_bit_cast(bf16x8, o2); } }
    const float c1s = 0.07216878364870322f * LOG2E;
    float m = -1e30f, l = 0.f, alpha; f32x16 o[4]; zero_o(o); f32x16 p0, p1;
    const int nt = 4 * (qb + 1), mydiag = 4 * qb + (w >> 1);
    const LAS unsigned char* kl0 = lds + L_K + r32 * 400 + hi * 16;
    const LAS unsigned char* vl0 = lds + L_V + (4 * hi + ((lane & 15) >> 2)) * VRS + (16 * ((lane >> 4) & 1) + 4 * (lane & 3)) * 2;
    TileRegs R;
    load_mla(R, KVM, KR, tid);
    for (int t = 0; t < nt; ++t) { const int b = t & 1;
        store_mla(R, lds + L_K + b * KBUF, lds + L_V + b * VBUF, tid);
        __syncthreads();
        if (t + 1 < nt) load_mla(R, KVM + (size_t)(t + 1) * 64 * 2048, KR + (size_t)(t + 1) * 64 * 64, tid);
        if (t <= mydiag) {
            qk_tile<12, 400>(p0, p1, kl0 + b * KBUF, qf);
            if (t == mydiag) mask_range(p0, p1, 64 * t + 4 * hi, 0, q);
            softmax_step(p0, p1, m, l, alpha, c1s); rescale(o, alpha);
            pv_tile(o, p0, p1, vl0 + b * VBUF);
        }
    }
    l = swapsum(l); const float inv = l > 0.f ? 1.f / l : 0.f;
    store_o(BR + (size_t)q * 3072 + h * 128 + 4 * hi, o, inv);
}

__device__ __forceinline__ void diff_unit(Frame& F, const Args& args, int l_idx, int h, int qb) {
    const int tid = F.tid, lane = F.lane, w = F.wave, r32 = lane & 31, hi = lane >> 5, mp = w >> 2, wq = w & 3;
    const bf16_t* Z = WSP(bf16_t, WS_Z); bf16_t* BR = WSP(bf16_t, WS_BR);
    LAS unsigned char* lds = F.lds;
    const int q = 128 * qb + 32 * wq + r32;
    bf16x8 qf[4];
    { const bf16_t* qrow = Z + (size_t)q * LDZ + ZC_DQ + h * 128 + mp * 64 + 8 * hi;
#pragma unroll
      for (int d0 = 0; d0 < 4; ++d0) qf[d0] = *(const bf16x8*)(qrow + 16 * d0); }
    const float slope = exp2f(-0.5f * (float)(2 * h + 1));
    const float c1s = 0.125f * LOG2E, c2s = slope * LOG2E, pq = (float)F.pos[q];
    float m = -1e30f, l = 0.f, alpha; f32x16 o[4]; zero_o(o); f32x16 p0, p1;
    const int nt = 2 * (qb + 1), mydiag = 2 * qb + (wq >> 1);
    const bf16_t* kp = Z + ZC_DK + h * 128; const bf16_t* vp = Z + ZC_DV + h * 128;
    const LAS unsigned char* kl0 = lds + L_K + r32 * 272 + hi * 16 + mp * 128;
    const LAS unsigned char* vl0 = lds + L_V + (4 * hi + ((lane & 15) >> 2)) * VRS + (16 * ((lane >> 4) & 1) + 4 * (lane & 3)) * 2;
    int t0 = 0;
    { const unsigned* nr = (const unsigned*)(F.ctl + CW_NRM + 32 * l_idx);
      const float q0 = __builtin_bit_cast(float, nr[2 * h]), q1 = __builtin_bit_cast(float, nr[2 * h + 1]), k0 = __builtin_bit_cast(float, nr[16 + 2 * h]), k1 = __builtin_bit_cast(float, nr[17 + 2 * h]);
      const float thr = 152.f + 2.f * c1s * sqrtf(fmaxf(q0 * k0, q1 * k1)) * 1.01f;
      const float* tp = WSP(float, WS_TPOS);
      const float pqmin = fminf(tp[2 * qb], tp[2 * qb + 1]), pqmax = fmaxf(tp[128 + 2 * qb], tp[128 + 2 * qb + 1]);
      while (t0 < nt - 1) { const float dmin = fmaxf(fmaxf(pqmin - tp[128 + t0], tp[t0] - pqmax), 0.f); if (c2s * dmin > thr) ++t0; else break; }
      t0 = __builtin_amdgcn_readfirstlane(t0); }
    TileRegs R;
    load128(R, kp + (size_t)t0 * 64 * LDZ, LDZ, vp + (size_t)t0 * 64 * LDZ, LDZ, tid); if (tid < 64) R.ps = (float)F.pos[t0 * 64 + tid];
    for (int t = t0; t < nt; ++t) { const int b = (t - t0) & 1;
        store128(R, lds + L_K + b * KBUF, lds + L_V + b * VBUF, (LAS float*)(lds + L_POS + b * PBUF), tid, true, true);
        __syncthreads();
        if (t + 1 < nt) { load128(R, kp + (size_t)(t + 1) * 64 * LDZ, LDZ, vp + (size_t)(t + 1) * 64 * LDZ, LDZ, tid); if (tid < 64) R.ps = (float)F.pos[(t + 1) * 64 + tid]; }
        if (t <= mydiag) {
            qk_tile<4, 272>(p0, p1, kl0 + b * KBUF, qf);
            scale_bias<true>(p0, p1, c1s, c2s, pq, (const LAS float*)(lds + L_POS + b * PBUF) + 4 * hi);
            if (t == mydiag) mask_range(p0, p1, 64 * t + 4 * hi, 0, q);
            softmax_step(p0, p1, m, l, alpha); rescale(o, alpha);
            pv_tile(o, p0, p1, vl0 + b * VBUF);
        }
    }
    l = swapsum(l); const float inv = l > 0.f ? 1.f / l : 0.f;
    __syncthreads();
    LAS float* xb = (LAS float*)lds + wq * 4096 + lane;
    if (mp == 1) {
#pragma unroll
        for (int d = 0; d < 4; ++d)
#pragma unroll
            for (int r = 0; r < 16; ++r) xb[(16 * d + r) * 64] = o[d][r] * inv;
    }
    __syncthreads();
    if (mp == 0) {
        int li = l_idx; asm volatile("; keep the lambda arithmetic here (hoisted to the layer loop it stays live across every phase)" : "+s"(li));
        const float* lp = args.in[IN_DLAM] + (size_t)li * 256;
        const float lam_init = li == 0 ? 0.200000000f : li == 1 ? 0.355509068f : li == 2 ? 0.470713018f : 0.556058204f;
        const float lam = __expf(wave_sum(lp[lane] * lp[64 + lane])) - __expf(wave_sum(lp[128 + lane] * lp[192 + lane])) + lam_init;
        float ss = 0.f;
#pragma unroll
        for (int d = 0; d < 4; ++d)
#pragma unroll
            for (int r = 0; r < 16; ++r) { const float a = o[d][r] * inv - lam * xb[(16 * d + r) * 64]; o[d][r] = a; ss += a * a; }
        ss = swapsum(ss);
        const float rr = (1.f - lam_init) / sqrtf(ss * (1.f / 128.f) + 1e-6f);
        const float* gs = args.in[IN_DSUB] + (size_t)l_idx * 128 + 4 * hi;
#pragma unroll
        for (int d = 0; d < 4; ++d)
#pragma unroll
            for (int g4 = 0; g4 < 4; ++g4) { const f32x4 gv = *(const f32x4*)(gs + 32 * d + 8 * g4);
#pragma unroll
                for (int j = 0; j < 4; ++j) o[d][4 * g4 + j] *= gv[j]; }
        store_o(BR + (size_t)q * 3072 + 1024 + h * 128 + 4 * hi, o, rr);
    }
}

__device__ __forceinline__ void nsa_unit(Frame& F, int g, int qb) {
    const int tid = F.tid, lane = F.lane, w = F.wave, r32 = lane & 31, hi = lane >> 5;
    const bf16_t* Z = WSP(bf16_t, WS_Z); const bf16_t* KC = WSP(bf16_t, WS_KCMP); bf16_t* BR = WSP(bf16_t, WS_BR);
    LAS unsigned char* lds = F.lds;
    const int q0 = 64 * qb, qi = 8 * w + (r32 >> 2), q = q0 + qi, hh = 4 * g + (r32 & 3);
    bf16x8 qf[8];
    { const bf16_t* qrow = Z + (size_t)q * LDZ + ZC_NQ + hh * 128 + 8 * hi;
#pragma unroll
      for (int d0 = 0; d0 < 8; ++d0) qf[d0] = *(const bf16x8*)(qrow + 16 * d0); }
    const float slope = exp2f(-(float)(hh + 1));
    const float c1s = 0.08838834764831845f * LOG2E, c2s = slope * LOG2E, pq = (float)F.pos[q];
    float g0, g1, g2; { const bf16_t* gl = Z + (size_t)q * LDZ + ZC_NG + hh * 3; g0 = sigmoidf_(bf1(gl[0])); g1 = sigmoidf_(bf1(gl[1])); g2 = sigmoidf_(bf1(gl[2])); }
    bf16_t* orow = BR + (size_t)q * 3072 + 2048 + hh * 128 + 4 * hi;
    LAS float* imp = (LAS float*)(lds + L_IMP); LAS unsigned* sel = (LAS unsigned*)(lds + L_SEL); LAS unsigned* ctrl = (LAS unsigned*)(lds + L_CTRL); LAS unsigned* list = (LAS unsigned*)(lds + L_LIST);
    const LAS unsigned char* kl0 = lds + L_K + r32 * 272 + hi * 16;
    const LAS unsigned char* vl0 = lds + L_V + (4 * hi + ((lane & 15) >> 2)) * VRS + (16 * ((lane >> 4) & 1) + 4 * (lane & 3)) * 2;
    f32x16 o[4], p0, p1; TileRegs R; float alpha;
    for (int i = tid; i < 64 * 128; i += NTHREADS) imp[i] = 0.f;
    if (tid < 4) ctrl[4 + tid] = 0u;
    const int ntc = ((4 * qb + 2) >> 6) + 1;
    const int khi_c = q >= 31 ? ((q - 31) >> 4) : -1;
    const bf16_t* kc = KC + ((size_t)(0 * 2 + g) * 512) * 128; const bf16_t* vc = KC + ((size_t)(1 * 2 + g) * 512) * 128;
    float m = -1e30f, l = 0.f;
#define CMP_POS(t) do { if (tid < 64) { int pi = 31 + 16 * ((t) * 64 + tid); pi = pi < S ? pi : S - 1; R.ps = (float)F.pos[pi]; } } while (0)
    load128(R, kc, 128, nullptr, 0, tid); CMP_POS(0);
    for (int t = 0; t < ntc; ++t) { const int b = t & 1;
        store128(R, lds + L_K + b * KBUF, nullptr, (LAS float*)(lds + L_POS + b * PBUF), tid, false, true);
        __syncthreads();
        if (t + 1 < ntc) { load128(R, kc + (size_t)(t + 1) * 64 * 128, 128, nullptr, 0, tid); CMP_POS(t + 1); }
        qk_tile<8, 272>(p0, p1, kl0 + b * KBUF, qf);
        scale_bias<true>(p0, p1, c1s, c2s, pq, (const LAS float*)(lds + L_POS + b * PBUF) + 4 * hi);
        mask_range(p0, p1, 64 * t + 4 * hi, 0, khi_c);
        softmax_step(p0, p1, m, l, alpha);
    }
    __syncthreads();
    l = swapsum(l); const float invl = l > 0.f ? 1.f / l : 0.f;
    load128(R, kc, 128, nullptr, 0, tid); CMP_POS(0);
    for (int t = 0; t < ntc; ++t) { const int b = t & 1;
        store128(R, lds + L_K + b * KBUF, nullptr, (LAS float*)(lds + L_POS + b * PBUF), tid, false, true);
        __syncthreads();
        if (t + 1 < ntc) { load128(R, kc + (size_t)(t + 1) * 64 * 128, 128, nullptr, 0, tid); CMP_POS(t + 1); }
        qk_tile<8, 272>(p0, p1, kl0 + b * KBUF, qf);
        scale_bias<true>(p0, p1, c1s, c2s, pq, (const LAS float*)(lds + L_POS + b * PBUF) + 4 * hi);
        mask_range(p0, p1, 64 * t + 4 * hi, 0, khi_c);
        LAS float* ip = imp + qi * 128 + 16 * t + hi;
#pragma unroll
        for (int k4 = 0; k4 < 4; ++k4) {
            const float e0 = __builtin_amdgcn_exp2f(p0[4 * k4] - m) * invl, e1 = __builtin_amdgcn_exp2f(p0[4 * k4 + 1] - m) * invl, e2 = __builtin_amdgcn_exp2f(p0[4 * k4 + 2] - m) * invl, e3 = __builtin_amdgcn_exp2f(p0[4 * k4 + 3] - m) * invl;
            const float f0 = __builtin_amdgcn_exp2f(p1[4 * k4] - m) * invl, f1 = __builtin_amdgcn_exp2f(p1[4 * k4 + 1] - m) * invl, f2 = __builtin_amdgcn_exp2f(p1[4 * k4 + 2] - m) * invl, f3 = __builtin_amdgcn_exp2f(p1[4 * k4 + 3] - m) * invl;
            const int j0 = 2 * k4, j1 = 8 + 2 * k4;
            __hip_atomic_fetch_add(ip + j0, (e0 + e1) + (e2 + e3), __ATOMIC_RELAXED, __HIP_MEMORY_SCOPE_WORKGROUP);
            if (16 * t + hi + j0 + 1 < 128) __hip_atomic_fetch_add(ip + j0 + 1, e3, __ATOMIC_RELAXED, __HIP_MEMORY_SCOPE_WORKGROUP);
            __hip_atomic_fetch_add(ip + j1, (f0 + f1) + (f2 + f3), __ATOMIC_RELAXED, __HIP_MEMORY_SCOPE_WORKGROUP);
            if (16 * t + hi + j1 + 1 < 128) __hip_atomic_fetch_add(ip + j1 + 1, f3, __ATOMIC_RELAXED, __HIP_MEMORY_SCOPE_WORKGROUP); }
    }
    __syncthreads();
    { unsigned u0 = 0u, u1 = 0u, u2 = 0u, u3 = 0u;
      for (int qq = 0; qq < 8; ++qq) { LAS float* iq = imp + (8 * w + qq) * 128;
          const int j0 = lane, j1 = lane + 64;
          const float v0 = (j0 == 0 || j0 == qb || j0 == qb - 1) ? __builtin_inff() : (j0 <= qb ? iq[j0] : -__builtin_inff());
          const float v1 = (j1 == qb || j1 == qb - 1) ? __builtin_inff() : (j1 <= qb ? iq[j1] : -__builtin_inff());
          WAVE_LDS_SYNC();
          iq[j0] = v0; iq[j1] = v1;
          WAVE_LDS_SYNC();
          int c0 = 0, c1 = 0;
          for (int k4 = 0; k4 <= (qb >> 2); ++k4) { const f32x4 vv = *(const LAS f32x4*)(iq + 4 * k4);
#pragma unroll
              for (int jj = 0; jj < 4; ++jj) { const int k = 4 * k4 + jj; const float vk = vv[jj];
                  c0 += (vk > v0 || (vk == v0 && k < j0)) ? 1 : 0; c1 += (vk > v1 || (vk == v1 && k < j1)) ? 1 : 0; } }
          const unsigned long long mlo = __ballot(c0 < 16 && v0 > -__builtin_inff()), mhi = __ballot(c1 < 16 && v1 > -__builtin_inff());
          const unsigned a0 = (unsigned)mlo, a1 = (unsigned)(mlo >> 32), a2 = (unsigned)mhi, a3 = (unsigned)(mhi >> 32);
          if (lane == 0) { LAS unsigned* sq = sel + (8 * w + qq) * 4; sq[0] = a0; sq[1] = a1; sq[2] = a2; sq[3] = a3; }
          u0 |= a0; u1 |= a1; u2 |= a2; u3 |= a3; }
      if (lane == 0) { __hip_atomic_fetch_or(ctrl + 4, u0, __ATOMIC_RELAXED, __HIP_MEMORY_SCOPE_WORKGROUP); __hip_atomic_fetch_or(ctrl + 5, u1, __ATOMIC_RELAXED, __HIP_MEMORY_SCOPE_WORKGROUP);
          __hip_atomic_fetch_or(ctrl + 6, u2, __ATOMIC_RELAXED, __HIP_MEMORY_SCOPE_WORKGROUP); __hip_atomic_fetch_or(ctrl + 7, u3, __ATOMIC_RELAXED, __HIP_MEMORY_SCOPE_WORKGROUP); }
      __syncthreads();
      if (tid == 0) { int n = 0;
          for (int w4 = 0; w4 < 4; ++w4) { unsigned bits = ctrl[4 + w4]; while (bits) { const int b = __builtin_ctz(bits); bits &= bits - 1u; list[n++] = (unsigned)(32 * w4 + b); } }
          ctrl[8] = (unsigned)n; }
      __syncthreads();
      zero_o(o);
      load128(R, kc, 128, vc, 128, tid); CMP_POS(0);
      for (int t = 0; t < ntc; ++t) { const int b = t & 1;
          store128(R, lds + L_K + b * KBUF, lds + L_V + b * VBUF, (LAS float*)(lds + L_POS + b * PBUF), tid, true, true);
          __syncthreads();
          if (t + 1 < ntc) { load128(R, kc + (size_t)(t + 1) * 64 * 128, 128, vc + (size_t)(t + 1) * 64 * 128, 128, tid); CMP_POS(t + 1); }
          qk_tile<8, 272>(p0, p1, kl0 + b * KBUF, qf);
          scale_bias<true>(p0, p1, c1s, c2s, pq, (const LAS float*)(lds + L_POS + b * PBUF) + 4 * hi);
          mask_range(p0, p1, 64 * t + 4 * hi, 0, khi_c);
#pragma unroll
          for (int r = 0; r < 16; ++r) { p0[r] = __builtin_amdgcn_exp2f(p0[r] - m) * invl; p1[r] = __builtin_amdgcn_exp2f(p1[r] - m) * invl; }
          pv_tile<1>(o, p0, p1, vl0 + b * VBUF);
      }
      __syncthreads();
      store_o(orow, o, g0);
#undef CMP_POS
      const unsigned s0 = sel[qi * 4 + 0], s1 = sel[qi * 4 + 1], s2 = sel[qi * 4 + 2], s3 = sel[qi * 4 + 3];
      const int nb = (int)ctrl[8];
      const bf16_t* ks = Z + ZC_NKV + ((1 * 2 + 0) * 2 + g) * 128; const bf16_t* vs = Z + ZC_NKV + ((1 * 2 + 1) * 2 + g) * 128;
      m = -1e30f; l = 0.f; zero_o(o);
      if (nb > 0) { const int j = (int)list[0]; load128(R, ks + (size_t)j * 64 * LDZ, LDZ, vs + (size_t)j * 64 * LDZ, LDZ, tid); if (tid < 64) R.ps = (float)F.pos[64 * j + tid]; }
      for (int t = 0; t < nb; ++t) { const int b = t & 1; const int j = (int)list[t];
          store128(R, lds + L_K + b * KBUF, lds + L_V + b * VBUF, (LAS float*)(lds + L_POS + b * PBUF), tid, true, true);
          __syncthreads();
          if (t + 1 < nb) { const int jn = (int)list[t + 1]; load128(R, ks + (size_t)jn * 64 * LDZ, LDZ, vs + (size_t)jn * 64 * LDZ, LDZ, tid); if (tid < 64) R.ps = (float)F.pos[64 * jn + tid]; }
          const unsigned wsel = (j < 32 ? u0 : j < 64 ? u1 : j < 96 ? u2 : u3) >> (j & 31);
          if (wsel & 1u) {
              const unsigned mine = ((j < 32 ? s0 : j < 64 ? s1 : j < 96 ? s2 : s3) >> (j & 31)) & 1u;
              qk_tile<8, 272>(p0, p1, kl0 + b * KBUF, qf);
              scale_bias<true>(p0, p1, c1s, c2s, pq, (const LAS float*)(lds + L_POS + b * PBUF) + 4 * hi);
              mask_range(p0, p1, 64 * j + 4 * hi, 0, mine ? q : -1);
              softmax_step(p0, p1, m, l, alpha); rescale(o, alpha);
              pv_tile<1>(o, p0, p1, vl0 + b * VBUF);
          }
      }
      __syncthreads();
      l = swapsum(l); addstore_o(orow, o, l > 0.f ? g1 / l : 0.f);
    }
    { const bf16_t* kw = Z + ZC_NKV + ((2 * 2 + 0) * 2 + g) * 128; const bf16_t* vw = Z + ZC_NKV + ((2 * 2 + 1) * 2 + g) * 128;
      const int kb0 = q0 >= 512 ? q0 - 512 : 0, nw = (q0 - kb0) / 64 + 1;
      m = -1e30f; l = 0.f; zero_o(o);
      load128(R, kw + (size_t)kb0 * LDZ, LDZ, vw + (size_t)kb0 * LDZ, LDZ, tid); if (tid < 64) R.ps = (float)F.pos[kb0 + tid];
      for (int t = 0; t < nw; ++t) { const int b = t & 1; const int kb = kb0 + 64 * t;
          store128(R, lds + L_K + b * KBUF, lds + L_V + b * VBUF, (LAS float*)(lds + L_POS + b * PBUF), tid, true, true);
          __syncthreads();
          if (t + 1 < nw) { load128(R, kw + (size_t)(kb + 64) * LDZ, LDZ, vw + (size_t)(kb + 64) * LDZ, LDZ, tid); if (tid < 64) R.ps = (float)F.pos[kb + 64 + tid]; }
          qk_tile<8, 272>(p0, p1, kl0 + b * KBUF, qf);
          scale_bias<true>(p0, p1, c1s, c2s, pq, (const LAS float*)(lds + L_POS + b * PBUF) + 4 * hi);
          if (t == 0 || t == nw - 1) mask_range(p0, p1, kb + 4 * hi, q - 511, q);
          softmax_step(p0, p1, m, l, alpha); rescale(o, alpha);
          pv_tile<1>(o, p0, p1, vl0 + b * VBUF);
      }
      __syncthreads();
      l = swapsum(l); addstore_o(orow, o, l > 0.f ? g2 / l : 0.f);
    }
}
}

#ifndef FAST_MLA
#define FAST_MLA 1
#endif
#ifndef FAST_DIFF
#define FAST_DIFF 1
#endif
#ifndef FAST_NSA
#define FAST_NSA 1
#endif
constexpr int ATT_NITEMS = 1024;
__device__ const unsigned short ATT_ORDER[ATT_NITEMS] = {
  31,287,543,799,1055,1311,1567,1823,30,286,542,798,1054,1310,1566,1822,29,285,541,797,1053,1309,1565,1821,28,284,540,796,1052,1308,1564,1820,
  27,283,539,795,1051,1307,1563,1819,26,282,538,794,1050,1306,1562,1818,25,281,537,793,1049,1305,1561,1817,24,280,536,792,1048,1304,1560,1816,
  23,279,535,791,1047,1303,1559,1815,22,278,534,790,1046,1302,1558,1814,21,277,533,789,1045,1301,1557,1813,20,276,532,788,1044,1300,1556,1812,
  19,275,531,787,1043,1299,1555,1811,5695,5951,18,274,530,786,1042,1298,1554,1810,5694,5950,5693,5949,5692,5948,5691,5947,17,273,529,785,1041,1297,
  1553,1809,5690,5946,5689,5945,5688,5944,16,272,528,784,1040,1296,1552,1808,5687,5943,5686,5942,5685,5941,15,271,527,783,1039,1295,1551,1807,5684,5940,
  5683,5939,5682,5938,5681,5937,14,270,526,782,1038,1294,1550,1806,5680,5936,8319,8575,8318,8574,8317,8573,8316,8572,8315,8571,8314,8570,5423,5679,5935,5424,
  5425,5426,5427,5428,5429,5430,5431,5432,5433,5434,5435,5436,5437,5438,5439,8313,8569,8312,8568,8311,8567,8310,8566,8309,8565,8308,8564,5422,5678,5934,8307,8563,
  8306,8562,8305,8561,13,269,525,781,1037,1293,1549,1805,8304,8560,5421,5677,5933,8303,8559,8302,8558,5420,5676,5932,8301,8557,8300,8556,8299,8555,8298,8554,
  8297,8553,8296,8552,5419,5675,5931,8295,8551,8294,8550,8293,8549,8292,8548,8291,8547,12,268,524,780,1036,1292,1548,1804,8290,8546,5418,5674,5930,8289,8545,
  8288,8544,5417,5673,5929,8287,8543,8286,8542,8285,8541,8284,8540,5416,5672,5928,8283,8539,8282,8538,8281,8537,8280,8536,8279,8535,8278,8534,5415,5671,5927,8277,
  8533,11,267,523,779,1035,1291,1547,1803,8276,8532,8275,8531,8274,8530,8273,8529,8272,8528,5414,5670,5926,5413,5669,5925,8271,8527,8270,8526,8269,8525,8268,
  8524,8267,8523,8266,8522,5412,5668,5924,8265,8521,8264,8520,8263,8519,10,266,522,778,1034,1290,1546,1802,8262,8518,8261,8517,8260,8516,5411,5667,5923,8259,
  8515,8258,8514,8257,8513,8256,8512,5410,5666,5922,8255,8511,8254,8510,5409,5665,5921,8253,8509,8252,8508,8251,8507,8250,8506,8249,8505,9,265,521,777,1033,
  1289,1545,1801,8248,8504,5408,5664,5920,8247,8503,8246,8502,8245,8501,8244,8500,8243,8499,8242,8498,5407,5663,5919,8241,8497,8240,8496,5406,5662,5918,8239,8495,
  8238,8494,8237,8493,8236,8492,5405,5661,5917,8235,8491,8,264,520,776,1032,1288,1544,1800,8234,8490,8233,8489,8232,8488,8231,8487,8230,8486,5404,5660,5916,
  8229,8485,8228,8484,8227,8483,8226,8482,8225,8481,8224,8480,5403,5659,5915,5402,5658,5914,8223,8479,8222,8478,8221,8477,7,263,519,775,1031,1287,1543,1799,
  8220,8476,8219,8475,8218,8474,5401,5657,5913,8217,8473,8216,8472,8215,8471,8214,8470,8213,8469,8212,8468,5400,5656,5912,8211,8467,5144,5145,5146,5147,5148,5149,
  5150,5151,5152,5153,5154,5155,5156,5157,5158,5159,5160,5161,5162,5163,5164,5165,5166,5167,5168,5169,5170,5171,5172,5173,5174,5175,5176,5177,5178,5179,5180,5181,
  5182,5183,8210,8466,5143,5399,5655,5911,8209,8465,6,262,518,774,1030,1286,1542,1798,5142,5398,5654,5910,8208,8464,5141,5397,5653,5909,5140,5396,5652,5908,
  8207,8463,5139,5395,5651,5907,5,261,517,773,1029,1285,1541,1797,8206,8462,5138,5394,5650,5906,8205,8461,8204,8460,5137,5393,5649,5905,8203,8459,5136,5392,
  5648,5904,4,260,516,772,1028,1284,1540,1796,8202,8458,5135,5391,5647,5903,8201,8457,5134,5390,5646,5902,8200,8456,5133,5389,5645,5901,8199,8455,3,259,
  515,771,1027,1283,1539,1795,4876,5132,5388,5644,5900,4877,4878,4879,4880,4881,4882,4883,4884,4885,4886,4887,4888,4889,4890,4891,4892,4893,4894,4895,4896,4897,
  4898,4899,4900,4901,4902,4903,4904,4905,4906,4907,4908,4909,4910,4911,4912,4913,4914,4915,4916,4917,4918,4919,4920,4921,4922,4923,4924,4925,4926,4927,4875,5131,
  5387,5643,5899,8198,8454,4874,5130,5386,5642,5898,8197,8453,4873,5129,5385,5641,5897,2,258,514,770,1026,1282,1538,1794,4872,5128,5384,5640,5896,8196,8452,
  4871,5127,5383,5639,5895,8195,8451,4614,4870,5126,5382,5638,5894,4615,4616,4617,4618,4619,4620,4621,4622,4623,4624,4625,4626,4627,4628,4629,4630,4631,4632,4633,
  4634,4635,4636,4637,4638,4639,4640,4641,4642,4643,4644,4645,4646,4647,4648,4649,4650,4651,4652,4653,4654,4655,4656,4657,4658,4659,4660,4661,4662,4663,4664,4665,
  4666,4667,4668,4669,4670,4671,1,257,513,769,1025,1281,1537,1793,4613,4869,5125,5381,5637,5893,8194,8450,4612,4868,5124,5380,5636,5892,8193,8449,4355,4611,
  4867,5123,5379,5635,5891,4356,4357,4358,4359,4360,4361,4362,4363,4364,4365,4366,4367,4368,4369,4370,4371,4372,4373,4374,4375,4376,4377,4378,4379,4380,4381,4382,
  4383,4384,4385,4386,4387,4388,4389,4390,4391,4392,4393,4394,4395,4396,4397,4398,4399,4400,4401,4402,4403,4404,4405,4406,4407,4408,4409,4410,4411,4412,4413,4414,
  4415,0,256,512,768,1024,1280,1536,1792,4354,4610,4866,5122,5378,5634,5890,8192,8448,4098,4099,4100,4101,4102,4103,4104,4105,4106,4107,4108,4109,4110,4111,
  4112,4113,4114,4115,4116,4117,4118,4119,4120,4121,4122,4123,4124,4125,4126,4127,4128,4129,4130,4131,4132,4133,4134,4135,4136,4137,4138,4139,4140,4141,4142,4143,
  4144,4145,4146,4147,4148,4149,4150,4151,4152,4153,4154,4155,4156,4157,4158,4159,4097,4353,4609,4865,5121,5377,5633,5889,4096,4352,4608,4864,5120,5376,5632,5888,
};

__device__ __forceinline__ void attn_phase(Frame& F, const Args& args, int l) {
    LAS int* slot = (LAS int*)(F.lds + fa::L_CTRL);
    gu32* head = F.ctl + CW_QUEUE + 64 * l;
    for (;;) {
        __syncthreads();
        if (F.tid == 0) *slot = (int)__hip_atomic_fetch_add(head, 1u, __ATOMIC_RELAXED, __HIP_MEMORY_SCOPE_AGENT);
        __syncthreads();
        const int idx = *slot;
        if (idx >= ATT_NITEMS) break;
        fresh(F, args);
        const unsigned code = ATT_ORDER[idx]; const int type = code >> 12, hd = (code >> 8) & 15, qb = code & 255;
#ifndef ATT_REP_MASK
#define ATT_REP_MASK 0
#endif
        for (int rep = 0; rep <= ((ATT_REP_MASK >> type) & 1); ++rep) {
            if (rep) { __syncthreads(); fresh(F, args); }
            if (type == 0) { if (FAST_MLA) fa::mla_unit(F, hd, qb); }
            else if (type == 1) { if (FAST_DIFF) fa::diff_unit(F, args, l, hd, qb); }
            else { if (FAST_NSA) fa::nsa_unit(F, hd, qb); }
        }
    }
}

#ifndef MK_N_LAUNCHES
#define MK_N_LAUNCHES 1
#endif
constexpr int NPHASE = 2 + 9 * NL;
__global__ void __launch_bounds__(NTHREADS, 2) fwd(Args args) {
    extern __shared__ __attribute__((aligned(16))) unsigned char lds[];
    Frame F;
    F.lds = (LAS unsigned char*)lds;
    F.MISC = (volatile LAS unsigned*)(F.lds + MISC_OFF);
    F.tid = threadIdx.x; F.lane = F.tid & 63; F.wave = __builtin_amdgcn_readfirstlane(F.tid >> 6);
    F.G = gridDim.x; F.bid = blockIdx.x; F.gw = blockIdx.x * NWAVES + F.wave; F.NGW = F.G * NWAVES;
    F.pos = (const int*)args.in[IN_POS]; F.out = args.out; F.ws = (GAS unsigned char*)args.ws;
    F.ctl = (gu32*)(F.ws + WS_CTL);
    for (int u = F.tid; u < (LDS_BYTES - MISC_OFF) / 4; u += NTHREADS) ((LAS unsigned*)(F.lds + MISC_OFF))[u] = 0u;
    __syncthreads();
    const int lo = args.ph_lo, hi = args.ph_hi;
    XcdBarrier bar; bar.bar = (unsigned*)(F.ctl + CW_BAR); bar.x = 0; bar.st = F.MISC + 8;
    if (hi - lo > 1) bar = xcd_barrier_post((unsigned*)(F.ctl + CW_BAR), F.MISC + 8);
#define IN(k) (lo <= (k) && (k) < hi)
#ifndef PH_REP_MASK
#define PH_REP_MASK 0
#endif
#define REPLOOP(k) for (int rep = 0; rep <= ((PH_REP_MASK >> (k)) & 1); ++rep)
#ifdef PROF
#define TSP ((unsigned long long*)((unsigned char*)args.ws + WS_CTL + 512 * 1024))
#define STAMP(k) do { if (blockIdx.x == 0 && threadIdx.x == 0) __hip_atomic_store(TSP + (k), (unsigned long long)wall_clock64(), __ATOMIC_RELAXED, __HIP_MEMORY_SCOPE_AGENT); } while (0)
#else
#define STAMP(k) do { } while (0)
#endif
#define SEAM(k) do { if (IN(k) && IN((k) + 1)) xcd_barrier(bar); STAMP((k) + 1); } while (0)

#define Z WSP(bf16_t, WS_Z)
#define H WSP(bf16_t, WS_H)
#define X WSP(float, WS_X)
#define Y WSP(float, WS_Y)
#define SSQ WSP(float, WS_SSQ)
#define MODL (WSP(float, WS_MOD) + (size_t)l * 6 * D)

    #ifndef SKIP_P0
    STAMP(0);
    if (IN(0)) REPLOOP(9) { __syncthreads(); fresh(F, args); p0_prologue(F, args); }
#endif
    SEAM(0);

    for (int l = 0; l < NL; ++l) {
        const int pb = 1 + 9 * l;
        if (IN(pb + 0)) REPLOOP(0) { fresh(F, args);
            if (l == 0) ln_rows(F, args.in[IN_X], false, nullptr, nullptr, nullptr, true, MODL, MODL + D, H, SSQ);
            else ln_rows(F, Y, true, args.in[IN_LN2G] + (size_t)(l - 1) * D, args.in[IN_LN2B] + (size_t)(l - 1) * D, X, true, MODL, MODL + D, H, SSQ);
        }
        SEAM(pb + 0);
        if (IN(pb + 1)) REPLOOP(1) { fresh(F, args);
            pg8::Gemm g{H, WLP(bf16_t, l, WL_IN), D, D, D, 0, 0}; pg8::PlainOrder So; So.init(S, LDZ, F.G, F.bid);
            pg8::EpiZ E{Z, rep ? nullptr : SSQ};
            pg8::gemm_phase<pg8::EpiZ, pg8::PlainOrder, true>(F.lds, g, So, E, F.tid);
        }
        SEAM(pb + 1);
        if (IN(pb + 2)) REPLOOP(2) {
            { fresh(F, args); pg8::Gemm g{Z + ZC_CQ, WLP(bf16_t, l, WL_UQ), 512, LDZ, 512, 0, 0}; pg8::PlainOrder So; So.init(S, 1536, F.G, F.bid);
              pg8::EpiRs E{WSP(bf16_t, WS_QM), 1536, SSQ, 0, 1.f / 512.f};
              pg8::gemm_phase<pg8::EpiRs, pg8::PlainOrder, false>(F.lds, g, So, E, F.tid); }
            { fresh(F, args); pg8::Gemm g{Z + ZC_CKV, WLP(bf16_t, l, WL_UKV), 256, LDZ, 256, 0, 0}; pg8::PlainOrder So; So.init(S, 2048, F.G, F.bid);
              pg8::EpiRs E{WSP(bf16_t, WS_KVM), 2048, SSQ, 1, 1.f / 256.f};
              pg8::gemm_phase<pg8::EpiRs, pg8::PlainOrder, false>(F.lds, g, So, E, F.tid); }
#ifndef SKIP_SIDE
            fresh(F, args); krope_job(F); diffnorm_job(F, l);
#ifdef NAIVE_COMPRESS
            compress_naive(F, args, l);
#else
            compress_mfma(F, args, l);
#endif
#endif
        }
        SEAM(pb + 2);
        if (IN(pb + 3)) { fresh(F, args); attn_phase(F, args, l);
#if !(FAST_MLA && FAST_DIFF && FAST_NSA)
            __syncthreads(); fresh(F, args); attn_naive(F, args, l, !FAST_MLA, !FAST_DIFF, !FAST_NSA);
#endif
        }
        SEAM(pb + 3);

#ifdef DIAG
        if (l == 0) {
            xcd_barrier(bar); fresh(F, args);
            attn_naive(F, args, 0, true, true, true, WS_MIX);
            xcd_barrier(bar); fresh(F, args);
            { const bf16_t* A = WSP(bf16_t, WS_BR); const bf16_t* B = WSP(bf16_t, WS_MIX); unsigned* res = (unsigned*)(F.ctl + 32768);
              for (int row = F.gw; row < S; row += F.NGW) { float mx[3] = {0.f, 0.f, 0.f};
#pragma unroll
                  for (int br = 0; br < 3; ++br) { for (int c = F.lane; c < 1024; c += 64) { const float d = fabsf(bf1(A[(size_t)row * 3072 + br * 1024 + c]) - bf1(B[(size_t)row * 3072 + br * 1024 + c])); mx[br] = fmaxf(mx[br], d); }
                      mx[br] = wave_max(mx[br]); }
                  if (F.lane == 0) { for (int br = 0; br < 3; ++br) { atomicMax(res + 64 * br, __builtin_bit_cast(unsigned, mx[br]));
                      if (mx[br] > DIAG_THR) { atomicAdd(res + 64 * (3 + br), 1u); atomicMax(res + 64 * (6 + br), 0x7fffffffu - (unsigned)row); atomicMax(res + 64 * (9 + br), (unsigned)row); } } } } }
            xcd_barrier(bar); fresh(F, args);
            { const unsigned* res = (const unsigned*)(F.ctl + 32768);
              float v[12]; for (int i = 0; i < 3; ++i) v[i] = __builtin_bit_cast(float, __hip_atomic_load(res + 64 * i, __ATOMIC_RELAXED, __HIP_MEMORY_SCOPE_AGENT));
              for (int i = 3; i < 6; ++i) v[i] = (float)__hip_atomic_load(res + 64 * i, __ATOMIC_RELAXED, __HIP_MEMORY_SCOPE_AGENT);
              for (int i = 6; i < 9; ++i) v[i] = (float)(0x7fffffffu - __hip_atomic_load(res + 64 * i, __ATOMIC_RELAXED, __HIP_MEMORY_SCOPE_AGENT));
              for (int i = 9; i < 12; ++i) v[i] = (float)__hip_atomic_load(res + 64 * i, __ATOMIC_RELAXED, __HIP_MEMORY_SCOPE_AGENT);
              const float Aval = DIAG_A, Bval = DIAG_B;
              for (size_t i = (size_t)F.bid * NTHREADS + F.tid; i < (size_t)S * D; i += (size_t)F.G * NTHREADS) F.out[i] = (i == 0) ? Aval : Bval; }
            return;
        }
#endif
        if (IN(pb + 4)) REPLOOP(4) { fresh(F, args);
            pg8::Gemm g{WSP(bf16_t, WS_BR), WLP(bf16_t, l, WL_BR), 1024, 3072, 1024, 1024, (size_t)D * 1024}; pg8::SliceOrder<3> So; So.init(S, D, F.G, F.bid);
            pg8::EpiMix E{Z + ZC_MG, WSP(bf16_t, WS_MIXB)};
            pg8::gemm_phase<pg8::EpiMix, pg8::SliceOrder<3>, true>(F.lds, g, So, E, F.tid);
        }
        SEAM(pb + 4);
        if (IN(pb + 5)) REPLOOP(5) { fresh(F, args);
            pg8::Gemm g{WSP(bf16_t, WS_MIXB), WLP(bf16_t, l, WL_OUT), D, D, D, 0, 0}; pg8::PlainOrder So; So.init(S, D, F.G, F.bid);
            pg8::EpiRes E{l == 0 ? args.in[IN_X] : X, MODL + 2 * D, Y};
            pg8::gemm_phase<pg8::EpiRes, pg8::PlainOrder, false>(F.lds, g, So, E, F.tid);
        }
        SEAM(pb + 5);
        if (IN(pb + 6)) REPLOOP(6) { fresh(F, args); ln_rows(F, Y, true, args.in[IN_LN1G] + (size_t)l * D, args.in[IN_LN1B] + (size_t)l * D, X, true, MODL + 3 * D, MODL + 4 * D, H, nullptr); }
        SEAM(pb + 6);
        if (IN(pb + 7)) REPLOOP(7) { fresh(F, args);
            pg8::Gemm g{H, WLP(bf16_t, l, WL_FF1), D, D, D, 0, 0}; pg8::PlainOrder So; So.init(S, FF, F.G, F.bid);
            pg8::EpiRelu2 E{Z  , FF};
            pg8::gemm_phase<pg8::EpiRelu2, pg8::PlainOrder, true>(F.lds, g, So, E, F.tid);
        }
        SEAM(pb + 7);
        if (IN(pb + 8)) REPLOOP(8) { fresh(F, args);
            pg8::Gemm g{Z, WLP(bf16_t, l, WL_FF2), FF, FF, FF, 0, 0}; pg8::PlainOrder So; So.init(S, D, F.G, F.bid);
            pg8::EpiRes E{X, MODL + 5 * D, Y};
            pg8::gemm_phase<pg8::EpiRes, pg8::PlainOrder, false>(F.lds, g, So, E, F.tid);
        }
        SEAM(pb + 8);
    }
    if (IN(NPHASE - 1)) { fresh(F, args); ln_rows(F, Y, true, args.in[IN_LN2G] + (size_t)(NL - 1) * D, args.in[IN_LN2B] + (size_t)(NL - 1) * D, F.out, false, nullptr, nullptr, nullptr, nullptr); }

#ifdef PROF
    STAMP(NPHASE);
    xcd_barrier(bar); fresh(F, args);
    {
#define TLD(i) __hip_atomic_load(TSP + (i), __ATOMIC_RELAXED, __HIP_MEMORY_SCOPE_AGENT)
#define TS(k) ((float)((TLD(2 + (k)) - TLD(1 + (k))) + (TLD(11 + (k)) - TLD(10 + (k))) + (TLD(20 + (k)) - TLD(19 + (k))) + (TLD(29 + (k)) - TLD(28 + (k)))) * 0.01f)
#define TPRO ((float)(TLD(1) - TLD(0)) * 0.01f)
#define TFIN ((float)(TLD(NPHASE) - TLD(NPHASE - 1)) * 0.01f)
#define TALL ((float)(TLD(NPHASE) - TLD(0)) * 0.01f)
      const float Bval = PROF_B, Aval = PROF_A + Bval + 100.f;
      for (size_t i = (size_t)F.bid * NTHREADS + F.tid; i < (size_t)S * D; i += (size_t)F.G * NTHREADS) F.out[i] = (i == 0) ? Aval : Bval; }
#endif
#undef IN
#undef SEAM
#undef Z
#undef H
#undef X
#undef Y
#undef SSQ
#undef MODL
}

extern "C" void kernel_launch(void* const* d_in, const int* in_sizes, int n_in, void* d_out, int out_size, void* d_ws, size_t ws_size, hipStream_t stream) {
    static int grid = 0;
    if (grid == 0) {
        if (n_in != 23 || in_sizes[0] != S * D || out_size != S * D || ws_size < WS_END) {
            fprintf(stderr, "kernel_launch: shape mismatch: n_in %d in0 %d out %d ws %zu (need %zu)\n", n_in, n_in > 0 ? in_sizes[0] : -1, out_size, ws_size, (size_t)WS_END); grid = -1; return; }
        int dev = 0, cus = 0, per_cu = 0;
        if (hipGetDevice(&dev) != hipSuccess || hipDeviceGetAttribute(&cus, hipDeviceAttributeMultiprocessorCount, dev) != hipSuccess) { fprintf(stderr, "kernel_launch: device query failed\n"); grid = -1; return; }
        if (hipFuncSetAttribute((const void*)fwd, hipFuncAttributeMaxDynamicSharedMemorySize, LDS_BYTES) != hipSuccess) { fprintf(stderr, "kernel_launch: hipFuncSetAttribute failed\n"); grid = -1; return; }
        if (hipOccupancyMaxActiveBlocksPerMultiprocessor(&per_cu, (const void*)fwd, NTHREADS, LDS_BYTES) != hipSuccess || per_cu < 1) { fprintf(stderr, "kernel_launch: occupancy query says %d\n", per_cu); }
        (void)hipGetLastError();
        grid = cus;
    }
    if (grid < 0) return;
    if (hipMemsetAsync((char*)d_ws + WS_CTL, 0, CTL_ZERO_BYTES, stream) != hipSuccess) { fprintf(stderr, "kernel_launch: memset failed\n"); return; }
    Args a{};
    for (int i = 0; i < 23; ++i) a.in[i] = (const float*)d_in[i];
    a.out = (float*)d_out; a.ws = (unsigned char*)d_ws;
#if MK_N_LAUNCHES == 1
    a.ph_lo = 0; a.ph_hi = NPHASE;
    hipLaunchKernelGGL(fwd, dim3(grid), dim3(NTHREADS), LDS_BYTES, stream, a);
#else
#ifndef HOST_REP_MASK
#define HOST_REP_MASK 0
#endif
    for (int p = 0; p < NPHASE; ++p) {
        const int type = (p == 0) ? 9 : (p == NPHASE - 1) ? 10 : (p - 1) % 9;
        const int reps = 1 + ((HOST_REP_MASK >> type) & 1);
        for (int r = 0; r < reps; ++r) {
            if (r > 0 && type == 1) { a.ph_lo = p - 1; a.ph_hi = p; hipLaunchKernelGGL(fwd, dim3(grid), dim3(NTHREADS), LDS_BYTES, stream, a); }
            a.ph_lo = p; a.ph_hi = p + 1; hipLaunchKernelGGL(fwd, dim3(grid), dim3(NTHREADS), LDS_BYTES, stream, a); }
    }
#endif
    const hipError_t le = hipPeekAtLastError();
    if (le != hipSuccess) fprintf(stderr, "kernel_launch: launch failed: %s\n", hipGetErrorName(le));
}
```
